# Optimizing an MI355X kernel written in HIP

```python
import math
import jax, jax.numpy as jnp
from jax import lax
import numpy as np

D_MODEL = 1024
BATCH = 4
SEQ = 8192
DEPTH = 2
DEC_BATCH = 2
DEC_SEQ = 8192
PAST_LEN = 128

DN_HEADS = 4
DN_HEAD_DIM = 64
DN_WIDTH = DN_HEADS * DN_HEAD_DIM
DN_CONV = 5
DN_CHUNK = 64
DIFF_HEADS = 4
DIFF_HEAD_DIM = 64
DIFF_WIDTH = DIFF_HEADS * 2 * DIFF_HEAD_DIM
SWA_HEADS = 4
SWA_KV_HEADS = 2
SWA_HEAD_DIM = 64
SWA_WIDTH = SWA_HEADS * SWA_HEAD_DIM
WINDOW = 128
BLOCK = 128
ROPE_THETA = 10000.0
MIX_WIDTH = DN_WIDTH + DIFF_WIDTH + SWA_WIDTH
D_FF = 4 * D_MODEL
EPS = 1e-6
IN_SIZES = (3 * DN_WIDTH,
            DN_WIDTH,
            2 * DN_HEADS,
            2 * DN_HEADS,
            2 * DIFF_HEADS * DIFF_HEAD_DIM,
            2 * DIFF_HEADS * DIFF_HEAD_DIM,
            DIFF_WIDTH,
            SWA_HEADS * SWA_HEAD_DIM,
            SWA_KV_HEADS * SWA_HEAD_DIM,
            SWA_KV_HEADS * SWA_HEAD_DIM)
IN_COLS = sum(IN_SIZES)

kernel_name = "hybrid_bidir_deltanet_diffattn_swa_encoder"


def _rmsnorm(x, w):
    xf = x.astype(jnp.float32)
    y = xf * lax.rsqrt(jnp.mean(xf * xf, axis=-1, keepdims=True) + EPS)
    return (y * w.astype(jnp.float32)).astype(x.dtype)


def _l2norm(x):
    xf = x.astype(jnp.float32)
    return xf * lax.rsqrt(jnp.sum(xf * xf, axis=-1, keepdims=True) + EPS)


def _rope(x, pos):
    half = x.shape[-1] // 2
    inv = ROPE_THETA ** (-jnp.arange(half, dtype=jnp.float32) / half)
    ang = pos[:, None] * inv[None, :]
    shape = (1, x.shape[1]) + (1,) * (x.ndim - 3) + (half,)
    cos = jnp.cos(ang).reshape(shape)
    sin = jnp.sin(ang).reshape(shape)
    xf = x.astype(jnp.float32)
    x1, x2 = xf[..., :half], xf[..., half:]
    return jnp.concatenate([x1 * cos - x2 * sin, x2 * cos + x1 * sin], axis=-1).astype(x.dtype)


def _short_conv(x, w):
    k, c = w.shape
    return lax.conv_general_dilated(
        x, w[:, None, :].astype(x.dtype), window_strides=(1,),
        padding=[(k // 2, k // 2)], dimension_numbers=("NWC", "WIO", "NWC"),
        feature_group_count=c)


def _gated_delta_rule(q, k, v, g, beta):
    f32 = jnp.float32
    b, s, h, dk = q.shape
    dv = v.shape[-1]
    c = DN_CHUNK
    n = s // c

    def chunks(t):
        t = t.astype(f32).reshape((b, n, c, h) + t.shape[3:])
        return jnp.moveaxis(t, 3, 1)

    q = chunks(q) * (dk ** -0.5)
    k = chunks(k)
    v = chunks(v)
    beta = chunks(beta)
    g = jnp.cumsum(chunks(g), axis=-1)
    tril = jnp.tril(jnp.ones((c, c), dtype=bool))
    strict = jnp.tril(jnp.ones((c, c), dtype=bool), -1)
    gdiff = g[..., :, None] - g[..., None, :]
    decay = jnp.where(tril, jnp.exp(jnp.where(tril, gdiff, 0.0)), 0.0)
    k_beta = k * beta[..., None]
    lmat = jnp.where(strict, jnp.einsum("bhncd,bhnmd->bhncm", k_beta, k) * decay, 0.0)
    amat = lmat + jnp.eye(c, dtype=f32)
    rhs = jnp.concatenate([v * beta[..., None], k_beta * jnp.exp(g)[..., None]], axis=-1)
    sol = lax.linalg.triangular_solve(amat, rhs, left_side=True, lower=True,
                                      unit_diagonal=True)
    u, w = sol[..., :dv], sol[..., dv:]
    a_intra = jnp.where(tril, jnp.einsum("bhncd,bhnmd->bhncm", q, k) * decay, 0.0)
    g_last = g[..., -1]
    q_dec = q * jnp.exp(g)[..., None]
    k_dec = k * jnp.exp(g_last[..., None] - g)[..., None]
    xs = (jnp.moveaxis(q_dec, 2, 0), jnp.moveaxis(k_dec, 2, 0), jnp.moveaxis(u, 2, 0),
          jnp.moveaxis(w, 2, 0), jnp.moveaxis(a_intra, 2, 0), jnp.moveaxis(g_last, 2, 0))

    def step(state, inp):
        qd, kd, ui, wi, ai, gl = inp
        v_new = ui - jnp.einsum("bhcd,bhde->bhce", wi, state)
        out = (jnp.einsum("bhcd,bhde->bhce", qd, state)
               + jnp.einsum("bhcm,bhme->bhce", ai, v_new))
        state = state * jnp.exp(gl)[..., None, None] + jnp.einsum("bhcd,bhce->bhde", kd, v_new)
        return state, out

    s0 = jnp.zeros((b, h, dk, dv), f32)
    _, o = lax.scan(step, s0, xs)
    return jnp.transpose(o, (1, 0, 3, 2, 4)).reshape(b, s, h, dv)


def _diff_attention(q, k, v, lam):
    b, s, h, _, d = q.shape
    nb = s // BLOCK
    q = q * (d ** -0.5)
    qb = jnp.moveaxis(q.reshape(b, nb, BLOCK, h, 2, d), 1, 0)

    def one_block(qi):
        sc = jnp.einsum("bqhjd,bkhjd->bhjqk", qi, k, preferred_element_type=jnp.float32)
        p = jax.nn.softmax(sc, axis=-1)
        a = p[:, :, 0] - lam * p[:, :, 1]
        return jnp.einsum("bhqk,bkhe->bqhe", a.astype(v.dtype), v)

    o = lax.map(one_block, qb)
    return jnp.moveaxis(o, 0, 1).reshape(b, s, h, 2 * d)


def _window_attention(q, k, v, sink):
    b, s, h, d = q.shape
    kv = k.shape[2]
    grp = h // kv
    nb = s // BLOCK
    qb = (q * (d ** -0.5)).reshape(b, nb, BLOCK, kv, grp, d)
    pad = ((0, 0), (BLOCK, BLOCK), (0, 0), (0, 0))
    kp = jnp.pad(k, pad)
    vp = jnp.pad(v, pad)

    def band(t):
        return jnp.concatenate(
            [t[:, i * BLOCK:i * BLOCK + s].reshape(b, nb, BLOCK, kv, d) for i in range(3)], axis=2)

    kb, vb = band(kp), band(vp)
    sc = jnp.einsum("bnqhgd,bnkhd->bnhgqk", qb, kb, preferred_element_type=jnp.float32)
    blk = jnp.arange(nb)[:, None, None] * BLOCK
    qpos = blk + jnp.arange(BLOCK)[None, :, None]
    kpos = blk - BLOCK + jnp.arange(3 * BLOCK)[None, None, :]
    mask = (jnp.abs(kpos - qpos) <= WINDOW) & (kpos >= 0) & (kpos < s)
    sc = jnp.where(mask[None, :, None, None], sc, -jnp.inf)
    sink_col = jnp.broadcast_to(sink.astype(jnp.float32).reshape(1, 1, kv, grp, 1, 1),
                                sc.shape[:-1] + (1,))
    p = jax.nn.softmax(jnp.concatenate([sc, sink_col], axis=-1), axis=-1)[..., :-1]
    o = jnp.einsum("bnhgqk,bnkhd->bnqhgd", p.astype(v.dtype), vb)
    return o.reshape(b, s, h, d)


def _layer(x, li, norm1_w, w_in, dn_conv_w, dn_a_log, dn_dt_bias, dn_norm_w,
           diff_lambda, diff_norm_w, swa_sink, w_out, norm2_w, w_up, w_down):
    b, s, _ = x.shape
    pos = jnp.arange(s, dtype=jnp.float32)
    hn = _rmsnorm(x, norm1_w)
    proj = hn @ w_in
    offs = []
    acc = 0
    for sz in IN_SIZES[:-1]:
        acc += sz
        offs.append(acc)
    (dn_qkv, dn_z, dn_b, dn_a, df_q, df_k, df_v, sw_q, sw_k, sw_v) = jnp.split(proj, offs, axis=-1)

    qkv = jax.nn.silu(_short_conv(dn_qkv, dn_conv_w))
    q, k, v = jnp.split(qkv, 3, axis=-1)
    q = _l2norm(q.reshape(b, s, DN_HEADS, DN_HEAD_DIM))
    k = _l2norm(k.reshape(b, s, DN_HEADS, DN_HEAD_DIM))
    v = v.reshape(b, s, DN_HEADS, DN_HEAD_DIM)
    beta = jax.nn.sigmoid(dn_b.astype(jnp.float32)).reshape(b, s, 2, DN_HEADS)
    g = (-jnp.exp(dn_a_log.astype(jnp.float32))
         * jax.nn.softplus(dn_a.astype(jnp.float32).reshape(b, s, 2, DN_HEADS)
                           + dn_dt_bias.astype(jnp.float32)))
    o_fwd = _gated_delta_rule(q, k, v, g[:, :, 0], beta[:, :, 0])
    flip = lambda t: jnp.flip(t, axis=1)
    o_bwd = flip(_gated_delta_rule(flip(q), flip(k), flip(v), flip(g[:, :, 1]), flip(beta[:, :, 1])))
    z = dn_z.astype(jnp.float32).reshape(b, s, DN_HEADS, DN_HEAD_DIM)
    dn_out = (_rmsnorm(o_fwd + o_bwd, dn_norm_w) * jax.nn.silu(z)).reshape(b, s, DN_WIDTH)

    dq = _rope(df_q.reshape(b, s, DIFF_HEADS, 2, DIFF_HEAD_DIM), pos)
    dk = _rope(df_k.reshape(b, s, DIFF_HEADS, 2, DIFF_HEAD_DIM), pos)
    dv = df_v.reshape(b, s, DIFF_HEADS, 2 * DIFF_HEAD_DIM)
    lam_init = 0.8 - 0.6 * math.exp(-0.3 * li)
    lamv = diff_lambda.astype(jnp.float32)
    lam = (jnp.exp(jnp.sum(lamv[0] * lamv[1])) - jnp.exp(jnp.sum(lamv[2] * lamv[3]))
           + lam_init)
    diff_o = _diff_attention(dq, dk, dv, lam)
    diff_out = (_rmsnorm(diff_o, diff_norm_w) * (1.0 - lam_init)).reshape(b, s, DIFF_WIDTH)

    sq = _rope(sw_q.reshape(b, s, SWA_HEADS, SWA_HEAD_DIM), pos)
    sk = _rope(sw_k.reshape(b, s, SWA_KV_HEADS, SWA_HEAD_DIM), pos)
    sv = sw_v.reshape(b, s, SWA_KV_HEADS, SWA_HEAD_DIM)
    swa_out = _window_attention(sq, sk, sv, swa_sink).reshape(b, s, SWA_WIDTH)

    mix = jnp.concatenate([dn_out.astype(x.dtype), diff_out.astype(x.dtype),
                           swa_out.astype(x.dtype)], axis=-1)
    x = x + mix @ w_out

    hn2 = _rmsnorm(x, norm2_w)
    x = x + jnp.square(jax.nn.relu(hn2 @ w_up)) @ w_down
    return x


def _trunk(x, norm1_w, w_in, dn_conv_w, dn_a_log, dn_dt_bias, dn_norm_w, diff_lambda,
           diff_norm_w, swa_sink, w_out, norm2_w, w_up, w_down, final_norm_w):
    for li in range(DEPTH):
        x = _layer(x, li, norm1_w[li], w_in[li], dn_conv_w[li], dn_a_log[li], dn_dt_bias[li],
                   dn_norm_w[li], diff_lambda[li], diff_norm_w[li], swa_sink[li], w_out[li],
                   norm2_w[li], w_up[li], w_down[li])
    return _rmsnorm(x, final_norm_w)


def setup_inputs(seed: int = 0) -> dict:
    key = jax.random.key(seed)
    ks = jax.random.split(key, 17)
    f32 = jnp.float32

    def nrm(k, shape, scale):
        return scale * jax.random.normal(k, shape, f32)

    x_prompt = nrm(ks[0], (BATCH, SEQ, D_MODEL), 1.0)
    x_sample = nrm(ks[1], (DEC_BATCH, DEC_SEQ, D_MODEL), 1.0)
    norm1_w = 1.0 + nrm(ks[2], (DEPTH, D_MODEL), 0.02)
    w_in = nrm(ks[3], (DEPTH, D_MODEL, IN_COLS), D_MODEL ** -0.5)
    dn_conv_w = nrm(ks[4], (DEPTH, DN_CONV, 3 * DN_WIDTH), DN_CONV ** -0.5)
    dn_a_log = jnp.log(jax.random.uniform(ks[5], (DEPTH, 2, DN_HEADS), f32, 1.0, 16.0))
    dt = jnp.exp(jax.random.uniform(ks[6], (DEPTH, 2, DN_HEADS), f32,
                                    math.log(1e-3), math.log(1e-1)))
    dn_dt_bias = dt + jnp.log(-jnp.expm1(-dt))
    dn_norm_w = 1.0 + nrm(ks[7], (DEPTH, DN_HEAD_DIM), 0.02)
    diff_lambda = nrm(ks[8], (DEPTH, 4, DIFF_HEAD_DIM), 0.1)
    diff_norm_w = 1.0 + nrm(ks[9], (DEPTH, 2 * DIFF_HEAD_DIM), 0.02)
    swa_sink = nrm(ks[10], (DEPTH, SWA_HEADS), 0.5)
    w_out = nrm(ks[11], (DEPTH, MIX_WIDTH, D_MODEL), MIX_WIDTH ** -0.5)
    norm2_w = 1.0 + nrm(ks[12], (DEPTH, D_MODEL), 0.02)
    w_up = nrm(ks[13], (DEPTH, D_MODEL, D_FF), D_MODEL ** -0.5)
    w_down = nrm(ks[14], (DEPTH, D_FF, D_MODEL), D_FF ** -0.5)
    final_norm_w = 1.0 + nrm(ks[15], (D_MODEL,), 0.02)
    return {"x_prompt": x_prompt, "x_sample": x_sample, "norm1_w": norm1_w, "w_in": w_in,
            "dn_conv_w": dn_conv_w, "dn_a_log": dn_a_log, "dn_dt_bias": dn_dt_bias,
            "dn_norm_w": dn_norm_w, "diff_lambda": diff_lambda, "diff_norm_w": diff_norm_w,
            "swa_sink": swa_sink, "w_out": w_out, "norm2_w": norm2_w, "w_up": w_up,
            "w_down": w_down, "final_norm_w": final_norm_w}


def reference(x_prompt, x_sample, norm1_w, w_in, dn_conv_w, dn_a_log, dn_dt_bias, dn_norm_w,
              diff_lambda, diff_norm_w, swa_sink, w_out, norm2_w, w_up, w_down, final_norm_w):
    y_prompt = _trunk(x_prompt, norm1_w, w_in, dn_conv_w, dn_a_log, dn_dt_bias, dn_norm_w,
                      diff_lambda, diff_norm_w, swa_sink, w_out, norm2_w, w_up, w_down,
                      final_norm_w)
    y_sample = _trunk(x_sample, norm1_w, w_in, dn_conv_w, dn_a_log, dn_dt_bias, dn_norm_w,
                      diff_lambda, diff_norm_w, swa_sink, w_out, norm2_w, w_up, w_down,
                      final_norm_w)
    return (y_prompt, y_sample)
```

```cpp
#include <hip/hip_runtime.h>
#include <cstdio>
#include <cstdint>
namespace pg8 {
#define PG8_LAS __attribute__((address_space(3)))
typedef unsigned short bf16_t;
typedef short bf16x8 __attribute__((ext_vector_type(8)));
typedef float f32x4 __attribute__((ext_vector_type(4)));
typedef unsigned u32x4 __attribute__((ext_vector_type(4)));
constexpr int BM = 256, BK = 64, HALF = 128, HTB = HALF * BK * 2  , STAGE_BYTES = 8 * HTB, NXCD = 8, WGM = 4;

__host__ __device__ __forceinline__ int lds_byte(int r, int c) { const int st = (r >> 4) * 2 + (c >> 5), rr = r & 15, cc = c & 31, ob = rr * 64 + cc * 2; return st * 1024 + (ob ^ (((ob >> 9) & 1) << 5)); }
__host__ __device__ __forceinline__ void stage_rc(int b, int& R, int& C) { const int st = b / 1024, sb = b % 1024, swz = sb ^ (((sb >> 9) & 1) << 5); R = (st >> 1) * 16 + swz / 64; C = (st & 1) * 32 + (swz % 64) / 2; }
__host__ __device__ __forceinline__ int perm32(int rho) { const int n = rho >> 4, i = rho & 15; return 8 * (i >> 2) + 4 * n + (i & 3); }

struct Unit { int pm, pn; };
struct Gemm { const bf16_t* A; const bf16_t* Bt; int M, N, K; };

struct StaticOrder {
    int nM, nN, nwg, G, c;
    __host__ __device__ void init(int M, int N, int G_, int c_) { nM = M / BM; nN = N / BM; nwg = nM * nN; G = G_; c = c_; }
    __host__ __device__ bool next(int i, Unit& u) const {
        const long L = (long)i * G + c; if (L >= nwg) return false;
        int wgid = (int)L; { const int q = nwg / NXCD, r = nwg % NXCD, xcd = wgid % NXCD, off = wgid / NXCD; wgid = (xcd < r ? xcd * (q + 1) : r * (q + 1) + (xcd - r) * q) + off; }
        const int nig = WGM * nN, gid = wgid / nig, fm = gid * WGM, gsz = (nM - fm) < WGM ? (nM - fm) : WGM;
        u.pm = fm + ((wgid % nig) % gsz); u.pn = (wgid % nig) / gsz; return true;
    }
    __device__ __forceinline__ void a_ready(const Unit&) const {}
    __device__ __forceinline__ void done(const Unit&) const {}
};

__device__ __forceinline__ unsigned cvt_pk_bf16(float lo, float hi) { unsigned r; asm volatile("v_cvt_pk_bf16_f32 %0, %1, %2" : "=v"(r) : "v"(lo), "v"(hi)); return r; }

__device__ __forceinline__ float row_rstd(const float* ss, int row) {
    const f32x4* p = (const f32x4*)(ss + (size_t)row * 16); const f32x4 a = p[0], b = p[1], c = p[2], d = p[3];
    const float t = (((a[0] + a[1]) + (a[2] + a[3])) + ((b[0] + b[1]) + (b[2] + b[3]))) + (((c[0] + c[1]) + (c[2] + c[3])) + ((d[0] + d[1]) + (d[2] + d[3])));
    return 1.0f / sqrtf(t * (1.0f / 1024.0f) + 1e-6f);
}
struct EpiProj {
    static constexpr bool PERM = true, AFTER_DRAIN = false;
    unsigned char* ws;
    const float* ss;
    __device__ __forceinline__ void operator()(const f32x4 (&acc)[2][2][4][2], const Unit& u, int wr, int wc, int fr, int fq) const {
        const int row0 = u.pm * BM + wr * 64 + fr; const int pn = u.pn;
        size_t boff; int ldc, colt;
        if (pn < 3) { boff = (size_t)84 << 20; ldc = 768; colt = pn * 256; }
        else if (pn == 3) { boff = (size_t)108 << 20; ldc = 256; colt = 0; }
        else if (pn < 6) { boff = (size_t)116 << 20; ldc = 512; colt = (pn - 4) * 256; }
        else if (pn < 8) { boff = (size_t)132 << 20; ldc = 512; colt = (pn - 6) * 256; }
        else if (pn < 10) { boff = (size_t)148 << 20; ldc = 512; colt = (pn - 8) * 256; }
        else if (pn == 10) { boff = (size_t)164 << 20; ldc = 256; colt = 0; }
        else { boff = (size_t)172 << 20; ldc = 256; colt = 0; }
        bf16_t* base = (bf16_t*)(ws + boff);
        const int col0 = colt + wc * 32 + 8 * fq;
#pragma unroll
        for (int ai = 0; ai < 2; ++ai)
#pragma unroll
            for (int m = 0; m < 4; ++m) { const int row = row0 + ai * HALF + m * 16; bf16_t* rowp = base + (size_t)row * ldc + col0;
                const float rs = ss ? row_rstd(ss, row) : 1.0f;
#pragma unroll
                for (int bj = 0; bj < 2; ++bj) { const f32x4 v0 = acc[ai][bj][m][0] * rs, v1 = acc[ai][bj][m][1] * rs;
                    u32x4 w; w.x = cvt_pk_bf16(v0[0], v0[1]); w.y = cvt_pk_bf16(v0[2], v0[3]); w.z = cvt_pk_bf16(v1[0], v1[1]); w.w = cvt_pk_bf16(v1[2], v1[3]);
                    *(u32x4*)(rowp + bj * HALF) = w; } }
    }
};
struct EpiRelu2 {
    static constexpr bool PERM = true, AFTER_DRAIN = false;
    bf16_t* O; int ldc;
    __device__ __forceinline__ void operator()(const f32x4 (&acc)[2][2][4][2], const Unit& u, int wr, int wc, int fr, int fq) const {
        const int row0 = u.pm * BM + wr * 64 + fr; const int col0 = u.pn * BM + wc * 32 + 8 * fq;
#pragma unroll
        for (int ai = 0; ai < 2; ++ai)
#pragma unroll
            for (int m = 0; m < 4; ++m) { bf16_t* rowp = O + (size_t)(row0 + ai * HALF + m * 16) * ldc + col0;
#pragma unroll
                for (int bj = 0; bj < 2; ++bj) { f32x4 v0 = acc[ai][bj][m][0], v1 = acc[ai][bj][m][1];
#pragma unroll
                    for (int e = 0; e < 4; ++e) { const float a = fmaxf(v0[e], 0.f), b = fmaxf(v1[e], 0.f); v0[e] = a * a; v1[e] = b * b; }
                    u32x4 w; w.x = cvt_pk_bf16(v0[0], v0[1]); w.y = cvt_pk_bf16(v0[2], v0[3]); w.z = cvt_pk_bf16(v1[0], v1[1]); w.w = cvt_pk_bf16(v1[2], v1[3]);
                    *(u32x4*)(rowp + bj * HALF) = w; } }
    }
};
struct EpiResid {
    static constexpr bool PERM = false, AFTER_DRAIN = false;
    const float* base; float* out; int ldc;
    __device__ __forceinline__ void operator()(const f32x4 (&acc)[2][2][4][2], const Unit& u, int wr, int wc, int fr, int fq) const {
        const int col0 = u.pn * BM + wc * 32 + 4 * fq;
#pragma unroll
        for (int ai = 0; ai < 2; ++ai)
#pragma unroll
            for (int m = 0; m < 4; ++m) { const size_t off = (size_t)(u.pm * BM + ai * HALF + wr * 64 + m * 16 + fr) * ldc + col0;
#pragma unroll
                for (int bj = 0; bj < 2; ++bj)
#pragma unroll
                    for (int n = 0; n < 2; ++n) { const f32x4 bs = *(const f32x4*)(base + off + bj * HALF + n * 16); *(f32x4*)(out + off + bj * HALF + n * 16) = bs + acc[ai][bj][m][n]; }  asm volatile("" ::: "memory"); }
    }
};

struct EpiResidN {
    static constexpr bool PERM = false, AFTER_DRAIN = false;
    const float* base; float* out; bf16_t* xb; float* ss; int ldc;
    __device__ __forceinline__ void operator()(const f32x4 (&acc)[2][2][4][2], const Unit& u, int wr, int wc, int fr, int fq) const {
        typedef unsigned u32x2 __attribute__((ext_vector_type(2)));
        const int col0 = u.pn * BM + wc * 32 + 4 * fq, lane = fr + 16 * fq;
#pragma unroll
        for (int ai = 0; ai < 2; ++ai)
#pragma unroll
            for (int m = 0; m < 4; ++m) { const int row = u.pm * BM + ai * HALF + wr * 64 + m * 16 + fr; const size_t off = (size_t)row * ldc + col0; float sq = 0.f;
#pragma unroll
                for (int bj = 0; bj < 2; ++bj)
#pragma unroll
                    for (int n = 0; n < 2; ++n) { const f32x4 bs = *(const f32x4*)(base + off + bj * HALF + n * 16); const f32x4 o = bs + acc[ai][bj][m][n];
                        *(f32x4*)(out + off + bj * HALF + n * 16) = o; sq += (o[0] * o[0] + o[1] * o[1]) + (o[2] * o[2] + o[3] * o[3]);
                        u32x2 w; w.x = cvt_pk_bf16(o[0], o[1]); w.y = cvt_pk_bf16(o[2], o[3]); *(u32x2*)(xb + off + bj * HALF + n * 16) = w; }
                sq += __int_as_float(__builtin_amdgcn_ds_bpermute((lane ^ 16) << 2, __float_as_int(sq))); sq += __int_as_float(__builtin_amdgcn_ds_bpermute((lane ^ 32) << 2, __float_as_int(sq)));
                if (fq == 0) ss[(size_t)row * 16 + u.pn * 4 + wc] = sq;
                asm volatile("" ::: "memory"); }
    }
};
struct EpiRes {
    static constexpr bool PERM = false, AFTER_DRAIN = false;
    const float* basef; const bf16_t* baseb; float* out; bf16_t* xb; float* ss;
    __device__ __forceinline__ void operator()(const f32x4 (&acc)[2][2][4][2], const Unit& u, int wr, int wc, int fr, int fq) const {
        typedef unsigned u32x2 __attribute__((ext_vector_type(2)));
        constexpr int ldc = 1024; const int col0 = u.pn * BM + wc * 32 + 4 * fq, lane = fr + 16 * fq;
#pragma unroll
        for (int ai = 0; ai < 2; ++ai)
#pragma unroll
            for (int m = 0; m < 4; ++m) { const int row = u.pm * BM + ai * HALF + wr * 64 + m * 16 + fr; const size_t off = (size_t)row * ldc + col0; float sq = 0.f;
#pragma unroll
                for (int bj = 0; bj < 2; ++bj)
#pragma unroll
                    for (int n = 0; n < 2; ++n) { const size_t o2 = off + bj * HALF + n * 16; f32x4 bs;
                        if (baseb) { const u32x2 b2 = *(const u32x2*)(baseb + o2); bs = (f32x4){__uint_as_float(b2.x << 16), __uint_as_float(b2.x & 0xffff0000u), __uint_as_float(b2.y << 16), __uint_as_float(b2.y & 0xffff0000u)}; }
                        else bs = *(const f32x4*)(basef + o2);
                        const f32x4 o = bs + acc[ai][bj][m][n];
                        if (out) *(f32x4*)(out + o2) = o;
                        if (xb) { sq += (o[0] * o[0] + o[1] * o[1]) + (o[2] * o[2] + o[3] * o[3]); u32x2 w; w.x = cvt_pk_bf16(o[0], o[1]); w.y = cvt_pk_bf16(o[2], o[3]); *(u32x2*)(xb + o2) = w; } }
                if (xb) { sq += __int_as_float(__builtin_amdgcn_ds_bpermute((lane ^ 16) << 2, __float_as_int(sq))); sq += __int_as_float(__builtin_amdgcn_ds_bpermute((lane ^ 32) << 2, __float_as_int(sq)));
                    if (fq == 0) ss[(size_t)row * 16 + u.pn * 4 + wc] = sq; }
                asm volatile("" ::: "memory"); }
    }
};
struct EpiRelu2S {
    static constexpr bool PERM = true, AFTER_DRAIN = false;
    bf16_t* O; const float* ss; int ldc;
    __device__ __forceinline__ void operator()(const f32x4 (&acc)[2][2][4][2], const Unit& u, int wr, int wc, int fr, int fq) const {
        const int row0 = u.pm * BM + wr * 64 + fr; const int col0 = u.pn * BM + wc * 32 + 8 * fq;
#pragma unroll
        for (int ai = 0; ai < 2; ++ai)
#pragma unroll
            for (int m = 0; m < 4; ++m) { const int row = row0 + ai * HALF + m * 16; bf16_t* rowp = O + (size_t)row * ldc + col0;
                const float rs = row_rstd(ss, row);
#pragma unroll
                for (int bj = 0; bj < 2; ++bj) { f32x4 v0 = acc[ai][bj][m][0], v1 = acc[ai][bj][m][1];
#pragma unroll
                    for (int e = 0; e < 4; ++e) { const float a = fmaxf(v0[e] * rs, 0.f), b = fmaxf(v1[e] * rs, 0.f); v0[e] = a * a; v1[e] = b * b; }
                    u32x4 w; w.x = cvt_pk_bf16(v0[0], v0[1]); w.y = cvt_pk_bf16(v0[2], v0[3]); w.z = cvt_pk_bf16(v1[0], v1[1]); w.w = cvt_pk_bf16(v1[2], v1[3]);
                    *(u32x4*)(rowp + bj * HALF) = w; } }
    }
};

template <class Epi, class Sched, bool ALIGN_EPI = false, bool SP2 = false>
__device__ __forceinline__ void gemm_phase(PG8_LAS unsigned char* lds, const Gemm g, const Sched& S, const Epi& E) {
    int tid_l = threadIdx.x; asm volatile("" : "+v"(tid_l));
    const int tid = tid_l, wid = __builtin_amdgcn_readfirstlane(tid >> 6), lane = tid & 63, wr = wid >> 2, wc = wid & 3, fr = lane & 15, fq = lane >> 4;
    const int K = g.K, nt = K / BK;
    unsigned voffA[2], voffB[2];
#pragma unroll
    for (int i = 0; i < 2; ++i) { int R, C; stage_rc(tid * 16 + i * 8192, R, C); const int Rb = Epi::PERM ? ((R & ~31) + perm32(R & 31)) : R;
        voffA[i] = (unsigned)(R * K + C) * 2u; voffB[i] = (unsigned)(Rb * K + C) * 2u; }
    const size_t kstep = (size_t)(BK * 2);
    const size_t hstep = (size_t)HALF * K * 2;
    const size_t tstep = 2 * hstep;
    const unsigned ldsw = (unsigned)wid * 1024u;
    const int aoff = lds_byte(wr * 64 + fr, fq * 8), boff = lds_byte(wc * 32 + fr, fq * 8);
#define PG8_SA(b, h) (((b) * 2 + (h)) * HTB)
#define PG8_SB(b, h) ((4 + (b) * 2 + (h)) * HTB)
#define PG8_STAGE(bufoff, gbase, voff) do { _Pragma("unroll") for (int _i = 0; _i < 2; ++_i) \
        __builtin_amdgcn_global_load_lds((const unsigned*)((const char*)(gbase) + (voff)[_i]), (PG8_LAS unsigned*)(lds + (bufoff) + ldsw + _i * 8192), 16, 0, 0); } while (0)
#define PG8_LDA(dst, b, h) do { _Pragma("unroll") for (int m = 0; m < 4; ++m) _Pragma("unroll") for (int k = 0; k < 2; ++k) dst[m][k] = *(const PG8_LAS bf16x8*)(lds + PG8_SA(b, h) + aoff + m * 2048 + k * 1024); } while (0)
#define PG8_LDB(dst, b, h) do { _Pragma("unroll") for (int n = 0; n < 2; ++n) _Pragma("unroll") for (int k = 0; k < 2; ++k) dst[n][k] = *(const PG8_LAS bf16x8*)(lds + PG8_SB(b, h) + boff + n * 2048 + k * 1024); } while (0)
#define PG8_MMA(ai, bj, At, Bt) do { __builtin_amdgcn_s_setprio(1); _Pragma("unroll") for (int m = 0; m < 4; ++m) _Pragma("unroll") for (int n = 0; n < 2; ++n) _Pragma("unroll") for (int k = 0; k < 2; ++k) \
        acc[ai][bj][m][n] = __builtin_amdgcn_mfma_f32_16x16x32_bf16(Bt[n][k], At[m][k], acc[ai][bj][m][n], 0, 0, 0); __builtin_amdgcn_s_setprio(0); } while (0)
#define PG8_WAIT_V(n) asm volatile("s_waitcnt vmcnt(" #n ")" ::: "memory")
#define PG8_WAIT_L(n) asm volatile("s_waitcnt lgkmcnt(" #n ")" ::: "memory")
#define PG8_BAR __builtin_amdgcn_s_barrier()
#define PG8_SCHED __builtin_amdgcn_sched_barrier(0)
    Unit cur, nxt; int ui = 0;
    if (!S.next(0, cur)) return;
    f32x4 acc[2][2][4][2];
#pragma unroll
    for (int a = 0; a < 2; ++a)
#pragma unroll
        for (int b = 0; b < 2; ++b)
#pragma unroll
            for (int m = 0; m < 4; ++m)
#pragma unroll
                for (int n = 0; n < 2; ++n) acc[a][b][m][n] = (f32x4){0.f, 0.f, 0.f, 0.f};
    bf16x8 At[4][2], B0[2][2], B1[2][2];
    const char* cA = (const char*)g.A + (size_t)cur.pm * tstep; const char* cB = (const char*)g.Bt + (size_t)cur.pn * tstep;
    S.a_ready(cur);
    if constexpr (SP2) {
        PG8_STAGE(PG8_SB(0, 0), cB, voffB); PG8_STAGE(PG8_SB(0, 1), cB + hstep, voffB); PG8_STAGE(PG8_SA(0, 0), cA, voffA); PG8_STAGE(PG8_SA(0, 1), cA + hstep, voffA);
        if (wr == 1) PG8_BAR;
        PG8_WAIT_V(2); PG8_BAR;
        PG8_STAGE(PG8_SB(1, 0), cB + kstep, voffB); PG8_STAGE(PG8_SA(1, 0), cA + kstep, voffA); PG8_STAGE(PG8_SB(1, 1), cB + hstep + kstep, voffB);
        PG8_WAIT_V(6); PG8_BAR;
    } else {
        PG8_STAGE(PG8_SB(0, 0), cB, voffB); PG8_STAGE(PG8_SA(0, 0), cA, voffA); PG8_STAGE(PG8_SB(0, 1), cB + hstep, voffB); PG8_STAGE(PG8_SA(0, 1), cA + hstep, voffA);
        if (wr == 1) PG8_BAR;
        PG8_WAIT_V(4); PG8_BAR;
        PG8_STAGE(PG8_SB(1, 0), cB + kstep, voffB); PG8_STAGE(PG8_SA(1, 0), cA + kstep, voffA); PG8_STAGE(PG8_SB(1, 1), cB + hstep + kstep, voffB);
        PG8_WAIT_V(6); PG8_BAR;
    }
    for (;;) {
        const bool has_next = S.next(ui + 1, nxt);
        const char* nA = has_next ? (const char*)g.A + (size_t)nxt.pm * tstep : cA; const char* nB = has_next ? (const char*)g.Bt + (size_t)nxt.pn * tstep : cB;
        for (int t = 0; t < nt; t += 2) {
            const bool last = (t == nt - 2);
            const char* a1 = cA + (size_t)(t + 1) * kstep;
            const char* a2 = last ? nA : cA + (size_t)(t + 2) * kstep; const char* b2 = last ? nB : cB + (size_t)(t + 2) * kstep;
            const char* a3 = a2 + kstep; const char* b3 = b2 + kstep;
            if (last && has_next) S.a_ready(nxt);
            if constexpr (SP2) {
            PG8_LDB(B0, 0, 0); PG8_LDB(B1, 0, 1); PG8_SCHED; PG8_LDA(At, 0, 0); PG8_STAGE(PG8_SA(1, 1), a1 + hstep, voffA);
            PG8_WAIT_V(8); PG8_WAIT_L(0); PG8_BAR; PG8_MMA(0, 0, At, B0); PG8_MMA(0, 1, At, B1); PG8_BAR; PG8_SCHED;
            PG8_LDA(At, 0, 1); PG8_STAGE(PG8_SB(0, 0), b2, voffB); PG8_STAGE(PG8_SB(0, 1), b2 + hstep, voffB); PG8_STAGE(PG8_SA(0, 0), a2, voffA);
            PG8_WAIT_V(8); PG8_WAIT_L(0); PG8_BAR; PG8_MMA(1, 0, At, B0); PG8_MMA(1, 1, At, B1); PG8_BAR; PG8_SCHED;
            PG8_LDB(B0, 1, 0); PG8_LDB(B1, 1, 1); PG8_SCHED; PG8_LDA(At, 1, 0); PG8_STAGE(PG8_SA(0, 1), a2 + hstep, voffA);
            PG8_WAIT_V(8); PG8_WAIT_L(0); PG8_BAR; PG8_MMA(0, 0, At, B0); PG8_MMA(0, 1, At, B1); PG8_BAR; PG8_SCHED;
            PG8_LDA(At, 1, 1); PG8_STAGE(PG8_SB(1, 0), b3, voffB); PG8_STAGE(PG8_SB(1, 1), b3 + hstep, voffB); PG8_STAGE(PG8_SA(1, 0), a3, voffA);
            PG8_WAIT_V(8); PG8_WAIT_L(0); PG8_BAR; PG8_MMA(1, 0, At, B0); PG8_MMA(1, 1, At, B1); PG8_BAR; PG8_SCHED;
            } else {
            PG8_LDB(B0, 0, 0); PG8_SCHED; PG8_LDA(At, 0, 0); PG8_STAGE(PG8_SA(1, 1), a1 + hstep, voffA);
            PG8_WAIT_L(8); PG8_BAR; PG8_WAIT_L(0); PG8_MMA(0, 0, At, B0); PG8_BAR; PG8_SCHED;
            PG8_LDB(B1, 0, 1); PG8_STAGE(PG8_SB(0, 0), b2, voffB);
            PG8_BAR; PG8_WAIT_L(0); PG8_MMA(0, 1, At, B1); PG8_BAR;
            PG8_LDA(At, 0, 1); PG8_STAGE(PG8_SA(0, 0), a2, voffA);
            PG8_BAR; PG8_WAIT_L(0); PG8_MMA(1, 0, At, B0); PG8_BAR; PG8_SCHED;
            PG8_STAGE(PG8_SB(0, 1), b2 + hstep, voffB);
            PG8_WAIT_V(6); PG8_BAR; PG8_MMA(1, 1, At, B1); PG8_BAR;
            PG8_LDB(B0, 1, 0); PG8_SCHED; PG8_LDA(At, 1, 0); PG8_STAGE(PG8_SA(0, 1), a2 + hstep, voffA);
            PG8_WAIT_L(8); PG8_BAR; PG8_WAIT_L(0); PG8_MMA(0, 0, At, B0); PG8_BAR; PG8_SCHED;
            PG8_LDB(B1, 1, 1); PG8_STAGE(PG8_SB(1, 0), b3, voffB);
            PG8_BAR; PG8_WAIT_L(0); PG8_MMA(0, 1, At, B1); PG8_BAR;
            PG8_LDA(At, 1, 1); PG8_STAGE(PG8_SA(1, 0), a3, voffA);
            PG8_BAR; PG8_WAIT_L(0); PG8_MMA(1, 0, At, B0); PG8_BAR; PG8_SCHED;
            PG8_STAGE(PG8_SB(1, 1), b3 + hstep, voffB);
            PG8_WAIT_V(6); PG8_BAR; PG8_MMA(1, 1, At, B1); PG8_BAR;
            }
        }
        if constexpr (ALIGN_EPI) { if (wr == 0) PG8_BAR; }
        if constexpr (!Epi::AFTER_DRAIN) { E(acc, cur, wr, wc, fr, fq); S.done(cur); }
        if (!has_next) break;
#pragma unroll
        for (int a = 0; a < 2; ++a)
#pragma unroll
            for (int b = 0; b < 2; ++b)
#pragma unroll
                for (int m = 0; m < 4; ++m)
#pragma unroll
                    for (int n = 0; n < 2; ++n) acc[a][b][m][n] = (f32x4){0.f, 0.f, 0.f, 0.f};
        cur = nxt; cA = nA; cB = nB; ++ui;
        if constexpr (ALIGN_EPI) { if (wr == 1) PG8_BAR; }
    }
    PG8_WAIT_V(0);
    if constexpr (!ALIGN_EPI) { if (wr == 0) PG8_BAR; }
    PG8_BAR;
    if constexpr (Epi::AFTER_DRAIN) { E.fused(acc, cur, wr, wc, fr, fq, lds, wid, lane); S.done(cur); }
#undef PG8_SA
#undef PG8_SB
#undef PG8_STAGE
#undef PG8_LDA
#undef PG8_LDB
#undef PG8_MMA
#undef PG8_WAIT_V
#undef PG8_WAIT_L
#undef PG8_BAR
#undef PG8_SCHED
}
}

#ifndef PG8_SP2
#define PG8_SP2 true
#endif
#ifndef PG8_ALIGN
#define PG8_ALIGN true
#endif
#include <hip/hip_bf16.h>
#include <cmath>
namespace attn_body {
using bf16=__hip_bfloat16;
using bf16x8=__attribute__((ext_vector_type(8)))short;
using s16x4=__attribute__((ext_vector_type(4)))short;
using f32x16=__attribute__((ext_vector_type(16)))float;
using u32x4=__attribute__((ext_vector_type(4)))unsigned;
constexpr int SEQ=8192,D=64;
constexpr int NW=8,QBLK=32,QB=QBLK*NW,KVBLK=64,NQB=SEQ/QB;
constexpr int ATTN_UNIT_ROWS=QB;
__device__ __forceinline__ int crow(int r,int hi){return (r&3)+8*(r>>2)+4*hi;}
#define SBAR() __builtin_amdgcn_sched_barrier(0)
__device__ __forceinline__ void cmask(f32x16&p0,f32x16&p1,int jb,int qrel,int hi){
  const float NEG=-INFINITY; int kb=64*jb+4*hi;
  #pragma unroll
  for(int r=0;r<16;++r){int kv=kb+(r&3)+8*(r>>2); if(kv>qrel)p0[r]=NEG; if(kv+32>qrel)p1[r]=NEG;}
}

constexpr int NSLOT=3, SLOTB=8192;
constexpr int LDS_K=0, LDS_V=NSLOT*SLOTB, LDS_WS=2*NSLOT*SLOTB, LDS_OST=LDS_WS+NW*64*4, LDS_BYTES=LDS_OST+NW*4096;
constexpr float C2=0.125f*1.4426950408889634f;
__device__ __forceinline__ void glds16(const void*gsrc,unsigned lds_dst){unsigned keep;
  asm volatile("s_mov_b32 %0, m0\n\ts_mov_b32 m0, %2\n\ts_nop 0\n\tglobal_load_lds_dwordx4 %1, off\n\ts_mov_b32 m0, %0":"=&s"(keep):"v"(gsrc),"s"(lds_dst):"memory");}
__device__ __forceinline__ float max3f(float a,float b,float c){float r;asm("v_max3_f32 %0, %1, %2, %3":"=v"(r):"v"(a),"v"(b),"v"(c));return r;}
__device__ __forceinline__ float max2f(float a,float b){float r;asm("v_max_f32_e32 %0, %1, %2":"=v"(r):"v"(a),"v"(b));return r;}
__device__ __forceinline__ float fadd_s(float a,float b){float r;asm("v_add_f32_e32 %0, %1, %2":"=v"(r):"v"(a),"v"(b));return r;}
__device__ __forceinline__ float fsub_s(float a,float b){float r;asm("v_sub_f32_e32 %0, %1, %2":"=v"(r):"v"(a),"v"(b));return r;}
typedef float f32x2_t __attribute__((ext_vector_type(2))); typedef __bf16 bf16x2_t __attribute__((ext_vector_type(2)));
__device__ __forceinline__ unsigned cvtpk_s(float lo,float hi){f32x2_t v={lo,hi};bf16x2_t b=__builtin_convertvector(v,bf16x2_t);return __builtin_bit_cast(unsigned,b);}
#define WAIT_BAR(N) asm volatile("s_waitcnt vmcnt(" #N ") lgkmcnt(0)\n\ts_barrier":::"memory")

__device__ __forceinline__ void qkt(f32x16&p0,f32x16&p1,const char*Kslot,const bf16x8*qr,const f32x16&negm,int r32,int hi){
  const char*kb=Kslot+hi*1024+r32*16;
  #pragma unroll
  for(int d0=0;d0<4;++d0){
    const bf16x8 b0=*reinterpret_cast<const bf16x8*>(kb+d0*2048);
    const bf16x8 b1=*reinterpret_cast<const bf16x8*>(kb+d0*2048+512);
    if(d0==0){p0=__builtin_amdgcn_mfma_f32_32x32x16_bf16(b0,qr[0],negm,0,0,0);p1=__builtin_amdgcn_mfma_f32_32x32x16_bf16(b1,qr[0],negm,0,0,0);}
    else{p0=__builtin_amdgcn_mfma_f32_32x32x16_bf16(b0,qr[d0],p0,0,0,0);p1=__builtin_amdgcn_mfma_f32_32x32x16_bf16(b1,qr[d0],p1,0,0,0);}}
}
typedef __attribute__((address_space(3))) const char* lds_cptr;
typedef short v4i16_t __attribute__((ext_vector_type(4)));
__device__ __forceinline__ void kload8(bf16x8*kf,lds_cptr kp){
  kf[0]=*(const __attribute__((address_space(3))) bf16x8*)(kp);      kf[1]=*(const __attribute__((address_space(3))) bf16x8*)(kp+512);
  kf[2]=*(const __attribute__((address_space(3))) bf16x8*)(kp+2048); kf[3]=*(const __attribute__((address_space(3))) bf16x8*)(kp+2560);
  kf[4]=*(const __attribute__((address_space(3))) bf16x8*)(kp+4096); kf[5]=*(const __attribute__((address_space(3))) bf16x8*)(kp+4608);
  kf[6]=*(const __attribute__((address_space(3))) bf16x8*)(kp+6144); kf[7]=*(const __attribute__((address_space(3))) bf16x8*)(kp+6656);
}
__device__ __forceinline__ void kload2(bf16x8*kf,lds_cptr kp,int j){ kf[2*j]=*(const __attribute__((address_space(3))) bf16x8*)(kp+j*2048); kf[2*j+1]=*(const __attribute__((address_space(3))) bf16x8*)(kp+j*2048+512); }
__device__ __forceinline__ s16x4 vtr(lds_cptr p){ return __builtin_bit_cast(s16x4,__builtin_amdgcn_ds_read_tr16_b64_v4i16((__attribute__((address_space(3))) v4i16_t*)p)); }
__device__ __forceinline__ float rowmax(const f32x16&p0,const f32x16&p1){
  float a=max3f(p0[0],p0[1],p1[0]),b=max3f(p0[2],p0[3],p1[1]);a=max3f(a,p1[2],p1[3]);
  #pragma unroll
  for(int r=4;r<16;r+=4){a=max3f(a,p0[r],p0[r+1]);b=max3f(b,p0[r+2],p0[r+3]);a=max3f(a,p1[r],p1[r+1]);b=max3f(b,p1[r+2],p1[r+3]);}
  const float m=max2f(a,b);
  auto rr=__builtin_amdgcn_permlane32_swap(__float_as_uint(m),__float_as_uint(m),false,false);
  return max2f(__uint_as_float(rr[0]),__uint_as_float(rr[1]));
}
__device__ __forceinline__ void pv(f32x16*o,int vb,bf16x8 pa0,bf16x8 pa1,bf16x8 pa2,bf16x8 pa3){
  #pragma unroll
  for(int d0=0;d0<2;++d0){s16x4 lo[4],hi[4];
    #pragma unroll
    for(int ks=0;ks<4;++ks){
      asm volatile("ds_read_b64_tr_b16 %0,%1 offset:%c2":"=&v"(lo[ks]):"v"(vb),"i"(d0*4096+ks*1024):"memory");
      asm volatile("ds_read_b64_tr_b16 %0,%1 offset:%c2":"=&v"(hi[ks]):"v"(vb),"i"(d0*4096+ks*1024+512):"memory");}
    asm volatile("s_waitcnt lgkmcnt(0)":::"memory");SBAR();
    #define PK(k) (bf16x8){lo[k][0],lo[k][1],lo[k][2],lo[k][3],hi[k][0],hi[k][1],hi[k][2],hi[k][3]}
    o[d0]=__builtin_amdgcn_mfma_f32_32x32x16_bf16(pa0,PK(0),o[d0],0,0,0);
    o[d0]=__builtin_amdgcn_mfma_f32_32x32x16_bf16(pa1,PK(1),o[d0],0,0,0);
    o[d0]=__builtin_amdgcn_mfma_f32_32x32x16_bf16(pa2,PK(2),o[d0],0,0,0);
    o[d0]=__builtin_amdgcn_mfma_f32_32x32x16_bf16(pa3,PK(3),o[d0],0,0,0);
    #undef PK
  }
}

#ifndef ATTN_STORE16
#define ATTN_STORE16(p,v) (*(u32x4*)(p)=(v))
#endif
__device__ __forceinline__ void swamask(f32x16&p0,f32x16&p1,int kvrel,int qrel,int hi){
  const float NEG=-INFINITY; const int kb=kvrel+4*hi-qrel;
  #pragma unroll
  for(int r=0;r<16;++r){int dl=kb+(r&3)+8*(r>>2); if(dl>128||dl<-128)p0[r]=NEG; if(dl+32>128||dl+32<-128)p1[r]=NEG;}
}
template<int THRL,int MODE> __device__ __forceinline__ void attn_unit(const bf16*Qb,int qp,const bf16*__restrict__ Kh,int kp,const bf16*__restrict__ Vh,int vp,bf16*Ob,int op,int q0,float sink_l2,char*shm,int kv0=0,float*stats=nullptr,bool primed=false,bool prime_next=false){
  int tid_l=threadIdx.x; asm volatile("":"+v"(tid_l));
  const int tid=tid_l,lane=tid&63,r32=lane&31,hi=lane>>5; const int wid=__builtin_amdgcn_readfirstlane(tid>>6);
  const bf16*Qw=Qb+(long)(q0+wid*QBLK)*qp;
  const unsigned ord=(MODE==1)?((q0==0)?0x765243u:((q0==SEQ-QB)?0x015243u:0x70615243u)):0u;
  #define KVS(t) ((MODE==1)?(q0-128+64*(int)((ord>>(4*(t)))&15u)):((MODE==2)?(kv0+64*(t)):(64*(t))))
  const unsigned lds0=(unsigned)(uintptr_t)shm;
  float*wsf=(float*)(shm+LDS_WS)+wid*64;
  const bf16*ksrc=Kh+(long)lane*kp+wid*8;
  const bf16*vsrc=Vh+(long)(16*(wid&3)+(lane>>2))*vp+(wid>>2)*32+(lane&3)*8;
  const unsigned kdst=lds0+LDS_K+wid*1024, vdst=lds0+LDS_V+wid*1024;
  #define DMA_K(t,slot) glds16(ksrc+(long)KVS(t)*kp,(unsigned)__builtin_amdgcn_readfirstlane(kdst+(slot)))
  #define DMA_V(t,slot) glds16(vsrc+(long)KVS(t)*vp,(unsigned)__builtin_amdgcn_readfirstlane(vdst+(slot)))
  const int vb0=(int)(lds0+LDS_V)+((lane>>4)&1)*32+(lane&3)*8+(4*hi+((lane&15)>>2))*64;
  const char*Kbase=shm+LDS_K; bf16x8 kf[8];
  const lds_cptr shm3=(lds_cptr)shm; const lds_cptr kp0=shm3+LDS_K+hi*1024+r32*16; const lds_cptr vp0=shm3+LDS_V+((lane>>4)&1)*32+(lane&3)*8+(4*hi+((lane&15)>>2))*64;
  const int NT=(MODE==1)?((q0==0||q0==SEQ-QB)?6:8):((MODE==2)?(SEQ/KVBLK/4):(SEQ/KVBLK));
  if(!primed){DMA_K(0,0);DMA_V(0,0);DMA_K(1,SLOTB);}
  bf16x8 qr[4];
  #pragma unroll
  for(int d0=0;d0<4;++d0)qr[d0]=*reinterpret_cast<const bf16x8*>(&Qw[(long)r32*qp+d0*16+hi*8]);
  float mhat=0.f,l_reg=0.f;float z0_=0.f;asm volatile("":"+v"(z0_));f32x16 o[2],negm;
  #pragma unroll
  for(int r=0;r<16;++r){o[0][r]=z0_;o[1][r]=z0_;negm[r]=z0_;}
  asm volatile("":"+v"(negm));
  const int qrel=wid*QBLK+r32;
  #define CMASK(P0,P1,t) do{ if constexpr(MODE==1) swamask(P0,P1,KVS(t)-q0,qrel,hi); }while(0)
  bool resc=false;
  #define START(P0,P1) do{ const float rm=rowmax(P0,P1); resc=false; \
    { const float dl=rm; mhat=fadd_s(mhat,dl); \
      _Pragma("unroll") for(int r=0;r<16;++r){P0[r]=fsub_s(P0[r],dl);P1[r]=fsub_s(P1[r],dl);} \
      _Pragma("unroll") for(int r=0;r<16;++r)negm[r]=-mhat; asm volatile("":"+v"(negm)); } \
    _Pragma("unroll") for(int r=0;r<16;++r)P0[r]=__builtin_amdgcn_exp2f(P0[r]); }while(0)
  #define RESC() do{ if(resc){ asm volatile("s_waitcnt lgkmcnt(0)":::"memory"); \
      _Pragma("unroll") for(int d_=0;d_<2;++d_) _Pragma("unroll") for(int r=0;r<16;++r)o[d_][r]*=wsf[crow(r,hi)]; } }while(0)
  f32x16 pA0,pA1,pB0,pB1;
  int sl_prev=0,sl_cur=0,sl_next=SLOTB;
  #define ROT() do{sl_prev=sl_cur;sl_cur=sl_next;sl_next=(sl_next==(NSLOT-1)*SLOTB)?0:sl_next+SLOTB;}while(0)
  DMA_K(2,2*SLOTB);
  WAIT_BAR(3);
  qkt(pA0,pA1,Kbase,qr,negm,r32,hi);asm volatile("s_nop 15\n\ts_nop 7":"+v"(pA0),"+v"(pA1));CMASK(pA0,pA1,0);
  START(pA0,pA1);
  _Pragma("unroll") for(int r=0;r<16;++r)pA1[r]=__builtin_amdgcn_exp2f(pA1[r]);
  WAIT_BAR(0);
  DMA_K(3,0);DMA_V(1,SLOTB);
  ROT();
  kload8(kf,kp0+sl_cur);
  WAIT_BAR(2);
  s16x4 vlo[8],vhi[8]; u32x4 pw0,pw1,pw2,pw3;
  #define PKW(P,B) cvtpk_s(P[B],P[B+1])
  #define PAF(k) __builtin_bit_cast(bf16x8,pw##k)
  #define VFR(i) (bf16x8){vlo[i][0],vlo[i][1],vlo[i][2],vlo[i][3],vhi[i][0],vhi[i][1],vhi[i][2],vhi[i][3]}
  #define PIN(x) asm volatile("":"+v"(x))
  #define MX3(a,b,c) __builtin_fmaxf(__builtin_fmaxf((a),(b)),(c))
  #define GAPA(MF,A0,A1,A2,A3,W0,W1,PW) do{ MF; sacc+=A0; sacc+=A1; sacc+=A2; sacc+=A3; PIN(sacc); W0; W1; PIN(PW); SBAR(); }while(0)
  #define EX(v) __builtin_amdgcn_exp2f(v)
  #define GAPB(MF,X,B) do{ MF; X[B]=EX(X[B]); X[B+1]=EX(X[B+1]); X[B+2]=EX(X[B+2]); X[B+3]=EX(X[B+3]); PIN(X); SBAR(); }while(0)
  #define VRD(i) do{ vlo[i]=vtr(vp_+(((i)>>2)*4096+((i)&3)*1024)); vhi[i]=vtr(vp_+(((i)>>2)*4096+((i)&3)*1024+512)); }while(0)
  #define KRD(G,j) do{ if(G){ kload2(kf,kp0+sl_next,j); SBAR(); } }while(0)
  #define STEP(C0,C1,P0,P1,t,GK,GV,GL) do{ SBAR(); \
    const lds_cptr vp_=vp0+sl_prev; \
    __builtin_amdgcn_s_setprio(1); VRD(0); SBAR(); float sacc=(P0[0]+P0[1]); \
    GAPA(C0=__builtin_amdgcn_mfma_f32_32x32x16_bf16(kf[0],qr[0],negm,0,0,0), P0[2],P0[3],P0[4],P0[5],     pw0[0]=PKW(P0,0), pw0[1]=PKW(P0,2), pw0); \
    VRD(4); SBAR(); GAPA(C1=__builtin_amdgcn_mfma_f32_32x32x16_bf16(kf[1],qr[0],negm,0,0,0), P0[6],P0[7],P0[8],P0[9],     pw0[2]=PKW(P0,4), pw0[3]=PKW(P0,6), pw0); \
    VRD(1); SBAR(); GAPA(C0=__builtin_amdgcn_mfma_f32_32x32x16_bf16(kf[2],qr[1],C0,0,0,0),   P0[10],P0[11],P0[12],P0[13], pw1[0]=PKW(P0,8), pw1[1]=PKW(P0,10), pw1); \
    VRD(5); SBAR(); GAPA(C1=__builtin_amdgcn_mfma_f32_32x32x16_bf16(kf[3],qr[1],C1,0,0,0),   P0[14],P0[15],P1[0],P1[1],   pw1[2]=PKW(P0,12),pw1[3]=PKW(P0,14), pw1); \
    VRD(2); SBAR(); GAPA(C0=__builtin_amdgcn_mfma_f32_32x32x16_bf16(kf[4],qr[2],C0,0,0,0),   P1[2],P1[3],P1[4],P1[5],     pw2[0]=PKW(P1,0), pw2[1]=PKW(P1,2), pw2); \
    VRD(6); SBAR(); GAPA(C1=__builtin_amdgcn_mfma_f32_32x32x16_bf16(kf[5],qr[2],C1,0,0,0),   P1[6],P1[7],P1[8],P1[9],     pw2[2]=PKW(P1,4), pw2[3]=PKW(P1,6), pw2); \
    VRD(3); SBAR(); GAPA(C0=__builtin_amdgcn_mfma_f32_32x32x16_bf16(kf[6],qr[3],C0,0,0,0),   P1[10],P1[11],P1[12],P1[13], pw3[0]=PKW(P1,8), pw3[1]=PKW(P1,10), pw3); \
    VRD(7); SBAR(); GAPA(C1=__builtin_amdgcn_mfma_f32_32x32x16_bf16(kf[7],qr[3],C1,0,0,0),   P1[14],P1[15],0.f,0.f,       pw3[2]=PKW(P1,12),pw3[3]=PKW(P1,14), pw3); \
    l_reg+=sacc; __builtin_amdgcn_s_setprio(0); \
    if(GK){DMA_K((t)+3,sl_cur);} if(GV){DMA_V((t)+1,sl_next);} \
    CMASK(C0,C1,t); \
    { float a=MX3(C0[0],C0[1],C1[0]),b=MX3(C0[2],C0[3],C1[1]); a=MX3(a,C1[2],C1[3]); \
      _Pragma("unroll") for(int r=4;r<16;r+=4){a=MX3(a,C0[r],C0[r+1]);b=MX3(b,C0[r+2],C0[r+3]);a=MX3(a,C1[r],C1[r+1]);b=MX3(b,C1[r+2],C1[r+3]);} \
      float rm=__builtin_fmaxf(a,b); { auto rr=__builtin_amdgcn_permlane32_swap(__float_as_uint(rm),__float_as_uint(rm),false,false); rm=__builtin_fmaxf(__uint_as_float(rr[0]),__uint_as_float(rr[1])); } \
      resc=false; \
      if(__builtin_expect(__any(rm>(float)THRL),0)){ const float dl=__builtin_fmaxf(rm,0.f); mhat+=dl; \
        _Pragma("unroll") for(int r=0;r<16;++r){C0[r]-=dl;C1[r]-=dl;} \
        _Pragma("unroll") for(int r=0;r<16;++r)negm[r]=-mhat; asm volatile("":"+v"(negm)); \
        const float f=__builtin_amdgcn_exp2f(-dl); l_reg*=f; if(hi==0)wsf[r32]=f; resc=true; } } \
    SBAR(); \
    __builtin_amdgcn_s_setprio(1); \
    GAPB(o[0]=__builtin_amdgcn_mfma_f32_32x32x16_bf16(PAF(0),VFR(0),o[0],0,0,0), C0,0); \
    GAPB(o[1]=__builtin_amdgcn_mfma_f32_32x32x16_bf16(PAF(0),VFR(4),o[1],0,0,0), C0,4); \
    KRD(GL,0); GAPB(o[0]=__builtin_amdgcn_mfma_f32_32x32x16_bf16(PAF(1),VFR(1),o[0],0,0,0), C0,8); \
    KRD(GL,1); GAPB(o[1]=__builtin_amdgcn_mfma_f32_32x32x16_bf16(PAF(1),VFR(5),o[1],0,0,0), C0,12); \
    KRD(GL,2); GAPB(o[0]=__builtin_amdgcn_mfma_f32_32x32x16_bf16(PAF(2),VFR(2),o[0],0,0,0), C1,0); \
    KRD(GL,3); GAPB(o[1]=__builtin_amdgcn_mfma_f32_32x32x16_bf16(PAF(2),VFR(6),o[1],0,0,0), C1,4); \
    GAPB(o[0]=__builtin_amdgcn_mfma_f32_32x32x16_bf16(PAF(3),VFR(3),o[0],0,0,0), C1,8); \
    GAPB(o[1]=__builtin_amdgcn_mfma_f32_32x32x16_bf16(PAF(3),VFR(7),o[1],0,0,0), C1,12); \
    __builtin_amdgcn_s_setprio(0); \
    }while(0)
  int t=1;
  for(;t+5<NT;t+=2){
    STEP(pB0,pB1,pA0,pA1,t,true,true,true);     WAIT_BAR(2); RESC(); ROT();
    STEP(pA0,pA1,pB0,pB1,t+1,true,true,true);   WAIT_BAR(2); RESC(); ROT();
  }
  #undef CMASK
  #define CMASK(P0,P1,t) do{ if constexpr(MODE==1) swamask(P0,P1,KVS(t)-q0,qrel,hi); }while(0)
  #define ENDW(tt) do{ if((tt)+3<NT){WAIT_BAR(2);} else if((tt)+2<NT){WAIT_BAR(1);} else {WAIT_BAR(0);} }while(0)
  for(;t+1<NT;t+=2){
    STEP(pB0,pB1,pA0,pA1,t,(t+3<NT),(t+1<NT),(t+1<NT));       ENDW(t);   RESC(); ROT();
    STEP(pA0,pA1,pB0,pB1,t+1,(t+4<NT),(t+2<NT),(t+2<NT));     ENDW(t+1); RESC(); ROT();
  }
  STEP(pB0,pB1,pA0,pA1,NT-1,false,false,false); RESC();
  { float sacc=pB0[0]+pB0[1]; _Pragma("unroll") for(int r=2;r<16;++r)sacc+=pB0[r]; _Pragma("unroll") for(int r=0;r<16;++r)sacc+=pB1[r]; l_reg+=sacc;
    pw0=(u32x4){PKW(pB0,0),PKW(pB0,2),PKW(pB0,4),PKW(pB0,6)};pw1=(u32x4){PKW(pB0,8),PKW(pB0,10),PKW(pB0,12),PKW(pB0,14)};pw2=(u32x4){PKW(pB1,0),PKW(pB1,2),PKW(pB1,4),PKW(pB1,6)};pw3=(u32x4){PKW(pB1,8),PKW(pB1,10),PKW(pB1,12),PKW(pB1,14)};
    SBAR(); pv(o,vb0+sl_cur,PAF(0),PAF(1),PAF(2),PAF(3)); }
  #undef PKW
  #undef PAF
  #undef VFR
  #undef PIN
  #undef MX3
  #undef GAPA
  #undef GAPB
  #undef EX
  #undef VRD
  #undef KRD
  #undef STEP
  #undef ENDW
  asm volatile("s_waitcnt lgkmcnt(0)\n\ts_barrier":::"memory");
  if(prime_next){DMA_K(0,0);DMA_V(0,0);DMA_K(1,SLOTB);}
  {auto rr=__builtin_amdgcn_permlane32_swap(__float_as_uint(l_reg),__float_as_uint(l_reg),false,false);l_reg=__uint_as_float(rr[0])+__uint_as_float(rr[1]);}
  if constexpr(MODE==1) l_reg+=__builtin_amdgcn_exp2f(sink_l2-mhat);
  if constexpr(MODE==2){ if(hi==0){ float*sp=stats+2*(long)(q0+wid*QBLK+r32); sp[0]=mhat; sp[1]=l_reg; } }
  if(hi==0)wsf[32+r32]=l_reg;asm volatile("s_waitcnt lgkmcnt(0)":::"memory");
  float rli[16];
  #pragma unroll
  for(int r=0;r<16;++r)rli[r]=__builtin_amdgcn_rcpf(wsf[32+crow(r,hi)]);
  bf16*Ow=Ob+(long)(q0+wid*QBLK)*op;
  { bf16*stg=(bf16*)(shm+LDS_OST)+wid*2048;
    #pragma unroll
    for(int r=0;r<16;++r){const int orow=crow(r,hi);
      #pragma unroll
      for(int d0=0;d0<2;++d0)stg[orow*64+d0*32+r32]=__float2bfloat16(o[d0][r]*rli[r]);}
    asm volatile("s_waitcnt lgkmcnt(0)":::"memory");
    #pragma unroll
    for(int i=0;i<4;++i){const int row=i*8+(lane>>3),ch=lane&7; const u32x4 v=*(const u32x4*)(stg+row*64+ch*8); ATTN_STORE16(Ow+(long)row*op+ch*8,v);} }
  asm volatile("s_waitcnt lgkmcnt(0)\n\ts_barrier":::"memory");
  #undef DMA_K
  #undef KVS
  #undef DMA_V
  #undef CMASK
  #undef START
  #undef RESC
  #undef ROT
}
constexpr int ATTN_LDS_BYTES=LDS_BYTES;
#undef SBAR
#undef WAIT_BAR
}
#include <hip/hip_cooperative_groups.h>
namespace cg = cooperative_groups;
#define LAS __attribute__((address_space(3)))
#define GAS __attribute__((address_space(1)))
typedef unsigned short bf16;
typedef unsigned v4u __attribute__((ext_vector_type(4)));
typedef unsigned v2u __attribute__((ext_vector_type(2)));
typedef float f32x4 __attribute__((ext_vector_type(4)));
typedef float f32x16 __attribute__((ext_vector_type(16)));
typedef short bf16x8 __attribute__((ext_vector_type(8)));
constexpr int NWAVES = 8, NTHR = 512;
constexpr int DMODEL = 1024, SEQ = 8192, MG = 2 * SEQ, NGRP = 3, DEPTH = 2, INC = 3088, NPROJ = 3072, DFF = 4096;
constexpr float EPS = 1e-6f;
constexpr float LOG2E = 1.4426950408889634f;
constexpr size_t MiB = 1u << 20;
constexpr size_t WS_ROPE = 1 * MiB;
constexpr size_t WS_WIN = 4 * MiB, WS_WOUT = 16 * MiB, WS_WUP = 20 * MiB, WS_WDN = 36 * MiB;
constexpr size_t WS_HN = 52 * MiB, WS_DNRAW = 84 * MiB, WS_Z = 108 * MiB, WS_DFQ = 116 * MiB, WS_DFK = 132 * MiB, WS_DFV = 148 * MiB;
constexpr size_t WS_SWQ = 164 * MiB, WS_SWKV = 172 * MiB, WS_BG = 180 * MiB, WS_GS = 181 * MiB;
constexpr size_t WS_QS = 182 * MiB, WS_KS = 198 * MiB, WS_KT = 214 * MiB, WS_U = 230 * MiB, WS_W = 246 * MiB;
constexpr size_t WS_ODN = 262 * MiB, WS_ODF = 294 * MiB, WS_MIX = 326 * MiB, WS_HID = 358 * MiB, WS_END = 486 * MiB;
constexpr size_t WS_WL = 3 * MiB;
constexpr size_t WS_SS2 = 497 * MiB;
constexpr size_t WS_SS = 496 * MiB;
constexpr size_t WS_PO = 486 * MiB, WS_PS = 494 * MiB;
constexpr int LDS_BYTES = 147456;
static_assert(WS_DNRAW == 84 * MiB && WS_Z == 108 * MiB && WS_DFQ == 116 * MiB && WS_DFK == 132 * MiB && WS_DFV == 148 * MiB && WS_SWQ == 164 * MiB && WS_SWKV == 172 * MiB, "EpiProj offsets");

__device__ __forceinline__ float bf2f(unsigned short b) { return __uint_as_float((unsigned)b << 16); }
__device__ __forceinline__ unsigned f2bf(float f) { unsigned u = __builtin_bit_cast(unsigned, f); return (u + 0x7fffu + ((u >> 16) & 1u)) >> 16; }
typedef float f32x2_ __attribute__((ext_vector_type(2))); typedef __bf16 bf16x2_ __attribute__((ext_vector_type(2)));
__device__ __forceinline__ unsigned pk2(float lo, float hi) { f32x2_ v = {lo, hi}; bf16x2_ b = __builtin_convertvector(v, bf16x2_); return __builtin_bit_cast(unsigned, b); }
__device__ __forceinline__ float shx(float v, int o, int lane) { return __int_as_float(__builtin_amdgcn_ds_bpermute((lane ^ o) << 2, __float_as_int(v))); }
__device__ __forceinline__ float wave_sum(float v, int lane) {
#pragma unroll
    for (int o = 1; o < 64; o <<= 1) v += shx(v, o, lane);
    return v;
}
#define MFMA32(a, b, c) __builtin_amdgcn_mfma_f32_32x32x16_bf16((a), (b), (c), 0, 0, 0)
__device__ __forceinline__ int crow(int r, int hi) { return (r & 3) + 8 * (r >> 2) + 4 * hi; }
__device__ __forceinline__ bf16x8 pack8(const f32x16& x, int s) {
    v4u p; p.x = pk2(x[8 * s], x[8 * s + 1]); p.y = pk2(x[8 * s + 2], x[8 * s + 3]); p.z = pk2(x[8 * s + 4], x[8 * s + 5]); p.w = pk2(x[8 * s + 6], x[8 * s + 7]);
    return __builtin_bit_cast(bf16x8, p);
}

#define XB_TMO      128
#define XB_XCNT(j)  (256  + 64 * (j))
#define XB_XSUB(j)  (1280 + 64 * (j))
#define XB_XGEN(j)  (2304 + 64 * (j))
#define XB_TOP      3328
#define XB_TOPGEN   3392
#define XCD_BAR_WORDS 3456
#define XB_SPIN_CAP (1u << 18)

__device__ __forceinline__ unsigned xb_ld(unsigned* p)              { return __hip_atomic_load(p, __ATOMIC_RELAXED, __HIP_MEMORY_SCOPE_AGENT); }
__device__ __forceinline__ unsigned xb_add(unsigned* p, unsigned v) { return __hip_atomic_fetch_add(p, v, __ATOMIC_RELAXED, __HIP_MEMORY_SCOPE_AGENT); }
__device__ __forceinline__ unsigned xb_xcc_id() { return (unsigned)__builtin_amdgcn_s_getreg((3 << 11) | 20) & 0xFu; }
#define XB_SPIN(cond, bar) do { unsigned _sp = 0; while (cond) { __builtin_amdgcn_s_sleep(1); \
    if ((++_sp & 255u) == 0u) { if (xb_ld(&(bar)[XB_TMO])) break; if (_sp > XB_SPIN_CAP) { atomicAdd(&(bar)[XB_TMO], 1u); break; } } } } while (0)

struct XcdBarrier {
    unsigned* bar; unsigned x;
    volatile LAS unsigned* st;
};

__device__ __forceinline__ XcdBarrier xcd_barrier_post(unsigned* bar, volatile LAS unsigned* st) {
    XcdBarrier b; b.bar = bar; b.x = xb_xcc_id(); b.st = st;
    if (threadIdx.x == 0) (void)xb_add(&bar[XB_XCNT(b.x)], 1u);
    return b;
}
__device__ __forceinline__ void xcd_barrier_complete(unsigned* bar, unsigned x, unsigned& nloc, unsigned& nx) {
    const unsigned G = gridDim.x * gridDim.y * gridDim.z;
    unsigned sum, cnt, mine, sp = 0u;
    for (;;) {
        sum = 0u; cnt = 0u; mine = 0u;
#pragma unroll
        for (unsigned j = 0; j < 16; ++j) { const unsigned c = xb_ld(&bar[XB_XCNT(j)]); sum += c; cnt += (c > 0u) ? 1u : 0u; mine = (j == x) ? c : mine; }
        if (sum == G) break;
        __builtin_amdgcn_s_sleep(1);
        if ((++sp & 255u) == 0u) { if (xb_ld(&bar[XB_TMO])) break; if (sp > XB_SPIN_CAP) { atomicAdd(&bar[XB_TMO], 1u); break; } }
    }
    nloc = mine > 0u ? mine : 1u; nx = cnt > 0u ? cnt : 1u;
}

__device__ __forceinline__ void xcd_barrier(const XcdBarrier& b) {
    asm volatile("s_waitcnt vmcnt(0)" ::: "memory");
    __syncthreads();
    if (threadIdx.x == 0) {
        unsigned* bar = b.bar;
        __builtin_amdgcn_s_waitcnt(0);
        unsigned nloc = b.st[0], nx = b.st[1];
        if (nloc == 0u) { xcd_barrier_complete(bar, b.x, nloc, nx); b.st[0] = nloc; b.st[1] = nx; }
        const unsigned old = xb_add(&bar[XB_XSUB(b.x)], 1u);
        const unsigned gen = old / nloc;
        if (old + 1u == (gen + 1u) * nloc) {
            __builtin_amdgcn_fence(__ATOMIC_RELEASE, "agent");
            asm volatile("s_waitcnt vmcnt(0)" ::: "memory");
            const unsigned og = xb_add(&bar[XB_TOP], 1u);
            const unsigned tg = og / nx;
            if (og + 1u == (tg + 1u) * nx) xb_add(&bar[XB_TOPGEN], 1u);
            else XB_SPIN(xb_ld(&bar[XB_TOPGEN]) == tg, bar);
            __builtin_amdgcn_fence(__ATOMIC_ACQUIRE, "agent");
            xb_add(&bar[XB_XGEN(b.x)], 1u);
            asm volatile("s_waitcnt vmcnt(0)" ::: "memory");
        } else {
            XB_SPIN(xb_ld(&bar[XB_XGEN(b.x)]) == gen, bar);
            __builtin_amdgcn_fence(__ATOMIC_ACQUIRE, "agent");
            asm volatile("s_waitcnt vmcnt(0)" ::: "memory");
        }
    }
    __syncthreads();
}

struct Ctx {
    LAS unsigned char* lds; unsigned char* ldsg;
    int tid, lane, wave, vcu, G, bx;
    unsigned char* ws;
};

__device__ __forceinline__ void transpose_item(const float* W, int K, int Nsrc, bf16* WT, int nblk, int item, int skip_from, int skip, LAS float* scr, int lane, const float* kscale = nullptr) {
    const int kb = item / nblk, nb = item % nblk, k0 = 64 * kb, n0 = 32 * nb, c0 = n0 + (n0 >= skip_from ? skip : 0);
    { const int kk0 = lane >> 3, c4 = (lane & 7) * 4;
      f32x4 v[8];
#pragma unroll
      for (int i = 0; i < 8; ++i) v[i] = *(const f32x4*)(W + (size_t)(k0 + kk0 + 8 * i) * Nsrc + c0 + c4);
#pragma unroll
      for (int i = 0; i < 8; ++i) { const int kk = kk0 + 8 * i; const float sc = kscale ? kscale[k0 + kk] : 1.f; LAS float* d = scr + kk * 33 + c4; d[0] = v[i].x * sc; d[1] = v[i].y * sc; d[2] = v[i].z * sc; d[3] = v[i].w * sc; } }
    asm volatile("s_waitcnt lgkmcnt(0)" ::: "memory");
    const int c = lane & 7;
#pragma unroll
    for (int j = 0; j < 4; ++j) { const int n = (lane >> 3) + 8 * j; const LAS float* s = scr + (8 * c) * 33 + n;
        v4u o; o.x = pk2(s[0 * 33], s[1 * 33]); o.y = pk2(s[2 * 33], s[3 * 33]); o.z = pk2(s[4 * 33], s[5 * 33]); o.w = pk2(s[6 * 33], s[7 * 33]);
        *(v4u*)(WT + (size_t)(n0 + n) * K + k0 + 8 * c) = o; }
    asm volatile("s_waitcnt lgkmcnt(0)" ::: "memory");
}

__device__ __forceinline__ void phase_prologue(Ctx& C, const float* w_in, const float* w_out, const float* w_up, const float* w_dn, const float* n2w, const float* n1w) {
    LAS float* scr = (LAS float*)(C.lds + C.wave * 16384);
    const int gw = C.vcu * NWAVES + C.wave, NGW = C.G * NWAVES;
    constexpr int I_IN = (DMODEL / 64) * (NPROJ / 32), I_OUT = (DMODEL / 64) * (DMODEL / 32), I_UP = (DMODEL / 64) * (DFF / 32), I_DN = (DFF / 64) * (DMODEL / 32);
    constexpr int PER = I_IN + I_OUT + I_UP + I_DN;
    for (int it = gw; it < DEPTH * PER; it += NGW) {
        const int l = it / PER; int r = it % PER;
        if (r < I_IN) { transpose_item(w_in + (size_t)l * DMODEL * INC, DMODEL, INC, (bf16*)(C.ws + WS_WIN) + (size_t)l * NPROJ * DMODEL, NPROJ / 32, r, 1024, 16, scr, C.lane, l ? n1w + DMODEL : nullptr); continue; } r -= I_IN;
        if (r < I_OUT) { transpose_item(w_out + (size_t)l * DMODEL * DMODEL, DMODEL, DMODEL, (bf16*)(C.ws + WS_WOUT) + (size_t)l * DMODEL * DMODEL, DMODEL / 32, r, 1 << 30, 0, scr, C.lane); continue; } r -= I_OUT;
        if (r < I_UP) { transpose_item(w_up + (size_t)l * DMODEL * DFF, DMODEL, DFF, (bf16*)(C.ws + WS_WUP) + (size_t)l * DFF * DMODEL, DFF / 32, r, 1 << 30, 0, scr, C.lane, n2w + l * DMODEL); continue; } r -= I_UP;
        transpose_item(w_dn + (size_t)l * DFF * DMODEL, DFF, DMODEL, (bf16*)(C.ws + WS_WDN) + (size_t)l * DMODEL * DFF, DMODEL / 32, r, 1 << 30, 0, scr, C.lane);
    }
    for (int e = C.vcu * NTHR + C.tid; e < DEPTH * 32 * DMODEL; e += C.G * NTHR) { const int k = e & (DMODEL - 1), o = (e >> 10) & 31, l = e >> 15;
        const float v = (o < 16) ? w_in[(size_t)l * DMODEL * INC + (size_t)k * INC + 1024 + o] * (l ? n1w[DMODEL + k] : 1.f) : 0.f;
        ((bf16*)(C.ws + WS_WL))[e] = (bf16)(pk2(v, 0.f) & 0xffffu); }
    float* cosT = (float*)(C.ws + WS_ROPE); float* sinT = cosT + SEQ * 32;
    for (int e = C.vcu * NTHR + C.tid; e < SEQ * 32; e += C.G * NTHR) {
        const int pos = e >> 5, i = e & 31;
        const double inv = exp(-(double)i * (9.210340371976184 / 32.0));
        double rev = (double)pos * inv * 0.15915494309189535;
        rev -= floor(rev);
        const float fr = (float)rev;
        cosT[e] = __builtin_amdgcn_cosf(fr); sinT[e] = __builtin_amdgcn_sinf(fr);
    }
}

template <bool LOGITS>
__device__ __forceinline__ void phase_norm(Ctx& C, const float* x, const float* nw, bf16* hn, const float* w_in_l, float* bg) {
    LAS float* wl = (LAS float*)C.lds;
    if (LOGITS) {
        for (int e = C.tid; e < DMODEL * 16; e += NTHR) { const int k = e >> 4, o = e & 15;
            wl[(((((k >> 8) * 4 + (k & 3)) * 4 + (o >> 2)) * 64 + ((k >> 2) & 63)) * 4) + (o & 3)] = w_in_l[(size_t)k * INC + 1024 + o]; }
        __syncthreads();
    }
    const int gw = C.vcu * NWAVES + C.wave, NGW = C.G * NWAVES;
    f32x4 wv[4];
#pragma unroll
    for (int j = 0; j < 4; ++j) wv[j] = ((const f32x4*)nw)[C.lane + 64 * j];
    f32x4 v[4];
    { const f32x4* xr = (const f32x4*)(x + (size_t)gw * DMODEL) + C.lane;
#pragma unroll
      for (int j = 0; j < 4; ++j) v[j] = xr[64 * j]; }
    for (int m = gw; m < MG; m += NGW) {
        f32x4 vn[4]; { const int mn = (m + NGW < MG) ? m + NGW : m; const f32x4* xr = (const f32x4*)(x + (size_t)mn * DMODEL) + C.lane;
#pragma unroll
          for (int j = 0; j < 4; ++j) vn[j] = xr[64 * j]; }
        float s = 0.f;
#pragma unroll
        for (int j = 0; j < 4; ++j) s += (v[j].x * v[j].x + v[j].y * v[j].y) + (v[j].z * v[j].z + v[j].w * v[j].w);
        const float rstd = 1.f / sqrtf(wave_sum(s, C.lane) * (1.f / DMODEL) + EPS);
        unsigned long long* o8 = (unsigned long long*)(hn + (size_t)m * DMODEL) + C.lane;
#pragma unroll
        for (int j = 0; j < 4; ++j) { v[j] = v[j] * rstd * wv[j]; o8[64 * j] = (unsigned long long)pk2(v[j].x, v[j].y) | ((unsigned long long)pk2(v[j].z, v[j].w) << 32); }
        if (LOGITS) {
            float acc[16];
#pragma unroll
            for (int o = 0; o < 16; ++o) acc[o] = 0.f;
#pragma unroll
            for (int j = 0; j < 4; ++j)
#pragma unroll
                for (int e = 0; e < 4; ++e) { const int k = 4 * C.lane + 256 * j + e; const float hv = v[j][e];
#pragma unroll
                    for (int o4 = 0; o4 < 4; ++o4) { const f32x4 w4 = *(const LAS f32x4*)(wl + ((((j * 4 + e) * 4 + o4) * 64 + C.lane) * 4)); acc[4 * o4] += hv * w4.x; acc[4 * o4 + 1] += hv * w4.y; acc[4 * o4 + 2] += hv * w4.z; acc[4 * o4 + 3] += hv * w4.w; } }
            float mine = 0.f;
#pragma unroll
            for (int o = 0; o < 16; ++o) { const float t = wave_sum(acc[o], C.lane); if (C.lane == o) mine = t; }
            if (C.lane < 16) bg[(size_t)m * 16 + C.lane] = mine;
        }
#pragma unroll
        for (int j = 0; j < 4; ++j) v[j] = vn[j];
    }
    if (LOGITS) __syncthreads();
}

__device__ __forceinline__ void phase_logits(Ctx& C, const bf16* A, const bf16* WL, const float* ss, float* bg) {
    if (C.wave < 2) {
        const int r32 = C.lane & 31, hi = C.lane >> 5, row0 = (C.wave * 256 + C.vcu) * 32;
        const GAS bf16* ap = (const GAS bf16*)A + (size_t)(row0 + r32) * DMODEL + 8 * hi; const GAS bf16* bp = (const GAS bf16*)WL + (size_t)r32 * DMODEL + 8 * hi;
        f32x16 acc = f32x16{};
        for (int k0 = 0; k0 < DMODEL; k0 += 128) {
            bf16x8 af[8], bf_[8];
#pragma unroll
            for (int j = 0; j < 8; ++j) { af[j] = *(const GAS bf16x8*)(ap + k0 + 16 * j); bf_[j] = *(const GAS bf16x8*)(bp + k0 + 16 * j); }
#pragma unroll
            for (int j = 0; j < 8; ++j) acc = MFMA32(af[j], bf_[j], acc);
        }
        if (r32 < 16) {
#pragma unroll
            for (int r = 0; r < 16; ++r) { const int row = row0 + crow(r, hi); const float rs = ss ? pg8::row_rstd(ss, row) : 1.0f; bg[(size_t)row * 16 + r32] = acc[r] * rs; }
        }
    }
}

__device__ __forceinline__ void phase_final_norm(Ctx& C, float* x, const float* nw) {
    const int gw = C.vcu * NWAVES + C.wave, NGW = C.G * NWAVES;
    f32x4 wv[4];
#pragma unroll
    for (int j = 0; j < 4; ++j) wv[j] = ((const f32x4*)nw)[C.lane + 64 * j];
    for (int m = gw; m < MG; m += 2 * NGW) {
        f32x4* xa = (f32x4*)(x + (size_t)m * DMODEL) + C.lane; f32x4* xb = (f32x4*)(x + (size_t)(m + NGW) * DMODEL) + C.lane;
        f32x4 va[4], vb[4]; float sa = 0.f, sb = 0.f;
#pragma unroll
        for (int j = 0; j < 4; ++j) { va[j] = xa[64 * j]; vb[j] = xb[64 * j]; }
#pragma unroll
        for (int j = 0; j < 4; ++j) { sa += (va[j].x * va[j].x + va[j].y * va[j].y) + (va[j].z * va[j].z + va[j].w * va[j].w); sb += (vb[j].x * vb[j].x + vb[j].y * vb[j].y) + (vb[j].z * vb[j].z + vb[j].w * vb[j].w); }
        const float ra = 1.f / sqrtf(wave_sum(sa, C.lane) * (1.f / DMODEL) + EPS), rb = 1.f / sqrtf(wave_sum(sb, C.lane) * (1.f / DMODEL) + EPS);
#pragma unroll
        for (int j = 0; j < 4; ++j) { xa[64 * j] = va[j] * ra * wv[j]; xb[64 * j] = vb[j] * rb * wv[j]; }
    }
}

__device__ __forceinline__ void phase_rope(Ctx& C) {
    const float* cosT = (const float*)(C.ws + WS_ROPE); const float* sinT = cosT + SEQ * 32;
    const int total = MG * 22 * 4, T = C.G * NTHR;
    for (int it0 = C.vcu * NTHR + C.tid; it0 < total; it0 += 4 * T) {
        bf16* p[4]; float sc[4]; v4u a[4], b[4]; f32x4 c0[4], c1[4], s0[4], s1[4]; bool ok[4];
#pragma unroll
        for (int u = 0; u < 4; ++u) {
            const int it = it0 + u * T; ok[u] = it < total; const int itc = ok[u] ? it : it0;
            const int i8 = itc & 3, grp = (itc >> 2) % 22, row = (itc >> 2) / 22, pos = row & (SEQ - 1);
            sc[u] = 1.f;
            if (grp < 8) { p[u] = (bf16*)(C.ws + WS_DFQ) + (size_t)row * 512 + grp * 64; sc[u] = 0.125f * LOG2E; }
            else if (grp < 16) { p[u] = (bf16*)(C.ws + WS_DFK) + (size_t)row * 512 + (grp - 8) * 64; }
            else if (grp < 20) { p[u] = (bf16*)(C.ws + WS_SWQ) + (size_t)row * 256 + (grp - 16) * 64; sc[u] = 0.125f * LOG2E; }
            else { p[u] = (bf16*)(C.ws + WS_SWKV) + (size_t)row * 256 + (grp - 20) * 64; }
            p[u] += i8 * 8;
            a[u] = *(const v4u*)(p[u]); b[u] = *(const v4u*)(p[u] + 32);
            c0[u] = *(const f32x4*)(cosT + pos * 32 + i8 * 8); c1[u] = *(const f32x4*)(cosT + pos * 32 + i8 * 8 + 4);
            s0[u] = *(const f32x4*)(sinT + pos * 32 + i8 * 8); s1[u] = *(const f32x4*)(sinT + pos * 32 + i8 * 8 + 4);
        }
#pragma unroll
        for (int u = 0; u < 4; ++u) {
            v4u oa, ob;
#pragma unroll
            for (int w = 0; w < 4; ++w) {
                const float x1l = __uint_as_float(a[u][w] << 16), x1h = __uint_as_float(a[u][w] & 0xffff0000u), x2l = __uint_as_float(b[u][w] << 16), x2h = __uint_as_float(b[u][w] & 0xffff0000u);
                const float cl = (w < 2) ? c0[u][2 * w] : c1[u][2 * w - 4], ch = (w < 2) ? c0[u][2 * w + 1] : c1[u][2 * w - 3];
                const float sl = (w < 2) ? s0[u][2 * w] : s1[u][2 * w - 4], sh = (w < 2) ? s0[u][2 * w + 1] : s1[u][2 * w - 3];
                oa[w] = pk2((x1l * cl - x2l * sl) * sc[u], (x1h * ch - x2h * sh) * sc[u]);
                ob[w] = pk2((x2l * cl + x1l * sl) * sc[u], (x2h * ch + x1h * sh) * sc[u]);
            }
            if (ok[u]) { *(v4u*)(p[u]) = oa; *(v4u*)(p[u] + 32) = ob; }
        }
    }
}

__device__ __forceinline__ void rope_span(Ctx& C, int beg, int end, int t, int nthr) {
    const float* cosT = (const float*)(C.ws + WS_ROPE); const float* sinT = cosT + SEQ * 32;
    for (int it0 = beg + t; it0 < end; it0 += 2 * nthr) {
        bf16* p[2]; float sc[2]; v4u a[2], b[2]; f32x4 c0[2], c1[2], s0[2], s1[2]; bool ok[2];
#pragma unroll
        for (int u = 0; u < 2; ++u) {
            const int it = it0 + u * nthr; ok[u] = it < end; const int itc = ok[u] ? it : it0;
            const int i8 = itc & 3, grp = (itc >> 2) % 22, row = (itc >> 2) / 22, pos = row & (SEQ - 1);
            sc[u] = 1.f;
            if (grp < 8) { p[u] = (bf16*)(C.ws + WS_DFQ) + (size_t)row * 512 + grp * 64; sc[u] = 0.125f * LOG2E; }
            else if (grp < 16) { p[u] = (bf16*)(C.ws + WS_DFK) + (size_t)row * 512 + (grp - 8) * 64; }
            else if (grp < 20) { p[u] = (bf16*)(C.ws + WS_SWQ) + (size_t)row * 256 + (grp - 16) * 64; sc[u] = 0.125f * LOG2E; }
            else { p[u] = (bf16*)(C.ws + WS_SWKV) + (size_t)row * 256 + (grp - 20) * 64; }
            p[u] += i8 * 8;
            a[u] = *(const v4u*)(p[u]); b[u] = *(const v4u*)(p[u] + 32);
            c0[u] = *(const f32x4*)(cosT + pos * 32 + i8 * 8); c1[u] = *(const f32x4*)(cosT + pos * 32 + i8 * 8 + 4);
            s0[u] = *(const f32x4*)(sinT + pos * 32 + i8 * 8); s1[u] = *(const f32x4*)(sinT + pos * 32 + i8 * 8 + 4);
        }
#pragma unroll
        for (int u = 0; u < 2; ++u) {
            v4u oa, ob;
#pragma unroll
            for (int w = 0; w < 4; ++w) {
                const float x1l = __uint_as_float(a[u][w] << 16), x1h = __uint_as_float(a[u][w] & 0xffff0000u), x2l = __uint_as_float(b[u][w] << 16), x2h = __uint_as_float(b[u][w] & 0xffff0000u);
                const float cl = (w < 2) ? c0[u][2 * w] : c1[u][2 * w - 4], ch = (w < 2) ? c0[u][2 * w + 1] : c1[u][2 * w - 3];
                const float sl = (w < 2) ? s0[u][2 * w] : s1[u][2 * w - 4], sh = (w < 2) ? s0[u][2 * w + 1] : s1[u][2 * w - 3];
                oa[w] = pk2((x1l * cl - x2l * sl) * sc[u], (x1h * ch - x2h * sh) * sc[u]);
                ob[w] = pk2((x2l * cl + x1l * sl) * sc[u], (x2h * ch + x1h * sh) * sc[u]);
            }
            if (ok[u]) { *(v4u*)(p[u]) = oa; *(v4u*)(p[u] + 32) = ob; }
        }
    }
}

__device__ __forceinline__ void phase_dn_prep(Ctx& C, const float* convw, const float* a_log, const float* dt_bias) {
    constexpr int P = 65;
    LAS float* raw = (LAS float*)C.lds;
    LAS float* KK = raw; LAS float* QK = raw + 64 * P; LAS float* Ld = raw + 2 * 64 * P;
    LAS float* qkv = (LAS float*)(C.lds + 66048);
    LAS float* sm = (LAS float*)(C.lds + 66048 + 49920);
    LAS float* betaT = sm, *gT = sm + 128, *Gs = sm + 256, *bs = sm + 384;
    const bf16* dnraw = (const bf16*)(C.ws + WS_DNRAW); const float* bg = (const float*)(C.ws + WS_BG);
    for (int task = C.vcu; task < 2 * 4 * 128; task += C.G) {
        const int nc = task & 127, h = (task >> 7) & 3, seq = task >> 9, c0 = nc * 64;
        __syncthreads();
        int tid_ = C.tid; asm volatile("" : "+v"(tid_));
        const int tidl = tid_, lanel = tid_ & 63, wavel = __builtin_amdgcn_readfirstlane(tid_ >> 6);
        for (int idx = tidl; idx < 3 * 68 * 8; idx += NTHR) {
            const int c8 = idx & 7, rr = (idx >> 3) % 68, part = (idx >> 3) / 68, t = c0 - 2 + rr;
            v4u v = (v4u){0u, 0u, 0u, 0u};
            if (t >= 0 && t < SEQ) v = *(const v4u*)(dnraw + (size_t)(seq * SEQ + t) * 768 + part * 256 + h * 64 + c8 * 8);
            LAS float* d = raw + (part * 68 + rr) * 64 + c8 * 8;
#pragma unroll
            for (int w = 0; w < 4; ++w) { d[2 * w] = __uint_as_float(v[w] << 16); d[2 * w + 1] = __uint_as_float(v[w] & 0xffff0000u); }
        }
        if (tidl < 128) { const int dir = tidl >> 6, i = tidl & 63; const size_t row = (size_t)(seq * SEQ + c0 + i);
            const float bl = bg[row * 16 + dir * 4 + h], al = bg[row * 16 + 8 + dir * 4 + h] + dt_bias[dir * 4 + h];
            betaT[dir * 64 + i] = 1.f / (1.f + __expf(-bl));
            const float e_ = __expf(-fabsf(al)); const float sp = fmaxf(al, 0.f) + ((e_ < 0.01f) ? e_ * (1.f - e_ * (0.5f - e_ * 0.33333333f)) : __logf(1.f + e_));
            gT[dir * 64 + i] = -__expf(a_log[dir * 4 + h]) * sp; }
        __syncthreads();
        { const int c = tidl & 63, i0 = tidl >> 6;
#pragma unroll
          for (int part = 0; part < 3; ++part) { float cw[5];
#pragma unroll
            for (int j = 0; j < 5; ++j) cw[j] = convw[j * 768 + part * 256 + h * 64 + c];
#pragma unroll
            for (int k = 0; k < 8; ++k) { const int i = i0 + 8 * k; float sacc = 0.f;
#pragma unroll
                for (int j = 0; j < 5; ++j) sacc += raw[(part * 68 + i + j) * 64 + c] * cw[j];
                qkv[(part * 64 + i) * P + c] = sacc / (1.f + __expf(-sacc)); } } }
        if (wavel < 2) { const int dir = wavel, il = lanel, it = dir ? 63 - il : il; float a = gT[dir * 64 + it];
#pragma unroll
            for (int o = 1; o < 64; o <<= 1) { const float t = __int_as_float(__builtin_amdgcn_ds_bpermute(((il - o) & 63) << 2, __float_as_int(a))); if (il >= o) a += t; }
            Gs[dir * 64 + il] = a; bs[dir * 64 + il] = betaT[dir * 64 + it]; }
        __syncthreads();
        if (tidl < 128) { LAS float* r = qkv + tidl * P; float s = 0.f;
            for (int c = 0; c < 64; ++c) s += r[c] * r[c];
            const float sc = 1.f / sqrtf(s + EPS);
            for (int c = 0; c < 64; ++c) r[c] *= sc; }
        __syncthreads();
        { const int r32 = lanel & 31, hi = lanel >> 5, mat = wavel >> 2, it = (wavel >> 1) & 1, mt = wavel & 1;
          const LAS float* ar = qkv + ((mat ? 0 : 64) + r32 + 32 * it) * P + 2 * hi; const LAS float* br = qkv + (64 + r32 + 32 * mt) * P + 2 * hi;
          f32x16 acc = f32x16{};
#pragma unroll
          for (int j = 0; j < 16; ++j) { const float a0 = ar[4 * j], a1 = ar[4 * j + 1], b0 = br[4 * j], b1 = br[4 * j + 1];
              acc = __builtin_amdgcn_mfma_f32_32x32x2f32(a0, b0, acc, 0, 0, 0); acc = __builtin_amdgcn_mfma_f32_32x32x2f32(a1, b1, acc, 0, 0, 0); }
          LAS float* dst = (mat ? QK : KK) + (32 * it) * P + r32 + 32 * mt;
#pragma unroll
          for (int r = 0; r < 16; ++r) dst[((r & 3) + 8 * (r >> 2) + 4 * hi) * P] = acc[r]; }
        __syncthreads();
        for (int idx = tidl; idx < 2 * 64 * 64; idx += NTHR) {
            const int ml = idx & 63, il = (idx >> 6) & 63, dir = idx >> 12;
            const int it = dir ? 63 - il : il, mt = dir ? 63 - ml : ml;
            float v = 0.f;
            if (il > ml) v = bs[dir * 64 + il] * KK[it * P + mt] * __expf(Gs[dir * 64 + il] - Gs[dir * 64 + ml]);
            Ld[idx] = v;
        }
        __syncthreads();
        const int blk0 = ((0 * 2 + seq) * 4 + h) * 128 + nc, blk1 = ((1 * 2 + seq) * 4 + h) * 128 + (127 - nc);
        if (wavel < 4) {
            const int dir = wavel >> 1, col = (wavel & 1) * 64 + lanel;
            unsigned lb = (unsigned)(uintptr_t)(Ld + dir * 4096);
            const LAS float* src = (col < 64) ? (qkv + (2 * 64) * P + col) : (qkv + 64 * P + (col - 64));
            float xs[64];
#pragma unroll
            for (int il = 0; il < 64; ++il) {
                const int it = dir ? 63 - il : il;
                float a = src[it * P] * bs[dir * 64 + il];
                if (col >= 64) a *= __expf(Gs[dir * 64 + il]);
#pragma unroll
                for (int m4 = 0; m4 < (il + 3) / 4; ++m4) { const f32x4 l4 = *(const LAS f32x4*)(uintptr_t)(lb + (il * 64 + 4 * m4) * 4);
                    if (4 * m4 < il) a -= l4.x * xs[4 * m4];
                    if (4 * m4 + 1 < il) a -= l4.y * xs[4 * m4 + 1];
                    if (4 * m4 + 2 < il) a -= l4.z * xs[4 * m4 + 2];
                    if (4 * m4 + 3 < il) a -= l4.w * xs[4 * m4 + 3]; }
                xs[il] = a; if (il & 1) asm volatile("" : "+v"(lb) : "v"(a));
            }
            const int blk = dir ? blk1 : blk0;
            if (col < 64) {
                bf16* U = (bf16*)(C.ws + WS_U) + (size_t)blk * 4096;
                const int et = col >> 5, r32 = col & 31;
#pragma unroll
                for (int mt = 0; mt < 2; ++mt)
#pragma unroll
                    for (int hi = 0; hi < 2; ++hi) { v4u o0, o1;
#pragma unroll
                        for (int q = 0; q < 4; ++q) { const int ra = 2 * q, rb = 2 * q + 1, rc = 8 + 2 * q, rd = 9 + 2 * q;
                            o0[q] = pk2(xs[32 * mt + (ra & 3) + 8 * (ra >> 2) + 4 * hi], xs[32 * mt + (rb & 3) + 8 * (rb >> 2) + 4 * hi]);
                            o1[q] = pk2(xs[32 * mt + (rc & 3) + 8 * (rc >> 2) + 4 * hi], xs[32 * mt + (rd & 3) + 8 * (rd >> 2) + 4 * hi]); }
                        bf16* dst = U + ((mt * 2 + et) * 64 + r32 + 32 * hi) * 16; *(v4u*)dst = o0; *(v4u*)(dst + 8) = o1; }
            } else {
                bf16* W = (bf16*)(C.ws + WS_W) + (size_t)blk * 4096; const int d = col - 64;
#pragma unroll
                for (int il = 0; il < 64; ++il) W[il * 64 + d] = (bf16)(pk2(xs[il], 0.f) & 0xffffu);
            }
        } else {
            const int t2 = tidl - 256;
            for (int idx = t2; idx < 2 * 64 * 8; idx += 256) {
                const int d8 = idx & 7, il = (idx >> 3) & 63, dir = idx >> 9;
                const int it = dir ? 63 - il : il; const LAS float* s = qkv + it * P + d8 * 8; const float f = 0.125f * __expf(Gs[dir * 64 + il]);
                v4u o; o.x = pk2(s[0] * f, s[1] * f); o.y = pk2(s[2] * f, s[3] * f); o.z = pk2(s[4] * f, s[5] * f); o.w = pk2(s[6] * f, s[7] * f);
                *(v4u*)((bf16*)(C.ws + WS_QS) + (size_t)(dir ? blk1 : blk0) * 4096 + il * 64 + d8 * 8) = o;
            }
            for (int idx = t2; idx < 2 * 64 * 8; idx += 256) {
                const int i8 = idx & 7, d = (idx >> 3) & 63, dir = idx >> 9; const float gl = Gs[dir * 64 + 63];
                float v[8];
#pragma unroll
                for (int j = 0; j < 8; ++j) { const int il = i8 * 8 + j, it = dir ? 63 - il : il; v[j] = qkv[(64 + it) * P + d] * __expf(gl - Gs[dir * 64 + il]); }
                v4u o; o.x = pk2(v[0], v[1]); o.y = pk2(v[2], v[3]); o.z = pk2(v[4], v[5]); o.w = pk2(v[6], v[7]);
                *(v4u*)((bf16*)(C.ws + WS_KT) + (size_t)(dir ? blk1 : blk0) * 4096 + d * 64 + i8 * 8) = o;
            }
            for (int idx = t2; idx < 2 * 3 * 64 * 2; idx += 256) {
                const int half = idx & 1, ln = (idx >> 1) & 63, tt = (idx >> 7) % 3, dir = (idx >> 7) / 3;
                const int mt = (tt == 2) ? 1 : 0, itl = (tt == 0) ? 0 : 1, r32 = ln & 31, hi = ln >> 5, il = r32 + 32 * itl, itok = dir ? 63 - il : il;
                const float gi = Gs[dir * 64 + il];
                float v[8];
#pragma unroll
                for (int j = 0; j < 8; ++j) { const int r = 8 * half + j, ml = (r & 3) + 8 * (r >> 2) + 4 * hi + 32 * mt, mtok = dir ? 63 - ml : ml;
                    v[j] = (il >= ml) ? 0.125f * QK[itok * P + mtok] * __expf(gi - Gs[dir * 64 + ml]) : 0.f; }
                v4u o; o.x = pk2(v[0], v[1]); o.y = pk2(v[2], v[3]); o.z = pk2(v[4], v[5]); o.w = pk2(v[6], v[7]);
                *(v4u*)((bf16*)(C.ws + WS_KS) + (size_t)(dir ? blk1 : blk0) * 4096 + ((mt * 2 + itl) * 64 + ln) * 16 + 8 * half) = o;
            }
            if (t2 < 2) ((float*)(C.ws + WS_GS))[t2 ? blk1 : blk0] = __expf(Gs[t2 * 64 + 63]);
            { constexpr int PER_TASK = (MG * 22 * 4) / 1024; const int tslot = (task - C.vcu) / C.G; const int beg = (C.vcu * 4 + tslot) * PER_TASK; rope_span(C, beg, beg + PER_TASK, t2, 256); }
        }
    }
    __syncthreads();
}

#define DN_BAR() asm volatile("s_waitcnt lgkmcnt(0)\n\ts_barrier" ::: "memory")
#define LDG(T, base, off) (*(const GAS T*)((const GAS char*)(base) + (off)))
__device__ __forceinline__ void dn_chain(Ctx& C, int ch) {
    constexpr int SP = 72, IMG = 64 * SP;
    LAS bf16* STb = (LAS bf16*)C.lds; LAS v4u* VN = (LAS v4u*)(C.lds + 3 * IMG * 2);
    const int lane = C.lane, r32 = lane & 31, hi = lane >> 5, w = C.wave, wl = w & 3;
    const int dir = ch >> 3, seq = (ch >> 2) & 1, h = ch & 3;
    const GAS bf16* QD = (const GAS bf16*)(C.ws + WS_QS) + (size_t)ch * 128 * 4096; const GAS bf16* AT = (const GAS bf16*)(C.ws + WS_KS) + (size_t)ch * 128 * 4096;
    const GAS bf16* KT = (const GAS bf16*)(C.ws + WS_KT) + (size_t)ch * 128 * 4096; const GAS bf16* UU = (const GAS bf16*)(C.ws + WS_U) + (size_t)ch * 128 * 4096;
    const GAS bf16* WW = (const GAS bf16*)(C.ws + WS_W) + (size_t)ch * 128 * 4096; const GAS float* GL = (const GAS float*)(C.ws + WS_GS) + (size_t)ch * 128;
    GAS float* ODN = (GAS float*)(C.ws + WS_ODN) + (size_t)dir * MG * 256;
    __syncthreads();
    for (int e = C.tid; e < 3 * IMG / 2; e += NTHR) ((LAS unsigned*)STb)[e] = 0u;
    __syncthreads();
    if (w < 4) {
        const int et = wl >> 1, dt = wl & 1;
        f32x16 ST = f32x16{};
        bf16x8 wA0[2][4], kB0[2][2], wA1[2][4], kB1[2][2]; v4u uu0[2][2], uu1[2][2]; float gam0, gam1;
        const unsigned off_w0 = (unsigned)((r32 * 64 + 8 * hi) * 2), off_u0 = (unsigned)((et * 64 + lane) * 32), off_kt = (unsigned)(((r32 + 32 * dt) * 64 + 4 * hi) * 2);
#define CH_LOAD(n_, wA, kB, uu, gam) do { const GAS bf16* Wb = WW + (size_t)(n_) * 4096; const GAS bf16* Ub = UU + (size_t)(n_) * 4096; const GAS bf16* KTb = KT + (size_t)(n_) * 4096; \
            _Pragma("unroll") for (int mt = 0; mt < 2; ++mt) { \
                _Pragma("unroll") for (int kk = 0; kk < 4; ++kk) wA[mt][kk] = LDG(bf16x8, Wb, off_w0 + (unsigned)(mt * 4096 + kk * 32)); \
                uu[mt][0] = LDG(v4u, Ub, off_u0 + (unsigned)(mt * 4096)); uu[mt][1] = LDG(v4u, Ub, off_u0 + (unsigned)(mt * 4096 + 16)); \
                _Pragma("unroll") for (int s = 0; s < 2; ++s) { const v2u lo = LDG(v2u, KTb, off_kt + (unsigned)((32 * mt + 16 * s) * 2)), hh = LDG(v2u, KTb, off_kt + (unsigned)((32 * mt + 16 * s + 8) * 2)); \
                    kB[mt][s] = __builtin_bit_cast(bf16x8, (v4u){lo.x, lo.y, hh.x, hh.y}); } } \
            gam = GL[n_]; } while (0)
#define CH_STEP(n_, wA, kB, uu, gam) do { \
            const int c3 = (n_) % 3, x3 = (c3 == 2) ? 0 : c3 + 1; \
            bf16x8 sB[4]; \
            _Pragma("unroll") for (int kk = 0; kk < 4; ++kk) sB[kk] = *(const LAS bf16x8*)(STb + c3 * IMG + (r32 + 32 * et) * SP + 16 * kk + 8 * hi); \
            f32x16 ws0 = f32x16{}, ws1 = f32x16{}; \
            _Pragma("unroll") for (int kk = 0; kk < 4; ++kk) { ws0 = MFMA32(wA[0][kk], sB[kk], ws0); ws1 = MFMA32(wA[1][kk], sB[kk], ws1); } \
            _Pragma("unroll") for (int r = 0; r < 16; ++r) { \
                const float u0 = (r & 1) ? __uint_as_float(uu[0][r >> 3][(r >> 1) & 3] & 0xffff0000u) : __uint_as_float(uu[0][r >> 3][(r >> 1) & 3] << 16); \
                const float u1 = (r & 1) ? __uint_as_float(uu[1][r >> 3][(r >> 1) & 3] & 0xffff0000u) : __uint_as_float(uu[1][r >> 3][(r >> 1) & 3] << 16); \
                ws0[r] = u0 - ws0[r]; ws1[r] = u1 - ws1[r]; ST[r] *= gam; } \
            const bf16x8 p00 = pack8(ws0, 0), p01 = pack8(ws0, 1), p10 = pack8(ws1, 0), p11 = pack8(ws1, 1); \
            { LAS v4u* vn = VN + ((((n_) & 1) * 2 + et) * 4) * 64 + lane; vn[0] = __builtin_bit_cast(v4u, p00); vn[64] = __builtin_bit_cast(v4u, p01); vn[128] = __builtin_bit_cast(v4u, p10); vn[192] = __builtin_bit_cast(v4u, p11); } \
            ST = MFMA32(p00, kB[0][0], ST); ST = MFMA32(p10, kB[1][0], ST); ST = MFMA32(p01, kB[0][1], ST); ST = MFMA32(p11, kB[1][1], ST); \
            LAS bf16* dst = STb + x3 * IMG + (32 * et) * SP + r32 + 32 * dt; \
            _Pragma("unroll") for (int r = 0; r < 16; ++r) dst[crow(r, hi) * SP] = (bf16)(pk2(ST[r], 0.f) & 0xffffu); \
            DN_BAR(); } while (0)
        CH_LOAD(0, wA0, kB0, uu0, gam0);
        for (int n = 0; n < 128; n += 2) {
            CH_LOAD(n + 1, wA1, kB1, uu1, gam1);
            CH_STEP(n, wA0, kB0, uu0, gam0);
            CH_LOAD((n + 2 < 128) ? n + 2 : 127, wA0, kB0, uu0, gam0);
            CH_STEP(n + 1, wA1, kB1, uu1, gam1);
        }
        DN_BAR();
#undef CH_LOAD
#undef CH_STEP
    } else {
        const int it = wl >> 1, et = wl & 1;
        bf16x8 qA0[4], qA1[4]; v4u at0[2][2], at1[2][2];
        const unsigned off_q = (unsigned)(((r32 + 32 * it) * 64 + 8 * hi) * 2), off_at0 = (unsigned)((it * 64 + lane) * 32);
#define OW_LOAD(n_, qA, at) do { const GAS bf16* Qb = QD + (size_t)(n_) * 4096; const GAS bf16* Ab = AT + (size_t)(n_) * 4096; \
            _Pragma("unroll") for (int kk = 0; kk < 4; ++kk) qA[kk] = LDG(bf16x8, Qb, off_q + (unsigned)(kk * 32)); \
            _Pragma("unroll") for (int mt = 0; mt < 2; ++mt) { if (mt <= it) { at[mt][0] = LDG(v4u, Ab, off_at0 + (unsigned)(mt * 4096)); at[mt][1] = LDG(v4u, Ab, off_at0 + (unsigned)(mt * 4096 + 16)); } } } while (0)
#define OW_STEP(n_, qA, at) do { \
            const int c3 = (n_) % 3; \
            bf16x8 sB[4]; \
            _Pragma("unroll") for (int kk = 0; kk < 4; ++kk) sB[kk] = *(const LAS bf16x8*)(STb + c3 * IMG + (r32 + 32 * et) * SP + 16 * kk + 8 * hi); \
            const LAS v4u* vn = VN + ((((n_) & 1) * 2 + et) * 4) * 64 + lane; \
            f32x16 o = f32x16{}; \
            _Pragma("unroll") for (int kk = 0; kk < 4; ++kk) o = MFMA32(qA[kk], sB[kk], o); \
            _Pragma("unroll") for (int mt = 0; mt < 2; ++mt) { if (mt <= it) { \
                _Pragma("unroll") for (int s = 0; s < 2; ++s) o = MFMA32(__builtin_bit_cast(bf16x8, at[mt][s]), __builtin_bit_cast(bf16x8, vn[(mt * 2 + s) * 64]), o); } } \
            _Pragma("unroll") for (int r = 0; r < 16; ++r) { const int sr = (n_) * 64 + 32 * it + crow(r, hi), t = dir ? (SEQ - 1 - sr) : sr; \
                ODN[(size_t)(seq * SEQ + t) * 256 + h * 64 + 32 * et + r32] = o[r]; } \
            DN_BAR(); } while (0)
        OW_LOAD(0, qA0, at0);
        DN_BAR();
        for (int n = 0; n < 128; n += 2) {
            OW_LOAD(n + 1, qA1, at1);
            OW_STEP(n, qA0, at0);
            OW_LOAD((n + 2 < 128) ? n + 2 : 127, qA0, at0);
            OW_STEP(n + 1, qA1, at1);
        }
#undef OW_LOAD
#undef OW_STEP
    }
    __syncthreads();
}
#undef LDG
__device__ __forceinline__ void phase_finalize(Ctx& C, int li, const float* dn_norm_w, const float* diff_lambda, const float* diff_norm_w) {
    const int gw = C.vcu * NWAVES + C.wave, NGW = C.G * NWAVES, lane = C.lane;
    const float lam_init = 0.8f - 0.6f * __expf(-0.3f * (float)li);
    const float d1 = wave_sum(diff_lambda[lane] * diff_lambda[64 + lane], lane), d2 = wave_sum(diff_lambda[128 + lane] * diff_lambda[192 + lane], lane);
    const float lam = __expf(d1) - __expf(d2) + lam_init;
    const f32x4 nwd = *(const f32x4*)(dn_norm_w + (4 * lane & 63));
    const f32x4 nf0 = *(const f32x4*)(diff_norm_w + (8 * lane & 127)), nf1 = *(const f32x4*)(diff_norm_w + (8 * lane & 127) + 4);
    const float* of = (const float*)(C.ws + WS_ODN); const float* ob = of + (size_t)MG * 256;
    const bf16* zb = (const bf16*)(C.ws + WS_Z); const bf16* odf = (const bf16*)(C.ws + WS_ODF); bf16* mix = (bf16*)(C.ws + WS_MIX);
    const int hh_ = lane >> 4, e0_ = 8 * (lane & 15);
    f32x4 na = *(const f32x4*)(of + (size_t)gw * 256 + 4 * lane), nb = *(const f32x4*)(ob + (size_t)gw * 256 + 4 * lane); v2u nz = *(const v2u*)(zb + (size_t)gw * 256 + 4 * lane);
    v4u nda = *(const v4u*)(odf + (size_t)gw * 1024 + hh_ * 256 + e0_), ndb = *(const v4u*)(odf + (size_t)gw * 1024 + hh_ * 256 + 128 + e0_);
    for (int m = gw; m < MG; m += NGW) {
        const f32x4 ca = na, cb = nb; const v2u cz = nz; const v4u cda = nda, cdb = ndb;
        { const int mn = (m + NGW < MG) ? m + NGW : m;
          na = *(const f32x4*)(of + (size_t)mn * 256 + 4 * lane); nb = *(const f32x4*)(ob + (size_t)mn * 256 + 4 * lane); nz = *(const v2u*)(zb + (size_t)mn * 256 + 4 * lane);
          nda = *(const v4u*)(odf + (size_t)mn * 1024 + hh_ * 256 + e0_); ndb = *(const v4u*)(odf + (size_t)mn * 1024 + hh_ * 256 + 128 + e0_); }
        {
            const f32x4 a = ca, b = cb;
            const f32x4 o = a + b; float s = (o.x * o.x + o.y * o.y) + (o.z * o.z + o.w * o.w);
            s += shx(s, 1, lane); s += shx(s, 2, lane); s += shx(s, 4, lane); s += shx(s, 8, lane);
            const float rstd = 1.f / sqrtf(s * (1.f / 64.f) + EPS);
            const v2u zz = cz;
            const float z0 = __uint_as_float(zz.x << 16), z1 = __uint_as_float(zz.x & 0xffff0000u), z2 = __uint_as_float(zz.y << 16), z3 = __uint_as_float(zz.y & 0xffff0000u);
            v2u w; w.x = pk2(o.x * rstd * nwd.x * (z0 / (1.f + __expf(-z0))), o.y * rstd * nwd.y * (z1 / (1.f + __expf(-z1))));
            w.y = pk2(o.z * rstd * nwd.z * (z2 / (1.f + __expf(-z2))), o.w * rstd * nwd.w * (z3 / (1.f + __expf(-z3))));
            *(v2u*)(mix + (size_t)m * 1024 + 4 * lane) = w;
        }
        {
            const int hh = lane >> 4, e0 = 8 * (lane & 15);
            v4u a = cda; const v4u b = cdb;
            if (hh == 0 && m < SEQ) {
                const int cc = e0 >> 6; const bf16* po = (const bf16*)(C.ws + WS_PO); const float* ps = (const float*)(C.ws + WS_PS);
                float mp[4], lp[4]; v4u pp[4]; float mm = -INFINITY;
#pragma unroll
                for (int p = 0; p < 4; ++p) { pp[p] = *(const v4u*)(po + ((size_t)(p * 2 + cc) * SEQ + m) * 64 + (e0 & 63)); mp[p] = ps[((size_t)(p * 2 + cc) * SEQ + m) * 2]; lp[p] = ps[((size_t)(p * 2 + cc) * SEQ + m) * 2 + 1]; mm = fmaxf(mm, mp[p]); }
                float wsum = 0.f;
#pragma unroll
                for (int p = 0; p < 4; ++p) { lp[p] *= __builtin_amdgcn_exp2f(mp[p] - mm); wsum += lp[p]; }
                const float inv = 1.f / wsum;
#pragma unroll
                for (int w = 0; w < 4; ++w) { float lo = 0.f, hi_ = 0.f;
#pragma unroll
                    for (int p = 0; p < 4; ++p) { lo += lp[p] * __uint_as_float(pp[p][w] << 16); hi_ += lp[p] * __uint_as_float(pp[p][w] & 0xffff0000u); }
                    a[w] = pk2(lo * inv, hi_ * inv); }
            }
            float o[8]; float s = 0.f;
#pragma unroll
            for (int w = 0; w < 4; ++w) { o[2 * w] = __uint_as_float(a[w] << 16) - lam * __uint_as_float(b[w] << 16); o[2 * w + 1] = __uint_as_float(a[w] & 0xffff0000u) - lam * __uint_as_float(b[w] & 0xffff0000u);
                s += o[2 * w] * o[2 * w] + o[2 * w + 1] * o[2 * w + 1]; }
            s += shx(s, 1, lane); s += shx(s, 2, lane); s += shx(s, 4, lane); s += shx(s, 8, lane);
            const float sc = (1.f - lam_init) / sqrtf(s * (1.f / 128.f) + EPS);
            v4u w; w.x = pk2(o[0] * sc * nf0.x, o[1] * sc * nf0.y); w.y = pk2(o[2] * sc * nf0.z, o[3] * sc * nf0.w); w.z = pk2(o[4] * sc * nf1.x, o[5] * sc * nf1.y); w.w = pk2(o[6] * sc * nf1.z, o[7] * sc * nf1.w);
            *(v4u*)(mix + (size_t)m * 1024 + 256 + 8 * lane) = w;
        }
    }
}

struct Args { const float* in[16]; float* out; unsigned char* ws; };
__device__ __forceinline__ const float* ldarg(int k) { const Args* p = (const Args*)__builtin_amdgcn_kernarg_segment_ptr(); asm volatile("" : "+s"(p)); return p->in[k]; }
__device__ __forceinline__ float* ldout() { const Args* p = (const Args*)__builtin_amdgcn_kernarg_segment_ptr(); asm volatile("" : "+s"(p)); return p->out; }
__device__ __forceinline__ unsigned char* ldws() { const Args* p = (const Args*)__builtin_amdgcn_kernarg_segment_ptr(); asm volatile("" : "+s"(p)); return p->ws; }
__device__ __forceinline__ void refresh(Ctx& C, unsigned char* ldsp) {
    int t = threadIdx.x; asm volatile("" : "+v"(t));
    int bx = blockIdx.x; asm volatile("" : "+s"(bx));
    int G = gridDim.x; asm volatile("" : "+s"(G));
    unsigned lo = (unsigned)(uintptr_t)ldsp; asm volatile("" : "+s"(lo));
    C.lds = (LAS unsigned char*)(uintptr_t)lo; C.ldsg = ldsp; C.tid = t; C.lane = t & 63; C.wave = __builtin_amdgcn_readfirstlane(t >> 6);
    C.G = G; C.vcu = (G % 8 == 0) ? (bx % 8) * (G / 8) + bx / 8 : bx; C.bx = bx;
    C.ws = ldws();
}
#define RF() refresh(C, lds)
#define GSYNC() do { RF(); XcdBarrier b_; b_.bar = (unsigned*)C.ws; b_.x = xb_xcc_id(); b_.st = (volatile LAS unsigned*)(C.lds + 131424); xcd_barrier(b_); } while (0)
__global__ void __launch_bounds__(NTHR, 2) hybrid_fwd(Args args) {
    extern __shared__ __attribute__((aligned(16))) unsigned char lds[];
    cg::grid_group grid = cg::this_grid();
    Ctx C; RF();
    if (C.tid < 2) ((volatile LAS unsigned*)(C.lds + 131424))[C.tid] = 0u;
    __syncthreads();
    if (C.tid == 0) (void)xb_add(&((unsigned*)C.ws)[XB_XCNT(xb_xcc_id())], 1u);
#define ARGP(k) (ldarg(k))
#define x_prompt ARGP(0)
#define x_sample ARGP(1)
#define norm1_w ARGP(2)
#define w_in ARGP(3)
#define conv_w ARGP(4)
#define a_log ARGP(5)
#define dt_bias ARGP(6)
#define dn_norm_w ARGP(7)
#define diff_lambda ARGP(8)
#define diff_norm_w ARGP(9)
#define swa_sink ARGP(10)
#define w_out ARGP(11)
#define norm2_w ARGP(12)
#define w_up ARGP(13)
#define w_dn ARGP(14)
#define final_w ARGP(15)
#define HN ((bf16*)(C.ws + WS_HN))
#define MIX ((bf16*)(C.ws + WS_MIX))
#define HID ((bf16*)(C.ws + WS_HID))
    phase_prologue(C, w_in, w_out, w_up, w_dn, norm2_w, norm1_w);
    RF();
    phase_norm<false>(C, x_prompt, norm1_w, HN, nullptr, nullptr);
    if (ldws() == nullptr) grid.sync();
    GSYNC();
    for (int g = 0; g < NGRP; ++g) {
#define xo (ldout() + (size_t)g * MG * DMODEL)
        for (int li = 0; li < DEPTH; ++li) {
#define xcur (li ? (const float*)xo : ((g < 2) ? x_prompt + (size_t)g * MG * DMODEL : x_sample))
            RF();
            if (li == 0 && g > 0) { phase_norm<false>(C, xcur, norm1_w, HN, nullptr, nullptr); GSYNC(); }
            RF();
            { pg8::Gemm gm{HN, (const bf16*)(C.ws + WS_WIN) + (size_t)li * NPROJ * DMODEL, MG, NPROJ, DMODEL}; pg8::StaticOrder S; S.init(MG, NPROJ, C.G, C.bx);
              phase_logits(C, HN, (const bf16*)(C.ws + WS_WL) + (size_t)li * 32 * DMODEL, li ? (const float*)(C.ws + WS_SS2) : nullptr, (float*)(C.ws + WS_BG));
              pg8::EpiProj E{C.ws, li ? (const float*)(C.ws + WS_SS2) : nullptr};
              pg8::gemm_phase<pg8::EpiProj, pg8::StaticOrder, true, true>(C.lds, gm, S, E); }
            GSYNC();
            RF();
            RF();
#ifndef NO_PREP
            phase_dn_prep(C, conv_w + (size_t)li * 5 * 768, a_log + li * 8, dt_bias + li * 8);
#endif
            GSYNC();
            RF();
            {
#ifndef NO_CHAIN
                if (C.vcu < 16) dn_chain(C, C.vcu);
#endif
                __syncthreads(); RF();
                using abf = attn_body::bf16;
                {
                    const int nun = (C.vcu < 16) ? 0 : 4;
                    for (int i = 0; i < nun; ++i) {
                        const int bh = C.vcu >> 3, s = C.vcu & 7, b = bh >> 4, vh = bh & 15, h = vh >> 2, j = (vh >> 1) & 1, c = vh & 1;
                        const abf* Qb = (const abf*)(C.ws + WS_DFQ) + (size_t)b * SEQ * 512 + h * 128 + j * 64;
                        const abf* Kb = (const abf*)(C.ws + WS_DFK) + (size_t)b * SEQ * 512 + h * 128 + j * 64;
                        const abf* Vb = (const abf*)(C.ws + WS_DFV) + (size_t)b * SEQ * 512 + h * 128 + c * 64;
                        abf* Ob = (abf*)(C.ws + WS_ODF) + (size_t)b * SEQ * 1024 + h * 256 + j * 128 + c * 64;
                        const int qb = (i == 0) ? s : (i == 1) ? 15 - s : (i == 2) ? 16 + s : 31 - s;
                        attn_body::attn_unit<8, 0>(Qb, 512, Kb, 512, Vb, 512, Ob, 1024, qb * 256, 0.f, (char*)C.ldsg, 0, nullptr, i > 0, i + 1 < nun); }
                    {
                        RF();
                        const int qu = (C.vcu < 16) ? 240 + C.vcu : C.vcu - 16, part = qu & 3, un = qu >> 2, v2 = un & 15, i2 = un >> 4, s = v2 & 7, c = v2 >> 3;
                        const int qb = (i2 == 0) ? s : (i2 == 1) ? 15 - s : (i2 == 2) ? 16 + s : 31 - s;
                        const abf* Qb = (const abf*)(C.ws + WS_DFQ); const abf* Kb = (const abf*)(C.ws + WS_DFK); const abf* Vb = (const abf*)(C.ws + WS_DFV) + c * 64;
                        abf* Ob = (abf*)(C.ws + WS_PO) + (size_t)(part * 2 + c) * SEQ * 64;
                        attn_body::attn_unit<8, 2>(Qb, 512, Kb, 512, Vb, 512, Ob, 64, qb * 256, 0.f, (char*)C.ldsg, part * (SEQ / 4), (float*)(C.ws + WS_PS) + (size_t)(part * 2 + c) * SEQ * 2);
                    }
                }
                RF();
                {
                    const int nsw = 1;
                    for (int i = 0; i < nsw; ++i) {
                        const int un = C.vcu;
                        const int b = un >> 7, h = (un >> 5) & 3, qb = un & 31;
                        const abf* Qb = (const abf*)(C.ws + WS_SWQ) + (size_t)b * SEQ * 256 + h * 64;
                        const abf* Kb = (const abf*)(C.ws + WS_SWKV) + (size_t)b * SEQ * 256 + (h >> 1) * 64;
                        const abf* Vb = (const abf*)(C.ws + WS_SWKV) + (size_t)b * SEQ * 256 + 128 + (h >> 1) * 64;
                        abf* Ob = (abf*)(C.ws + WS_MIX) + (size_t)b * SEQ * 1024 + 768 + h * 64;
                        attn_body::attn_unit<8, 1>(Qb, 256, Kb, 256, Vb, 256, Ob, 1024, qb * 256, swa_sink[li * 4 + h] * LOG2E, (char*)C.ldsg);
                    }
                }
            }
            GSYNC();
            RF();
            phase_finalize(C, li, dn_norm_w + li * 64, diff_lambda + li * 256, diff_norm_w + li * 128);
            GSYNC();
            RF();
            { pg8::Gemm gm{MIX, (const bf16*)(C.ws + WS_WOUT) + (size_t)li * DMODEL * DMODEL, MG, DMODEL, DMODEL}; pg8::StaticOrder S; S.init(MG, DMODEL, C.G, C.bx);
              pg8::EpiRes E{li ? nullptr : xcur, li ? (const bf16*)HN : nullptr, nullptr, HN, (float*)(C.ws + WS_SS)};
              pg8::gemm_phase<pg8::EpiRes, pg8::StaticOrder, true, true>(C.lds, gm, S, E); }
            GSYNC();
            RF();
            { pg8::Gemm gm{HN, (const bf16*)(C.ws + WS_WUP) + (size_t)li * DFF * DMODEL, MG, DFF, DMODEL}; pg8::StaticOrder S; S.init(MG, DFF, C.G, C.bx);
              pg8::EpiRelu2S E{HID, (const float*)(C.ws + WS_SS), DFF};
              pg8::gemm_phase<pg8::EpiRelu2S, pg8::StaticOrder, true, true>(C.lds, gm, S, E); }
            GSYNC();
            RF();
            { pg8::Gemm gm{HID, (const bf16*)(C.ws + WS_WDN) + (size_t)li * DMODEL * DFF, MG, DMODEL, DFF}; pg8::StaticOrder S; S.init(MG, DMODEL, C.G, C.bx);
              pg8::EpiRes E{nullptr, HN, li ? xo : nullptr, li ? nullptr : HN, li ? nullptr : (float*)(C.ws + WS_SS2)};
              pg8::gemm_phase<pg8::EpiRes, pg8::StaticOrder, true, true>(C.lds, gm, S, E); }
            GSYNC();
        }
        RF();
        phase_final_norm(C, xo, final_w);
    }
}

extern "C" void kernel_launch(void* const* d_in, const int* in_sizes, int n_in, void* d_out, int out_size, void* d_ws, size_t ws_size, hipStream_t stream) {
    static int grid = 0;
    if (grid == 0) {
        if (n_in != 16 || ws_size < 498 * MiB) { fprintf(stderr, "kernel_launch: unexpected inputs (n_in %d, ws %zu)\n", n_in, ws_size); grid = -1; return; }
        int dev = 0, cus = 0, per_cu = 0;
        hipGetDevice(&dev); hipDeviceGetAttribute(&cus, hipDeviceAttributeMultiprocessorCount, dev);
        if (hipFuncSetAttribute((const void*)hybrid_fwd, hipFuncAttributeMaxDynamicSharedMemorySize, LDS_BYTES) != hipSuccess) { fprintf(stderr, "kernel_launch: hipFuncSetAttribute failed\n"); grid = -1; return; }
        hipOccupancyMaxActiveBlocksPerMultiprocessor(&per_cu, (const void*)hybrid_fwd, NTHR, LDS_BYTES);
        (void)hipGetLastError();
        if (per_cu < 1) per_cu = 1;
        grid = cus;
        if (grid != 256) fprintf(stderr, "kernel_launch: %d CUs (built for 256)\n", grid);
    }
    if (grid < 0) return;
    if (hipMemsetAsync(d_ws, 0, 65536, stream) != hipSuccess) { fprintf(stderr, "kernel_launch: hipMemsetAsync failed\n"); return; }
    Args a{};
    for (int i = 0; i < 16; ++i) a.in[i] = (const float*)d_in[i];
    a.out = (float*)d_out; a.ws = (unsigned char*)d_ws;
    void* kargs[] = {&a};
    hipError_t e = hipLaunchCooperativeKernel((const void*)hybrid_fwd, dim3(grid), dim3(NTHR), kargs, LDS_BYTES, stream);
    if (e != hipSuccess) fprintf(stderr, "cooperative launch failed: %s (grid %d)\n", hipGetErrorString(e), grid);
}
```

```cpp
#include <hip/hip_runtime.h>
#include <cstdio>
#include <cstdint>
namespace pg8 {
#define PG8_LAS __attribute__((address_space(3)))
typedef unsigned short bf16_t;
typedef short bf16x8 __attribute__((ext_vector_type(8)));
typedef float f32x4 __attribute__((ext_vector_type(4)));
typedef unsigned u32x4 __attribute__((ext_vector_type(4)));
constexpr int BM = 256, BK = 64, HALF = 128, HTB = HALF * BK * 2  , STAGE_BYTES = 8 * HTB, NXCD = 8, WGM = 4;

__host__ __device__ __forceinline__ int lds_byte(int r, int c) { const int st = (r >> 4) * 2 + (c >> 5), rr = r & 15, cc = c & 31, ob = rr * 64 + cc * 2; return st * 1024 + (ob ^ (((ob >> 9) & 1) << 5)); }
__host__ __device__ __forceinline__ void stage_rc(int b, int& R, int& C) { const int st = b / 1024, sb = b % 1024, swz = sb ^ (((sb >> 9) & 1) << 5); R = (st >> 1) * 16 + swz / 64; C = (st & 1) * 32 + (swz % 64) / 2; }
__host__ __device__ __forceinline__ int perm32(int rho) { const int n = rho >> 4, i = rho & 15; return 8 * (i >> 2) + 4 * n + (i & 3); }

struct Unit { int pm, pn; };
struct Gemm { const bf16_t* A; const bf16_t* Bt; int M, N, K; };

struct StaticOrder {
    int nM, nN, nwg, G, c;
    __host__ __device__ void init(int M, int N, int G_, int c_) { nM = M / BM; nN = N / BM; nwg = nM * nN; G = G_; c = c_; }
    __host__ __device__ bool next(int i, Unit& u) const {
        const long L = (long)i * G + c; if (L >= nwg) return false;
        int wgid = (int)L; { const int q = nwg / NXCD, r = nwg % NXCD, xcd = wgid % NXCD, off = wgid / NXCD; wgid = (xcd < r ? xcd * (q + 1) : r * (q + 1) + (xcd - r) * q) + off; }
        const int nig = WGM * nN, gid = wgid / nig, fm = gid * WGM, gsz = (nM - fm) < WGM ? (nM - fm) : WGM;
        u.pm = fm + ((wgid % nig) % gsz); u.pn = (wgid % nig) / gsz; return true;
    }
    __device__ __forceinline__ void a_ready(const Unit&) const {}
    __device__ __forceinline__ void done(const Unit&) const {}
};

__device__ __forceinline__ unsigned cvt_pk_bf16(float lo, float hi) { unsigned r; asm volatile("v_cvt_pk_bf16_f32 %0, %1, %2" : "=v"(r) : "v"(lo), "v"(hi)); return r; }

__device__ __forceinline__ float row_rstd(const float* ss, int row) {
    const f32x4* p = (const f32x4*)(ss + (size_t)row * 16); const f32x4 a = p[0], b = p[1], c = p[2], d = p[3];
    const float t = (((a[0] + a[1]) + (a[2] + a[3])) + ((b[0] + b[1]) + (b[2] + b[3]))) + (((c[0] + c[1]) + (c[2] + c[3])) + ((d[0] + d[1]) + (d[2] + d[3])));
    return 1.0f / sqrtf(t * (1.0f / 1024.0f) + 1e-6f);
}
struct EpiProj {
    static constexpr bool PERM = true, AFTER_DRAIN = false;
    unsigned char* ws;
    const float* ss;
    __device__ __forceinline__ void operator()(const f32x4 (&acc)[2][2][4][2], const Unit& u, int wr, int wc, int fr, int fq) const {
        const int row0 = u.pm * BM + wr * 64 + fr; const int pn = u.pn;
        size_t boff; int ldc, colt;
        if (pn < 3) { boff = (size_t)84 << 20; ldc = 768; colt = pn * 256; }
        else if (pn == 3) { boff = (size_t)108 << 20; ldc = 256; colt = 0; }
        else if (pn < 6) { boff = (size_t)116 << 20; ldc = 512; colt = (pn - 4) * 256; }
        else if (pn < 8) { boff = (size_t)132 << 20; ldc = 512; colt = (pn - 6) * 256; }
        else if (pn < 10) { boff = (size_t)148 << 20; ldc = 512; colt = (pn - 8) * 256; }
        else if (pn == 10) { boff = (size_t)164 << 20; ldc = 256; colt = 0; }
        else { boff = (size_t)172 << 20; ldc = 256; colt = 0; }
        bf16_t* base = (bf16_t*)(ws + boff);
        const int col0 = colt + wc * 32 + 8 * fq;
#pragma unroll
        for (int ai = 0; ai < 2; ++ai)
#pragma unroll
            for (int m = 0; m < 4; ++m) { const int row = row0 + ai * HALF + m * 16; bf16_t* rowp = base + (size_t)row * ldc + col0;
                const float rs = ss ? row_rstd(ss, row) : 1.0f;
#pragma unroll
                for (int bj = 0; bj < 2; ++bj) { const f32x4 v0 = acc[ai][bj][m][0] * rs, v1 = acc[ai][bj][m][1] * rs;
                    u32x4 w; w.x = cvt_pk_bf16(v0[0], v0[1]); w.y = cvt_pk_bf16(v0[2], v0[3]); w.z = cvt_pk_bf16(v1[0], v1[1]); w.w = cvt_pk_bf16(v1[2], v1[3]);
                    *(u32x4*)(rowp + bj * HALF) = w; } }
    }
};
struct EpiRelu2 {
    static constexpr bool PERM = true, AFTER_DRAIN = false;
    bf16_t* O; int ldc;
    __device__ __forceinline__ void operator()(const f32x4 (&acc)[2][2][4][2], const Unit& u, int wr, int wc, int fr, int fq) const {
        const int row0 = u.pm * BM + wr * 64 + fr; const int col0 = u.pn * BM + wc * 32 + 8 * fq;
#pragma unroll
        for (int ai = 0; ai < 2; ++ai)
#pragma unroll
            for (int m = 0; m < 4; ++m) { bf16_t* rowp = O + (size_t)(row0 + ai * HALF + m * 16) * ldc + col0;
#pragma unroll
                for (int bj = 0; bj < 2; ++bj) { f32x4 v0 = acc[ai][bj][m][0], v1 = acc[ai][bj][m][1];
#pragma unroll
                    for (int e = 0; e < 4; ++e) { const float a = fmaxf(v0[e], 0.f), b = fmaxf(v1[e], 0.f); v0[e] = a * a; v1[e] = b * b; }
                    u32x4 w; w.x = cvt_pk_bf16(v0[0], v0[1]); w.y = cvt_pk_bf16(v0[2], v0[3]); w.z = cvt_pk_bf16(v1[0], v1[1]); w.w = cvt_pk_bf16(v1[2], v1[3]);
                    *(u32x4*)(rowp + bj * HALF) = w; } }
    }
};
struct EpiResid {
    static constexpr bool PERM = false, AFTER_DRAIN = false;
    const float* base; float* out; int ldc;
    __device__ __forceinline__ void operator()(const f32x4 (&acc)[2][2][4][2], const Unit& u, int wr, int wc, int fr, int fq) const {
        const int col0 = u.pn * BM + wc * 32 + 4 * fq;
#pragma unroll
        for (int ai = 0; ai < 2; ++ai)
#pragma unroll
            for (int m = 0; m < 4; ++m) { const size_t off = (size_t)(u.pm * BM + ai * HALF + wr * 64 + m * 16 + fr) * ldc + col0;
#pragma unroll
                for (int bj = 0; bj < 2; ++bj)
#pragma unroll
                    for (int n = 0; n < 2; ++n) { const f32x4 bs = *(const f32x4*)(base + off + bj * HALF + n * 16); *(f32x4*)(out + off + bj * HALF + n * 16) = bs + acc[ai][bj][m][n]; }  asm volatile("" ::: "memory"); }
    }
};

struct EpiResidN {
    static constexpr bool PERM = false, AFTER_DRAIN = false;
    const float* base; float* out; bf16_t* xb; float* ss; int ldc;
    __device__ __forceinline__ void operator()(const f32x4 (&acc)[2][2][4][2], const Unit& u, int wr, int wc, int fr, int fq) const {
        typedef unsigned u32x2 __attribute__((ext_vector_type(2)));
        const int col0 = u.pn * BM + wc * 32 + 4 * fq, lane = fr + 16 * fq;
#pragma unroll
        for (int ai = 0; ai < 2; ++ai)
#pragma unroll
            for (int m = 0; m < 4; ++m) { const int row = u.pm * BM + ai * HALF + wr * 64 + m * 16 + fr; const size_t off = (size_t)row * ldc + col0; float sq = 0.f;
#pragma unroll
                for (int bj = 0; bj < 2; ++bj)
#pragma unroll
                    for (int n = 0; n < 2; ++n) { const f32x4 bs = *(const f32x4*)(base + off + bj * HALF + n * 16); const f32x4 o = bs + acc[ai][bj][m][n];
                        *(f32x4*)(out + off + bj * HALF + n * 16) = o; sq += (o[0] * o[0] + o[1] * o[1]) + (o[2] * o[2] + o[3] * o[3]);
                        u32x2 w; w.x = cvt_pk_bf16(o[0], o[1]); w.y = cvt_pk_bf16(o[2], o[3]); *(u32x2*)(xb + off + bj * HALF + n * 16) = w; }
                sq += __int_as_float(__builtin_amdgcn_ds_bpermute((lane ^ 16) << 2, __float_as_int(sq))); sq += __int_as_float(__builtin_amdgcn_ds_bpermute((lane ^ 32) << 2, __float_as_int(sq)));
                if (fq == 0) ss[(size_t)row * 16 + u.pn * 4 + wc] = sq;
                asm volatile("" ::: "memory"); }
    }
};
struct EpiRes {
    static constexpr bool PERM = false, AFTER_DRAIN = false;
    const float* basef; const bf16_t* baseb; float* out; bf16_t* xb; float* ss;
    __device__ __forceinline__ void operator()(const f32x4 (&acc)[2][2][4][2], const Unit& u, int wr, int wc, int fr, int fq) const {
        typedef unsigned u32x2 __attribute__((ext_vector_type(2)));
        constexpr int ldc = 1024; const int col0 = u.pn * BM + wc * 32 + 4 * fq, lane = fr + 16 * fq;
#pragma unroll
        for (int ai = 0; ai < 2; ++ai)
#pragma unroll
            for (int m = 0; m < 4; ++m) { const int row = u.pm * BM + ai * HALF + wr * 64 + m * 16 + fr; const size_t off = (size_t)row * ldc + col0; float sq = 0.f;
#pragma unroll
                for (int bj = 0; bj < 2; ++bj)
#pragma unroll
                    for (int n = 0; n < 2; ++n) { const size_t o2 = off + bj * HALF + n * 16; f32x4 bs;
                        if (baseb) { const u32x2 b2 = *(const u32x2*)(baseb + o2); bs = (f32x4){__uint_as_float(b2.x << 16), __uint_as_float(b2.x & 0xffff0000u), __uint_as_float(b2.y << 16), __uint_as_float(b2.y & 0xffff0000u)}; }
                        else bs = *(const f32x4*)(basef + o2);
                        const f32x4 o = bs + acc[ai][bj][m][n];
                        if (out) *(f32x4*)(out + o2) = o;
                        if (xb) { sq += (o[0] * o[0] + o[1] * o[1]) + (o[2] * o[2] + o[3] * o[3]); u32x2 w; w.x = cvt_pk_bf16(o[0], o[1]); w.y = cvt_pk_bf16(o[2], o[3]); *(u32x2*)(xb + o2) = w; } }
                if (xb) { sq += __int_as_float(__builtin_amdgcn_ds_bpermute((lane ^ 16) << 2, __float_as_int(sq))); sq += __int_as_float(__builtin_amdgcn_ds_bpermute((lane ^ 32) << 2, __float_as_int(sq)));
                    if (fq == 0) ss[(size_t)row * 16 + u.pn * 4 + wc] = sq; }
                asm volatile("" ::: "memory"); }
    }
};
struct EpiRelu2S {
    static constexpr bool PERM = true, AFTER_DRAIN = false;
    bf16_t* O; const float* ss; int ldc;
    __device__ __forceinline__ void operator()(const f32x4 (&acc)[2][2][4][2], const Unit& u, int wr, int wc, int fr, int fq) const {
        const int row0 = u.pm * BM + wr * 64 + fr; const int col0 = u.pn * BM + wc * 32 + 8 * fq;
#pragma unroll
        for (int ai = 0; ai < 2; ++ai)
#pragma unroll
            for (int m = 0; m < 4; ++m) { const int row = row0 + ai * HALF + m * 16; bf16_t* rowp = O + (size_t)row * ldc + col0;
                const float rs = row_rstd(ss, row);
#pragma unroll
                for (int bj = 0; bj < 2; ++bj) { f32x4 v0 = acc[ai][bj][m][0], v1 = acc[ai][bj][m][1];
#pragma unroll
                    for (int e = 0; e < 4; ++e) { const float a = fmaxf(v0[e] * rs, 0.f), b = fmaxf(v1[e] * rs, 0.f); v0[e] = a * a; v1[e] = b * b; }
                    u32x4 w; w.x = cvt_pk_bf16(v0[0], v0[1]); w.y = cvt_pk_bf16(v0[2], v0[3]); w.z = cvt_pk_bf16(v1[0], v1[1]); w.w = cvt_pk_bf16(v1[2], v1[3]);
                    *(u32x4*)(rowp + bj * HALF) = w; } }
    }
};

template <class Epi, class Sched, bool ALIGN_EPI = false, bool SP2 = false>
__device__ __forceinline__ void gemm_phase(PG8_LAS unsigned char* lds, const Gemm g, const Sched& S, const Epi& E) {
    int tid_l = threadIdx.x; asm volatile("" : "+v"(tid_l));
    const int tid = tid_l, wid = __builtin_amdgcn_readfirstlane(tid >> 6), lane = tid & 63, wr = wid >> 2, wc = wid & 3, fr = lane & 15, fq = lane >> 4;
    const int K = g.K, nt = K / BK;
    unsigned voffA[2], voffB[2];
#pragma unroll
    for (int i = 0; i < 2; ++i) { int R, C; stage_rc(tid * 16 + i * 8192, R, C); const int Rb = Epi::PERM ? ((R & ~31) + perm32(R & 31)) : R;
        voffA[i] = (unsigned)(R * K + C) * 2u; voffB[i] = (unsigned)(Rb * K + C) * 2u; }
    const size_t kstep = (size_t)(BK * 2);
    const size_t hstep = (size_t)HALF * K * 2;
    const size_t tstep = 2 * hstep;
    const unsigned ldsw = (unsigned)wid * 1024u;
    const int aoff = lds_byte(wr * 64 + fr, fq * 8), boff = lds_byte(wc * 32 + fr, fq * 8);
#define PG8_SA(b, h) (((b) * 2 + (h)) * HTB)
#define PG8_SB(b, h) ((4 + (b) * 2 + (h)) * HTB)
#define PG8_STAGE(bufoff, gbase, voff) do { _Pragma("unroll") for (int _i = 0; _i < 2; ++_i) \
        __builtin_amdgcn_global_load_lds((const unsigned*)((const char*)(gbase) + (voff)[_i]), (PG8_LAS unsigned*)(lds + (bufoff) + ldsw + _i * 8192), 16, 0, 0); } while (0)
#define PG8_LDA(dst, b, h) do { _Pragma("unroll") for (int m = 0; m < 4; ++m) _Pragma("unroll") for (int k = 0; k < 2; ++k) dst[m][k] = *(const PG8_LAS bf16x8*)(lds + PG8_SA(b, h) + aoff + m * 2048 + k * 1024); } while (0)
#define PG8_LDB(dst, b, h) do { _Pragma("unroll") for (int n = 0; n < 2; ++n) _Pragma("unroll") for (int k = 0; k < 2; ++k) dst[n][k] = *(const PG8_LAS bf16x8*)(lds + PG8_SB(b, h) + boff + n * 2048 + k * 1024); } while (0)
#define PG8_MMA(ai, bj, At, Bt) do { __builtin_amdgcn_s_setprio(1); _Pragma("unroll") for (int m = 0; m < 4; ++m) _Pragma("unroll") for (int n = 0; n < 2; ++n) _Pragma("unroll") for (int k = 0; k < 2; ++k) \
        acc[ai][bj][m][n] = __builtin_amdgcn_mfma_f32_16x16x32_bf16(Bt[n][k], At[m][k], acc[ai][bj][m][n], 0, 0, 0); __builtin_amdgcn_s_setprio(0); } while (0)
#define PG8_WAIT_V(n) asm volatile("s_waitcnt vmcnt(" #n ")" ::: "memory")
#define PG8_WAIT_L(n) asm volatile("s_waitcnt lgkmcnt(" #n ")" ::: "memory")
#define PG8_BAR __builtin_amdgcn_s_barrier()
#define PG8_SCHED __builtin_amdgcn_sched_barrier(0)
    Unit cur, nxt; int ui = 0;
    if (!S.next(0, cur)) return;
    f32x4 acc[2][2][4][2];
#pragma unroll
    for (int a = 0; a < 2; ++a)
#pragma unroll
        for (int b = 0; b < 2; ++b)
#pragma unroll
            for (int m = 0; m < 4; ++m)
#pragma unroll
                for (int n = 0; n < 2; ++n) acc[a][b][m][n] = (f32x4){0.f, 0.f, 0.f, 0.f};
    bf16x8 At[4][2], B0[2][2], B1[2][2];
    const char* cA = (const char*)g.A + (size_t)cur.pm * tstep; const char* cB = (const char*)g.Bt + (size_t)cur.pn * tstep;
    S.a_ready(cur);
    if constexpr (SP2) {
        PG8_STAGE(PG8_SB(0, 0), cB, voffB); PG8_STAGE(PG8_SB(0, 1), cB + hstep, voffB); PG8_STAGE(PG8_SA(0, 0), cA, voffA); PG8_STAGE(PG8_SA(0, 1), cA + hstep, voffA);
        if (wr == 1) PG8_BAR;
        PG8_WAIT_V(2); PG8_BAR;
        PG8_STAGE(PG8_SB(1, 0), cB + kstep, voffB); PG8_STAGE(PG8_SA(1, 0), cA + kstep, voffA); PG8_STAGE(PG8_SB(1, 1), cB + hstep + kstep, voffB);
        PG8_WAIT_V(6); PG8_BAR;
    } else {
        PG8_STAGE(PG8_SB(0, 0), cB, voffB); PG8_STAGE(PG8_SA(0, 0), cA, voffA); PG8_STAGE(PG8_SB(0, 1), cB + hstep, voffB); PG8_STAGE(PG8_SA(0, 1), cA + hstep, voffA);
        if (wr == 1) PG8_BAR;
        PG8_WAIT_V(4); PG8_BAR;
        PG8_STAGE(PG8_SB(1, 0), cB + kstep, voffB); PG8_STAGE(PG8_SA(1, 0), cA + kstep, voffA); PG8_STAGE(PG8_SB(1, 1), cB + hstep + kstep, voffB);
        PG8_WAIT_V(6); PG8_BAR;
    }
    for (;;) {
        const bool has_next = S.next(ui + 1, nxt);
        const char* nA = has_next ? (const char*)g.A + (size_t)nxt.pm * tstep : cA; const char* nB = has_next ? (const char*)g.Bt + (size_t)nxt.pn * tstep : cB;
        for (int t = 0; t < nt; t += 2) {
            const bool last = (t == nt - 2);
            const char* a1 = cA + (size_t)(t + 1) * kstep;
            const char* a2 = last ? nA : cA + (size_t)(t + 2) * kstep; const char* b2 = last ? nB : cB + (size_t)(t + 2) * kstep;
            const char* a3 = a2 + kstep; const char* b3 = b2 + kstep;
            if (last && has_next) S.a_ready(nxt);
            if constexpr (SP2) {
            PG8_LDB(B0, 0, 0); PG8_LDB(B1, 0, 1); PG8_SCHED; PG8_LDA(At, 0, 0); PG8_STAGE(PG8_SA(1, 1), a1 + hstep, voffA);
            PG8_WAIT_V(8); PG8_WAIT_L(0); PG8_BAR; PG8_MMA(0, 0, At, B0); PG8_MMA(0, 1, At, B1); PG8_BAR; PG8_SCHED;
            PG8_LDA(At, 0, 1); PG8_STAGE(PG8_SB(0, 0), b2, voffB); PG8_STAGE(PG8_SB(0, 1), b2 + hstep, voffB); PG8_STAGE(PG8_SA(0, 0), a2, voffA);
            PG8_WAIT_V(8); PG8_WAIT_L(0); PG8_BAR; PG8_MMA(1, 0, At, B0); PG8_MMA(1, 1, At, B1); PG8_BAR; PG8_SCHED;
            PG8_LDB(B0, 1, 0); PG8_LDB(B1, 1, 1); PG8_SCHED; PG8_LDA(At, 1, 0); PG8_STAGE(PG8_SA(0, 1), a2 + hstep, voffA);
            PG8_WAIT_V(8); PG8_WAIT_L(0); PG8_BAR; PG8_MMA(0, 0, At, B0); PG8_MMA(0, 1, At, B1); PG8_BAR; PG8_SCHED;
            PG8_LDA(At, 1, 1); PG8_STAGE(PG8_SB(1, 0), b3, voffB); PG8_STAGE(PG8_SB(1, 1), b3 + hstep, voffB); PG8_STAGE(PG8_SA(1, 0), a3, voffA);
            PG8_WAIT_V(8); PG8_WAIT_L(0); PG8_BAR; PG8_MMA(1, 0, At, B0); PG8_MMA(1, 1, At, B1); PG8_BAR; PG8_SCHED;
            } else {
            PG8_LDB(B0, 0, 0); PG8_SCHED; PG8_LDA(At, 0, 0); PG8_STAGE(PG8_SA(1, 1), a1 + hstep, voffA);
            PG8_WAIT_L(8); PG8_BAR; PG8_WAIT_L(0); PG8_MMA(0, 0, At, B0); PG8_BAR; PG8_SCHED;
            PG8_LDB(B1, 0, 1); PG8_STAGE(PG8_SB(0, 0), b2, voffB);
            PG8_BAR; PG8_WAIT_L(0); PG8_MMA(0, 1, At, B1); PG8_BAR;
            PG8_LDA(At, 0, 1); PG8_STAGE(PG8_SA(0, 0), a2, voffA);
            PG8_BAR; PG8_WAIT_L(0); PG8_MMA(1, 0, At, B0); PG8_BAR; PG8_SCHED;
            PG8_STAGE(PG8_SB(0, 1), b2 + hstep, voffB);
            PG8_WAIT_V(6); PG8_BAR; PG8_MMA(1, 1, At, B1); PG8_BAR;
            PG8_LDB(B0, 1, 0); PG8_SCHED; PG8_LDA(At, 1, 0); PG8_STAGE(PG8_SA(0, 1), a2 + hstep, voffA);
            PG8_WAIT_L(8); PG8_BAR; PG8_WAIT_L(0); PG8_MMA(0, 0, At, B0); PG8_BAR; PG8_SCHED;
            PG8_LDB(B1, 1, 1); PG8_STAGE(PG8_SB(1, 0), b3, voffB);
            PG8_BAR; PG8_WAIT_L(0); PG8_MMA(0, 1, At, B1); PG8_BAR;
            PG8_LDA(At, 1, 1); PG8_STAGE(PG8_SA(1, 0), a3, voffA);
            PG8_BAR; PG8_WAIT_L(0); PG8_MMA(1, 0, At, B0); PG8_BAR; PG8_SCHED;
            PG8_STAGE(PG8_SB(1, 1), b3 + hstep, voffB);
            PG8_WAIT_V(6); PG8_BAR; PG8_MMA(1, 1, At, B1); PG8_BAR;
            }
        }
        if constexpr (ALIGN_EPI) { if (wr == 0) PG8_BAR; }
        if constexpr (!Epi::AFTER_DRAIN) { E(acc, cur, wr, wc, fr, fq); S.done(cur); }
        if (!has_next) break;
#pragma unroll
        for (int a = 0; a < 2; ++a)
#pragma unroll
            for (int b = 0; b < 2; ++b)
#pragma unroll
                for (int m = 0; m < 4; ++m)
#pragma unroll
                    for (int n = 0; n < 2; ++n) acc[a][b][m][n] = (f32x4){0.f, 0.f, 0.f, 0.f};
        cur = nxt; cA = nA; cB = nB; ++ui;
        if constexpr (ALIGN_EPI) { if (wr == 1) PG8_BAR; }
    }
    PG8_WAIT_V(0);
    if constexpr (!ALIGN_EPI) { if (wr == 0) PG8_BAR; }
    PG8_BAR;
    if constexpr (Epi::AFTER_DRAIN) { E.fused(acc, cur, wr, wc, fr, fq, lds, wid, lane); S.done(cur); }
#undef PG8_SA
#undef PG8_SB
#undef PG8_STAGE
#undef PG8_LDA
#undef PG8_LDB
#undef PG8_MMA
#undef PG8_WAIT_V
#undef PG8_WAIT_L
#undef PG8_BAR
#undef PG8_SCHED
}
}

#ifndef PG8_SP2
#define PG8_SP2 true
#endif
#ifndef PG8_ALIGN
#define PG8_ALIGN true
#endif
#include <hip/hip_bf16.h>
#include <cmath>
namespace attn_body {
using bf16=__hip_bfloat16;
using bf16x8=__attribute__((ext_vector_type(8)))short;
using s16x4=__attribute__((ext_vector_type(4)))short;
using f32x16=__attribute__((ext_vector_type(16)))float;
using u32x4=__attribute__((ext_vector_type(4)))unsigned;
constexpr int SEQ=8192,D=64;
constexpr int NW=8,QBLK=32,QB=QBLK*NW,KVBLK=64,NQB=SEQ/QB;
constexpr int ATTN_UNIT_ROWS=QB;
__device__ __forceinline__ int crow(int r,int hi){return (r&3)+8*(r>>2)+4*hi;}
#define SBAR() __builtin_amdgcn_sched_barrier(0)
__device__ __forceinline__ void cmask(f32x16&p0,f32x16&p1,int jb,int qrel,int hi){
  const float NEG=-INFINITY; int kb=64*jb+4*hi;
  #pragma unroll
  for(int r=0;r<16;++r){int kv=kb+(r&3)+8*(r>>2); if(kv>qrel)p0[r]=NEG; if(kv+32>qrel)p1[r]=NEG;}
}

constexpr int NSLOT=3, SLOTB=8192;
constexpr int LDS_K=0, LDS_V=NSLOT*SLOTB, LDS_WS=2*NSLOT*SLOTB, LDS_OST=LDS_WS+NW*64*4, LDS_BYTES=LDS_OST+NW*4096;
constexpr float C2=0.125f*1.4426950408889634f;
__device__ __forceinline__ void glds16(const void*gsrc,unsigned lds_dst){unsigned keep;
  asm volatile("s_mov_b32 %0, m0\n\ts_mov_b32 m0, %2\n\ts_nop 0\n\tglobal_load_lds_dwordx4 %1, off\n\ts_mov_b32 m0, %0":"=&s"(keep):"v"(gsrc),"s"(lds_dst):"memory");}
__device__ __forceinline__ float max3f(float a,float b,float c){float r;asm("v_max3_f32 %0, %1, %2, %3":"=v"(r):"v"(a),"v"(b),"v"(c));return r;}
__device__ __forceinline__ float max2f(float a,float b){float r;asm("v_max_f32_e32 %0, %1, %2":"=v"(r):"v"(a),"v"(b));return r;}
__device__ __forceinline__ float fadd_s(float a,float b){float r;asm("v_add_f32_e32 %0, %1, %2":"=v"(r):"v"(a),"v"(b));return r;}
__device__ __forceinline__ float fsub_s(float a,float b){float r;asm("v_sub_f32_e32 %0, %1, %2":"=v"(r):"v"(a),"v"(b));return r;}
typedef float f32x2_t __attribute__((ext_vector_type(2))); typedef __bf16 bf16x2_t __attribute__((ext_vector_type(2)));
__device__ __forceinline__ unsigned cvtpk_s(float lo,float hi){f32x2_t v={lo,hi};bf16x2_t b=__builtin_convertvector(v,bf16x2_t);return __builtin_bit_cast(unsigned,b);}
#define WAIT_BAR(N) asm volatile("s_waitcnt vmcnt(" #N ") lgkmcnt(0)\n\ts_barrier":::"memory")

__device__ __forceinline__ void qkt(f32x16&p0,f32x16&p1,const char*Kslot,const bf16x8*qr,const f32x16&negm,int r32,int hi){
  const char*kb=Kslot+hi*1024+r32*16;
  #pragma unroll
  for(int d0=0;d0<4;++d0){
    const bf16x8 b0=*reinterpret_cast<const bf16x8*>(kb+d0*2048);
    const bf16x8 b1=*reinterpret_cast<const bf16x8*>(kb+d0*2048+512);
    if(d0==0){p0=__builtin_amdgcn_mfma_f32_32x32x16_bf16(b0,qr[0],negm,0,0,0);p1=__builtin_amdgcn_mfma_f32_32x32x16_bf16(b1,qr[0],negm,0,0,0);}
    else{p0=__builtin_amdgcn_mfma_f32_32x32x16_bf16(b0,qr[d0],p0,0,0,0);p1=__builtin_amdgcn_mfma_f32_32x32x16_bf16(b1,qr[d0],p1,0,0,0);}}
}
typedef __attribute__((address_space(3))) const char* lds_cptr;
typedef short v4i16_t __attribute__((ext_vector_type(4)));
__device__ __forceinline__ void kload8(bf16x8*kf,lds_cptr kp){
  kf[0]=*(const __attribute__((address_space(3))) bf16x8*)(kp);      kf[1]=*(const __attribute__((address_space(3))) bf16x8*)(kp+512);
  kf[2]=*(const __attribute__((address_space(3))) bf16x8*)(kp+2048); kf[3]=*(const __attribute__((address_space(3))) bf16x8*)(kp+2560);
  kf[4]=*(const __attribute__((address_space(3))) bf16x8*)(kp+4096); kf[5]=*(const __attribute__((address_space(3))) bf16x8*)(kp+4608);
  kf[6]=*(const __attribute__((address_space(3))) bf16x8*)(kp+6144); kf[7]=*(const __attribute__((address_space(3))) bf16x8*)(kp+6656);
}
__device__ __forceinline__ void kload2(bf16x8*kf,lds_cptr kp,int j){ kf[2*j]=*(const __attribute__((address_space(3))) bf16x8*)(kp+j*2048); kf[2*j+1]=*(const __attribute__((address_space(3))) bf16x8*)(kp+j*2048+512); }
__device__ __forceinline__ s16x4 vtr(lds_cptr p){ return __builtin_bit_cast(s16x4,__builtin_amdgcn_ds_read_tr16_b64_v4i16((__attribute__((address_space(3))) v4i16_t*)p)); }
__device__ __forceinline__ float rowmax(const f32x16&p0,const f32x16&p1){
  float a=max3f(p0[0],p0[1],p1[0]),b=max3f(p0[2],p0[3],p1[1]);a=max3f(a,p1[2],p1[3]);
  #pragma unroll
  for(int r=4;r<16;r+=4){a=max3f(a,p0[r],p0[r+1]);b=max3f(b,p0[r+2],p0[r+3]);a=max3f(a,p1[r],p1[r+1]);b=max3f(b,p1[r+2],p1[r+3]);}
  const float m=max2f(a,b);
  auto rr=__builtin_amdgcn_permlane32_swap(__float_as_uint(m),__float_as_uint(m),false,false);
  return max2f(__uint_as_float(rr[0]),__uint_as_float(rr[1]));
}
__device__ __forceinline__ void pv(f32x16*o,int vb,bf16x8 pa0,bf16x8 pa1,bf16x8 pa2,bf16x8 pa3){
  #pragma unroll
  for(int d0=0;d0<2;++d0){s16x4 lo[4],hi[4];
    #pragma unroll
    for(int ks=0;ks<4;++ks){
      asm volatile("ds_read_b64_tr_b16 %0,%1 offset:%c2":"=&v"(lo[ks]):"v"(vb),"i"(d0*4096+ks*1024):"memory");
      asm volatile("ds_read_b64_tr_b16 %0,%1 offset:%c2":"=&v"(hi[ks]):"v"(vb),"i"(d0*4096+ks*1024+512):"memory");}
    asm volatile("s_waitcnt lgkmcnt(0)":::"memory");SBAR();
    #define PK(k) (bf16x8){lo[k][0],lo[k][1],lo[k][2],lo[k][3],hi[k][0],hi[k][1],hi[k][2],hi[k][3]}
    o[d0]=__builtin_amdgcn_mfma_f32_32x32x16_bf16(pa0,PK(0),o[d0],0,0,0);
    o[d0]=__builtin_amdgcn_mfma_f32_32x32x16_bf16(pa1,PK(1),o[d0],0,0,0);
    o[d0]=__builtin_amdgcn_mfma_f32_32x32x16_bf16(pa2,PK(2),o[d0],0,0,0);
    o[d0]=__builtin_amdgcn_mfma_f32_32x32x16_bf16(pa3,PK(3),o[d0],0,0,0);
    #undef PK
  }
}

#ifndef ATTN_STORE16
#define ATTN_STORE16(p,v) (*(u32x4*)(p)=(v))
#endif
__device__ __forceinline__ void swamask(f32x16&p0,f32x16&p1,int kvrel,int qrel,int hi){
  const float NEG=-INFINITY; const int kb=kvrel+4*hi-qrel;
  #pragma unroll
  for(int r=0;r<16;++r){int dl=kb+(r&3)+8*(r>>2); if(dl>128||dl<-128)p0[r]=NEG; if(dl+32>128||dl+32<-128)p1[r]=NEG;}
}
template<int THRL,int MODE> __device__ __forceinline__ void attn_unit(const bf16*Qb,int qp,const bf16*__restrict__ Kh,int kp,const bf16*__restrict__ Vh,int vp,bf16*Ob,int op,int q0,float sink_l2,char*shm,int kv0=0,float*stats=nullptr,bool primed=false,bool prime_next=false){
  int tid_l=threadIdx.x; asm volatile("":"+v"(tid_l));
  const int tid=tid_l,lane=tid&63,r32=lane&31,hi=lane>>5; const int wid=__builtin_amdgcn_readfirstlane(tid>>6);
  const bf16*Qw=Qb+(long)(q0+wid*QBLK)*qp;
  const unsigned ord=(MODE==1)?((q0==0)?0x765243u:((q0==SEQ-QB)?0x015243u:0x70615243u)):0u;
  #define KVS(t) ((MODE==1)?(q0-128+64*(int)((ord>>(4*(t)))&15u)):((MODE==2)?(kv0+64*(t)):(64*(t))))
  const unsigned lds0=(unsigned)(uintptr_t)shm;
  float*wsf=(float*)(shm+LDS_WS)+wid*64;
  const bf16*ksrc=Kh+(long)lane*kp+wid*8;
  const bf16*vsrc=Vh+(long)(16*(wid&3)+(lane>>2))*vp+(wid>>2)*32+(lane&3)*8;
  const unsigned kdst=lds0+LDS_K+wid*1024, vdst=lds0+LDS_V+wid*1024;
  #define DMA_K(t,slot) glds16(ksrc+(long)KVS(t)*kp,(unsigned)__builtin_amdgcn_readfirstlane(kdst+(slot)))
  #define DMA_V(t,slot) glds16(vsrc+(long)KVS(t)*vp,(unsigned)__builtin_amdgcn_readfirstlane(vdst+(slot)))
  const int vb0=(int)(lds0+LDS_V)+((lane>>4)&1)*32+(lane&3)*8+(4*hi+((lane&15)>>2))*64;
  const char*Kbase=shm+LDS_K; bf16x8 kf[8];
  const lds_cptr shm3=(lds_cptr)shm; const lds_cptr kp0=shm3+LDS_K+hi*1024+r32*16; const lds_cptr vp0=shm3+LDS_V+((lane>>4)&1)*32+(lane&3)*8+(4*hi+((lane&15)>>2))*64;
  const int NT=(MODE==1)?((q0==0||q0==SEQ-QB)?6:8):((MODE==2)?(SEQ/KVBLK/4):(SEQ/KVBLK));
  if(!primed){DMA_K(0,0);DMA_V(0,0);DMA_K(1,SLOTB);}
  bf16x8 qr[4];
  #pragma unroll
  for(int d0=0;d0<4;++d0)qr[d0]=*reinterpret_cast<const bf16x8*>(&Qw[(long)r32*qp+d0*16+hi*8]);
  float mhat=0.f,l_reg=0.f;float z0_=0.f;asm volatile("":"+v"(z0_));f32x16 o[2],negm;
  #pragma unroll
  for(int r=0;r<16;++r){o[0][r]=z0_;o[1][r]=z0_;negm[r]=z0_;}
  asm volatile("":"+v"(negm));
  const int qrel=wid*QBLK+r32;
  #define CMASK(P0,P1,t) do{ if constexpr(MODE==1) swamask(P0,P1,KVS(t)-q0,qrel,hi); }while(0)
  bool resc=false;
  #define START(P0,P1) do{ const float rm=rowmax(P0,P1); resc=false; \
    { const float dl=rm; mhat=fadd_s(mhat,dl); \
      _Pragma("unroll") for(int r=0;r<16;++r){P0[r]=fsub_s(P0[r],dl);P1[r]=fsub_s(P1[r],dl);} \
      _Pragma("unroll") for(int r=0;r<16;++r)negm[r]=-mhat; asm volatile("":"+v"(negm)); } \
    _Pragma("unroll") for(int r=0;r<16;++r)P0[r]=__builtin_amdgcn_exp2f(P0[r]); }while(0)
  #define RESC() do{ if(resc){ asm volatile("s_waitcnt lgkmcnt(0)":::"memory"); \
      _Pragma("unroll") for(int d_=0;d_<2;++d_) _Pragma("unroll") for(int r=0;r<16;++r)o[d_][r]*=wsf[crow(r,hi)]; } }while(0)
  f32x16 pA0,pA1,pB0,pB1;
  int sl_prev=0,sl_cur=0,sl_next=SLOTB;
  #define ROT() do{sl_prev=sl_cur;sl_cur=sl_next;sl_next=(sl_next==(NSLOT-1)*SLOTB)?0:sl_next+SLOTB;}while(0)
  DMA_K(2,2*SLOTB);
  WAIT_BAR(3);
  qkt(pA0,pA1,Kbase,qr,negm,r32,hi);asm volatile("s_nop 15\n\ts_nop 7":"+v"(pA0),"+v"(pA1));CMASK(pA0,pA1,0);
  START(pA0,pA1);
  _Pragma("unroll") for(int r=0;r<16;++r)pA1[r]=__builtin_amdgcn_exp2f(pA1[r]);
  WAIT_BAR(0);
  DMA_K(3,0);DMA_V(1,SLOTB);
  ROT();
  kload8(kf,kp0+sl_cur);
  WAIT_BAR(2);
  s16x4 vlo[8],vhi[8]; u32x4 pw0,pw1,pw2,pw3;
  #define PKW(P,B) cvtpk_s(P[B],P[B+1])
  #define PAF(k) __builtin_bit_cast(bf16x8,pw##k)
  #define VFR(i) (bf16x8){vlo[i][0],vlo[i][1],vlo[i][2],vlo[i][3],vhi[i][0],vhi[i][1],vhi[i][2],vhi[i][3]}
  #define PIN(x) asm volatile("":"+v"(x))
  #define MX3(a,b,c) __builtin_fmaxf(__builtin_fmaxf((a),(b)),(c))
  #define GAPA(MF,A0,A1,A2,A3,W0,W1,PW) do{ MF; sacc+=A0; sacc+=A1; sacc+=A2; sacc+=A3; PIN(sacc); W0; W1; PIN(PW); SBAR(); }while(0)
  #define EX(v) __builtin_amdgcn_exp2f(v)
  #define GAPB(MF,X,B) do{ MF; X[B]=EX(X[B]); X[B+1]=EX(X[B+1]); X[B+2]=EX(X[B+2]); X[B+3]=EX(X[B+3]); PIN(X); SBAR(); }while(0)
  #define VRD(i) do{ vlo[i]=vtr(vp_+(((i)>>2)*4096+((i)&3)*1024)); vhi[i]=vtr(vp_+(((i)>>2)*4096+((i)&3)*1024+512)); }while(0)
  #define KRD(G,j) do{ if(G){ kload2(kf,kp0+sl_next,j); SBAR(); } }while(0)
  #define STEP(C0,C1,P0,P1,t,GK,GV,GL) do{ SBAR(); \
    const lds_cptr vp_=vp0+sl_prev; \
    __builtin_amdgcn_s_setprio(1); VRD(0); SBAR(); float sacc=(P0[0]+P0[1]); \
    GAPA(C0=__builtin_amdgcn_mfma_f32_32x32x16_bf16(kf[0],qr[0],negm,0,0,0), P0[2],P0[3],P0[4],P0[5],     pw0[0]=PKW(P0,0), pw0[1]=PKW(P0,2), pw0); \
    VRD(4); SBAR(); GAPA(C1=__builtin_amdgcn_mfma_f32_32x32x16_bf16(kf[1],qr[0],negm,0,0,0), P0[6],P0[7],P0[8],P0[9],     pw0[2]=PKW(P0,4), pw0[3]=PKW(P0,6), pw0); \
    VRD(1); SBAR(); GAPA(C0=__builtin_amdgcn_mfma_f32_32x32x16_bf16(kf[2],qr[1],C0,0,0,0),   P0[10],P0[11],P0[12],P0[13], pw1[0]=PKW(P0,8), pw1[1]=PKW(P0,10), pw1); \
    VRD(5); SBAR(); GAPA(C1=__builtin_amdgcn_mfma_f32_32x32x16_bf16(kf[3],qr[1],C1,0,0,0),   P0[14],P0[15],P1[0],P1[1],   pw1[2]=PKW(P0,12),pw1[3]=PKW(P0,14), pw1); \
    VRD(2); SBAR(); GAPA(C0=__builtin_amdgcn_mfma_f32_32x32x16_bf16(kf[4],qr[2],C0,0,0,0),   P1[2],P1[3],P1[4],P1[5],     pw2[0]=PKW(P1,0), pw2[1]=PKW(P1,2), pw2); \
    VRD(6); SBAR(); GAPA(C1=__builtin_amdgcn_mfma_f32_32x32x16_bf16(kf[5],qr[2],C1,0,0,0),   P1[6],P1[7],P1[8],P1[9],     pw2[2]=PKW(P1,4), pw2[3]=PKW(P1,6), pw2); \
    VRD(3); SBAR(); GAPA(C0=__builtin_amdgcn_mfma_f32_32x32x16_bf16(kf[6],qr[3],C0,0,0,0),   P1[10],P1[11],P1[12],P1[13], pw3[0]=PKW(P1,8), pw3[1]=PKW(P1,10), pw3); \
    VRD(7); SBAR(); GAPA(C1=__builtin_amdgcn_mfma_f32_32x32x16_bf16(kf[7],qr[3],C1,0,0,0),   P1[14],P1[15],0.f,0.f,       pw3[2]=PKW(P1,12),pw3[3]=PKW(P1,14), pw3); \
    l_reg+=sacc; __builtin_amdgcn_s_setprio(0); \
    if(GK){DMA_K((t)+3,sl_cur);} if(GV){DMA_V((t)+1,sl_next);} \
    CMASK(C0,C1,t); \
    { float a=MX3(C0[0],C0[1],C1[0]),b=MX3(C0[2],C0[3],C1[1]); a=MX3(a,C1[2],C1[3]); \
      _Pragma("unroll") for(int r=4;r<16;r+=4){a=MX3(a,C0[r],C0[r+1]);b=MX3(b,C0[r+2],C0[r+3]);a=MX3(a,C1[r],C1[r+1]);b=MX3(b,C1[r+2],C1[r+3]);} \
      float rm=__builtin_fmaxf(a,b); { auto rr=__builtin_amdgcn_permlane32_swap(__float_as_uint(rm),__float_as_uint(rm),false,false); rm=__builtin_fmaxf(__uint_as_float(rr[0]),__uint_as_float(rr[1])); } \
      resc=false; \
      if(__builtin_expect(__any(rm>(float)THRL),0)){ const float dl=__builtin_fmaxf(rm,0.f); mhat+=dl; \
        _Pragma("unroll") for(int r=0;r<16;++r){C0[r]-=dl;C1[r]-=dl;} \
        _Pragma("unroll") for(int r=0;r<16;++r)negm[r]=-mhat; asm volatile("":"+v"(negm)); \
        const float f=__builtin_amdgcn_exp2f(-dl); l_reg*=f; if(hi==0)wsf[r32]=f; resc=true; } } \
    SBAR(); \
    __builtin_amdgcn_s_setprio(1); \
    GAPB(o[0]=__builtin_amdgcn_mfma_f32_32x32x16_bf16(PAF(0),VFR(0),o[0],0,0,0), C0,0); \
    GAPB(o[1]=__builtin_amdgcn_mfma_f32_32x32x16_bf16(PAF(0),VFR(4),o[1],0,0,0), C0,4); \
    KRD(GL,0); GAPB(o[0]=__builtin_amdgcn_mfma_f32_32x32x16_bf16(PAF(1),VFR(1),o[0],0,0,0), C0,8); \
    KRD(GL,1); GAPB(o[1]=__builtin_amdgcn_mfma_f32_32x32x16_bf16(PAF(1),VFR(5),o[1],0,0,0), C0,12); \
    KRD(GL,2); GAPB(o[0]=__builtin_amdgcn_mfma_f32_32x32x16_bf16(PAF(2),VFR(2),o[0],0,0,0), C1,0); \
    KRD(GL,3); GAPB(o[1]=__builtin_amdgcn_mfma_f32_32x32x16_bf16(PAF(2),VFR(6),o[1],0,0,0), C1,4); \
    GAPB(o[0]=__builtin_amdgcn_mfma_f32_32x32x16_bf16(PAF(3),VFR(3),o[0],0,0,0), C1,8); \
    GAPB(o[1]=__builtin_amdgcn_mfma_f32_32x32x16_bf16(PAF(3),VFR(7),o[1],0,0,0), C1,12); \
    __builtin_amdgcn_s_setprio(0); \
    }while(0)
  int t=1;
  for(;t+5<NT;t+=2){
    STEP(pB0,pB1,pA0,pA1,t,true,true,true);     WAIT_BAR(2); RESC(); ROT();
    STEP(pA0,pA1,pB0,pB1,t+1,true,true,true);   WAIT_BAR(2); RESC(); ROT();
  }
  #undef CMASK
  #define CMASK(P0,P1,t) do{ if constexpr(MODE==1) swamask(P0,P1,KVS(t)-q0,qrel,hi); }while(0)
  #define ENDW(tt) do{ if((tt)+3<NT){WAIT_BAR(2);} else if((tt)+2<NT){WAIT_BAR(1);} else {WAIT_BAR(0);} }while(0)
  for(;t+1<NT;t+=2){
    STEP(pB0,pB1,pA0,pA1,t,(t+3<NT),(t+1<NT),(t+1<NT));       ENDW(t);   RESC(); ROT();
    STEP(pA0,pA1,pB0,pB1,t+1,(t+4<NT),(t+2<NT),(t+2<NT));     ENDW(t+1); RESC(); ROT();
  }
  STEP(pB0,pB1,pA0,pA1,NT-1,false,false,false); RESC();
  { float sacc=pB0[0]+pB0[1]; _Pragma("unroll") for(int r=2;r<16;++r)sacc+=pB0[r]; _Pragma("unroll") for(int r=0;r<16;++r)sacc+=pB1[r]; l_reg+=sacc;
    pw0=(u32x4){PKW(pB0,0),PKW(pB0,2),PKW(pB0,4),PKW(pB0,6)};pw1=(u32x4){PKW(pB0,8),PKW(pB0,10),PKW(pB0,12),PKW(pB0,14)};pw2=(u32x4){PKW(pB1,0),PKW(pB1,2),PKW(pB1,4),PKW(pB1,6)};pw3=(u32x4){PKW(pB1,8),PKW(pB1,10),PKW(pB1,12),PKW(pB1,14)};
    SBAR(); pv(o,vb0+sl_cur,PAF(0),PAF(1),PAF(2),PAF(3)); }
  #undef PKW
  #undef PAF
  #undef VFR
  #undef PIN
  #undef MX3
  #undef GAPA
  #undef GAPB
  #undef EX
  #undef VRD
  #undef KRD
  #undef STEP
  #undef ENDW
  asm volatile("s_waitcnt lgkmcnt(0)\n\ts_barrier":::"memory");
  if(prime_next){DMA_K(0,0);DMA_V(0,0);DMA_K(1,SLOTB);}
  {auto rr=__builtin_amdgcn_permlane32_swap(__float_as_uint(l_reg),__float_as_uint(l_reg),false,false);l_reg=__uint_as_float(rr[0])+__uint_as_float(rr[1]);}
  if constexpr(MODE==1) l_reg+=__builtin_amdgcn_exp2f(sink_l2-mhat);
  if constexpr(MODE==2){ if(hi==0){ float*sp=stats+2*(long)(q0+wid*QBLK+r32); sp[0]=mhat; sp[1]=l_reg; } }
  if(hi==0)wsf[32+r32]=l_reg;asm volatile("s_waitcnt lgkmcnt(0)":::"memory");
  float rli[16];
  #pragma unroll
  for(int r=0;r<16;++r)rli[r]=__builtin_amdgcn_rcpf(wsf[32+crow(r,hi)]);
  bf16*Ow=Ob+(long)(q0+wid*QBLK)*op;
  { bf16*stg=(bf16*)(shm+LDS_OST)+wid*2048;
    #pragma unroll
    for(int r=0;r<16;++r){const int orow=crow(r,hi);
      #pragma unroll
      for(int d0=0;d0<2;++d0)stg[orow*64+d0*32+r32]=__float2bfloat16(o[d0][r]*rli[r]);}
    asm volatile("s_waitcnt lgkmcnt(0)":::"memory");
    #pragma unroll
    for(int i=0;i<4;++i){const int row=i*8+(lane>>3),ch=lane&7; const u32x4 v=*(const u32x4*)(stg+row*64+ch*8); ATTN_STORE16(Ow+(long)row*op+ch*8,v);} }
  asm volatile("s_waitcnt lgkmcnt(0)\n\ts_barrier":::"memory");
  #undef DMA_K
  #undef KVS
  #undef DMA_V
  #undef CMASK
  #undef START
  #undef RESC
  #undef ROT
}
constexpr int ATTN_LDS_BYTES=LDS_BYTES;
#undef SBAR
#undef WAIT_BAR
}
#include <hip/hip_cooperative_groups.h>
namespace cg = cooperative_groups;
#define LAS __attribute__((address_space(3)))
#define GAS __attribute__((address_space(1)))
typedef unsigned short bf16;
typedef unsigned v4u __attribute__((ext_vector_type(4)));
typedef unsigned v2u __attribute__((ext_vector_type(2)));
typedef float f32x4 __attribute__((ext_vector_type(4)));
typedef float f32x16 __attribute__((ext_vector_type(16)));
typedef short bf16x8 __attribute__((ext_vector_type(8)));
constexpr int NWAVES = 8, NTHR = 512;
constexpr int DMODEL = 1024, SEQ = 8192, MG = 2 * SEQ, NGRP = 3, DEPTH = 2, INC = 3088, NPROJ = 3072, DFF = 4096;
constexpr float EPS = 1e-6f;
constexpr float LOG2E = 1.4426950408889634f;
constexpr size_t MiB = 1u << 20;
constexpr size_t WS_ROPE = 1 * MiB;
constexpr size_t WS_WIN = 4 * MiB, WS_WOUT = 16 * MiB, WS_WUP = 20 * MiB, WS_WDN = 36 * MiB;
constexpr size_t WS_HN = 52 * MiB, WS_DNRAW = 84 * MiB, WS_Z = 108 * MiB, WS_DFQ = 116 * MiB, WS_DFK = 132 * MiB, WS_DFV = 148 * MiB;
constexpr size_t WS_SWQ = 164 * MiB, WS_SWKV = 172 * MiB, WS_BG = 180 * MiB, WS_GS = 181 * MiB;
constexpr size_t WS_QS = 182 * MiB, WS_KS = 198 * MiB, WS_KT = 214 * MiB, WS_U = 230 * MiB, WS_W = 246 * MiB;
constexpr size_t WS_ODN = 262 * MiB, WS_ODF = 294 * MiB, WS_MIX = 326 * MiB, WS_HID = 358 * MiB, WS_END = 486 * MiB;
constexpr size_t WS_WL = 3 * MiB;
constexpr size_t WS_SS2 = 497 * MiB;
constexpr size_t WS_SS = 496 * MiB;
constexpr size_t WS_PO = 486 * MiB, WS_PS = 494 * MiB;
constexpr int LDS_BYTES = 147456;
static_assert(WS_DNRAW == 84 * MiB && WS_Z == 108 * MiB && WS_DFQ == 116 * MiB && WS_DFK == 132 * MiB && WS_DFV == 148 * MiB && WS_SWQ == 164 * MiB && WS_SWKV == 172 * MiB, "EpiProj offsets");

__device__ __forceinline__ float bf2f(unsigned short b) { return __uint_as_float((unsigned)b << 16); }
__device__ __forceinline__ unsigned f2bf(float f) { unsigned u = __builtin_bit_cast(unsigned, f); return (u + 0x7fffu + ((u >> 16) & 1u)) >> 16; }
typedef float f32x2_ __attribute__((ext_vector_type(2))); typedef __bf16 bf16x2_ __attribute__((ext_vector_type(2)));
__device__ __forceinline__ unsigned pk2(float lo, float hi) { f32x2_ v = {lo, hi}; bf16x2_ b = __builtin_convertvector(v, bf16x2_); return __builtin_bit_cast(unsigned, b); }
__device__ __forceinline__ float shx(float v, int o, int lane) { return __int_as_float(__builtin_amdgcn_ds_bpermute((lane ^ o) << 2, __float_as_int(v))); }
__device__ __forceinline__ float wave_sum(float v, int lane) {
#pragma unroll
    for (int o = 1; o < 64; o <<= 1) v += shx(v, o, lane);
    return v;
}
#define MFMA32(a, b, c) __builtin_amdgcn_mfma_f32_32x32x16_bf16((a), (b), (c), 0, 0, 0)
__device__ __forceinline__ int crow(int r, int hi) { return (r & 3) + 8 * (r >> 2) + 4 * hi; }
__device__ __forceinline__ bf16x8 pack8(const f32x16& x, int s) {
    v4u p; p.x = pk2(x[8 * s], x[8 * s + 1]); p.y = pk2(x[8 * s + 2], x[8 * s + 3]); p.z = pk2(x[8 * s + 4], x[8 * s + 5]); p.w = pk2(x[8 * s + 6], x[8 * s + 7]);
    return __builtin_bit_cast(bf16x8, p);
}

#define XB_TMO      128
#define XB_XCNT(j)  (256  + 64 * (j))
#define XB_XSUB(j)  (1280 + 64 * (j))
#define XB_XGEN(j)  (2304 + 64 * (j))
#define XB_TOP      3328
#define XB_TOPGEN   3392
#define XCD_BAR_WORDS 3456
#define XB_SPIN_CAP (1u << 18)

__device__ __forceinline__ unsigned xb_ld(unsigned* p)              { return __hip_atomic_load(p, __ATOMIC_RELAXED, __HIP_MEMORY_SCOPE_AGENT); }
__device__ __forceinline__ unsigned xb_add(unsigned* p, unsigned v) { return __hip_atomic_fetch_add(p, v, __ATOMIC_RELAXED, __HIP_MEMORY_SCOPE_AGENT); }
__device__ __forceinline__ unsigned xb_xcc_id() { return (unsigned)__builtin_amdgcn_s_getreg((3 << 11) | 20) & 0xFu; }
#define XB_SPIN(cond, bar) do { unsigned _sp = 0; while (cond) { __builtin_amdgcn_s_sleep(1); \
    if ((++_sp & 255u) == 0u) { if (xb_ld(&(bar)[XB_TMO])) break; if (_sp > XB_SPIN_CAP) { atomicAdd(&(bar)[XB_TMO], 1u); break; } } } } while (0)

struct XcdBarrier {
    unsigned* bar; unsigned x;
    volatile LAS unsigned* st;
};

__device__ __forceinline__ XcdBarrier xcd_barrier_post(unsigned* bar, volatile LAS unsigned* st) {
    XcdBarrier b; b.bar = bar; b.x = xb_xcc_id(); b.st = st;
    if (threadIdx.x == 0) (void)xb_add(&bar[XB_XCNT(b.x)], 1u);
    return b;
}
__device__ __forceinline__ void xcd_barrier_complete(unsigned* bar, unsigned x, unsigned& nloc, unsigned& nx) {
    const unsigned G = gridDim.x * gridDim.y * gridDim.z;
    unsigned sum, cnt, mine, sp = 0u;
    for (;;) {
        sum = 0u; cnt = 0u; mine = 0u;
#pragma unroll
        for (unsigned j = 0; j < 16; ++j) { const unsigned c = xb_ld(&bar[XB_XCNT(j)]); sum += c; cnt += (c > 0u) ? 1u : 0u; mine = (j == x) ? c : mine; }
        if (sum == G) break;
        __builtin_amdgcn_s_sleep(1);
        if ((++sp & 255u) == 0u) { if (xb_ld(&bar[XB_TMO])) break; if (sp > XB_SPIN_CAP) { atomicAdd(&bar[XB_TMO], 1u); break; } }
    }
    nloc = mine > 0u ? mine : 1u; nx = cnt > 0u ? cnt : 1u;
}

__device__ __forceinline__ void xcd_barrier(const XcdBarrier& b) {
    asm volatile("s_waitcnt vmcnt(0)" ::: "memory");
    __syncthreads();
    if (threadIdx.x == 0) {
        unsigned* bar = b.bar;
        __builtin_amdgcn_s_waitcnt(0);
        unsigned nloc = b.st[0], nx = b.st[1];
        if (nloc == 0u) { xcd_barrier_complete(bar, b.x, nloc, nx); b.st[0] = nloc; b.st[1] = nx; }
        const unsigned old = xb_add(&bar[XB_XSUB(b.x)], 1u);
        const unsigned gen = old / nloc;
        if (old + 1u == (gen + 1u) * nloc) {
            __builtin_amdgcn_fence(__ATOMIC_RELEASE, "agent");
            asm volatile("s_waitcnt vmcnt(0)" ::: "memory");
            const unsigned og = xb_add(&bar[XB_TOP], 1u);
            const unsigned tg = og / nx;
            if (og + 1u == (tg + 1u) * nx) xb_add(&bar[XB_TOPGEN], 1u);
            else XB_SPIN(xb_ld(&bar[XB_TOPGEN]) == tg, bar);
            __builtin_amdgcn_fence(__ATOMIC_ACQUIRE, "agent");
            xb_add(&bar[XB_XGEN(b.x)], 1u);
            asm volatile("s_waitcnt vmcnt(0)" ::: "memory");
        } else {
            XB_SPIN(xb_ld(&bar[XB_XGEN(b.x)]) == gen, bar);
            __builtin_amdgcn_fence(__ATOMIC_ACQUIRE, "agent");
            asm volatile("s_waitcnt vmcnt(0)" ::: "memory");
        }
    }
    __syncthreads();
}

struct Ctx {
    LAS unsigned char* lds; unsigned char* ldsg;
    int tid, lane, wave, vcu, G, bx;
    unsigned char* ws;
};

__device__ __forceinline__ void transpose_item(const float* W, int K, int Nsrc, bf16* WT, int nblk, int item, int skip_from, int skip, LAS float* scr, int lane, const float* kscale = nullptr) {
    const int kb = item / nblk, nb = item % nblk, k0 = 64 * kb, n0 = 32 * nb, c0 = n0 + (n0 >= skip_from ? skip : 0);
    { const int kk0 = lane >> 3, c4 = (lane & 7) * 4;
      f32x4 v[8];
#pragma unroll
      for (int i = 0; i < 8; ++i) v[i] = *(const f32x4*)(W + (size_t)(k0 + kk0 + 8 * i) * Nsrc + c0 + c4);
#pragma unroll
      for (int i = 0; i < 8; ++i) { const int kk = kk0 + 8 * i; const float sc = kscale ? kscale[k0 + kk] : 1.f; LAS float* d = scr + kk * 33 + c4; d[0] = v[i].x * sc; d[1] = v[i].y * sc; d[2] = v[i].z * sc; d[3] = v[i].w * sc; } }
    asm volatile("s_waitcnt lgkmcnt(0)" ::: "memory");
    const int c = lane & 7;
#pragma unroll
    for (int j = 0; j < 4; ++j) { const int n = (lane >> 3) + 8 * j; const LAS float* s = scr + (8 * c) * 33 + n;
        v4u o; o.x = pk2(s[0 * 33], s[1 * 33]); o.y = pk2(s[2 * 33], s[3 * 33]); o.z = pk2(s[4 * 33], s[5 * 33]); o.w = pk2(s[6 * 33], s[7 * 33]);
        *(v4u*)(WT + (size_t)(n0 + n) * K + k0 + 8 * c) = o; }
    asm volatile("s_waitcnt lgkmcnt(0)" ::: "memory");
}

__device__ __forceinline__ void phase_prologue(Ctx& C, const float* w_in, const float* w_out, const float* w_up, const float* w_dn, const float* n2w, const float* n1w) {
    LAS float* scr = (LAS float*)(C.lds + C.wave * 16384);
    const int gw = C.vcu * NWAVES + C.wave, NGW = C.G * NWAVES;
    constexpr int I_IN = (DMODEL / 64) * (NPROJ / 32), I_OUT = (DMODEL / 64) * (DMODEL / 32), I_UP = (DMODEL / 64) * (DFF / 32), I_DN = (DFF / 64) * (DMODEL / 32);
    constexpr int PER = I_IN + I_OUT + I_UP + I_DN;
    for (int it = gw; it < DEPTH * PER; it += NGW) {
        const int l = it / PER; int r = it % PER;
        if (r < I_IN) { transpose_item(w_in + (size_t)l * DMODEL * INC, DMODEL, INC, (bf16*)(C.ws + WS_WIN) + (size_t)l * NPROJ * DMODEL, NPROJ / 32, r, 1024, 16, scr, C.lane, l ? n1w + DMODEL : nullptr); continue; } r -= I_IN;
        if (r < I_OUT) { transpose_item(w_out + (size_t)l * DMODEL * DMODEL, DMODEL, DMODEL, (bf16*)(C.ws + WS_WOUT) + (size_t)l * DMODEL * DMODEL, DMODEL / 32, r, 1 << 30, 0, scr, C.lane); continue; } r -= I_OUT;
        if (r < I_UP) { transpose_item(w_up + (size_t)l * DMODEL * DFF, DMODEL, DFF, (bf16*)(C.ws + WS_WUP) + (size_t)l * DFF * DMODEL, DFF / 32, r, 1 << 30, 0, scr, C.lane, n2w + l * DMODEL); continue; } r -= I_UP;
        transpose_item(w_dn + (size_t)l * DFF * DMODEL, DFF, DMODEL, (bf16*)(C.ws + WS_WDN) + (size_t)l * DMODEL * DFF, DMODEL / 32, r, 1 << 30, 0, scr, C.lane);
    }
    for (int e = C.vcu * NTHR + C.tid; e < DEPTH * 32 * DMODEL; e += C.G * NTHR) { const int k = e & (DMODEL - 1), o = (e >> 10) & 31, l = e >> 15;
        const float v = (o < 16) ? w_in[(size_t)l * DMODEL * INC + (size_t)k * INC + 1024 + o] * (l ? n1w[DMODEL + k] : 1.f) : 0.f;
        ((bf16*)(C.ws + WS_WL))[e] = (bf16)(pk2(v, 0.f) & 0xffffu); }
    float* cosT = (float*)(C.ws + WS_ROPE); float* sinT = cosT + SEQ * 32;
    for (int e = C.vcu * NTHR + C.tid; e < SEQ * 32; e += C.G * NTHR) {
        const int pos = e >> 5, i = e & 31;
        const double inv = exp(-(double)i * (9.210340371976184 / 32.0));
        double rev = (double)pos * inv * 0.15915494309189535;
        rev -= floor(rev);
        const float fr = (float)rev;
        cosT[e] = __builtin_amdgcn_cosf(fr); sinT[e] = __builtin_amdgcn_sinf(fr);
    }
}

template <bool LOGITS>
__device__ __forceinline__ void phase_norm(Ctx& C, const float* x, const float* nw, bf16* hn, const float* w_in_l, float* bg) {
    LAS float* wl = (LAS float*)C.lds;
    if (LOGITS) {
        for (int e = C.tid; e < DMODEL * 16; e += NTHR) { const int k = e >> 4, o = e & 15;
            wl[(((((k >> 8) * 4 + (k & 3)) * 4 + (o >> 2)) * 64 + ((k >> 2) & 63)) * 4) + (o & 3)] = w_in_l[(size_t)k * INC + 1024 + o]; }
        __syncthreads();
    }
    const int gw = C.vcu * NWAVES + C.wave, NGW = C.G * NWAVES;
    f32x4 wv[4];
#pragma unroll
    for (int j = 0; j < 4; ++j) wv[j] = ((const f32x4*)nw)[C.lane + 64 * j];
    f32x4 v[4];
    { const f32x4* xr = (const f32x4*)(x + (size_t)gw * DMODEL) + C.lane;
#pragma unroll
      for (int j = 0; j < 4; ++j) v[j] = xr[64 * j]; }
    for (int m = gw; m < MG; m += NGW) {
        f32x4 vn[4]; { const int mn = (m + NGW < MG) ? m + NGW : m; const f32x4* xr = (const f32x4*)(x + (size_t)mn * DMODEL) + C.lane;
#pragma unroll
          for (int j = 0; j < 4; ++j) vn[j] = xr[64 * j]; }
        float s = 0.f;
#pragma unroll
        for (int j = 0; j < 4; ++j) s += (v[j].x * v[j].x + v[j].y * v[j].y) + (v[j].z * v[j].z + v[j].w * v[j].w);
        const float rstd = 1.f / sqrtf(wave_sum(s, C.lane) * (1.f / DMODEL) + EPS);
        unsigned long long* o8 = (unsigned long long*)(hn + (size_t)m * DMODEL) + C.lane;
#pragma unroll
        for (int j = 0; j < 4; ++j) { v[j] = v[j] * rstd * wv[j]; o8[64 * j] = (unsigned long long)pk2(v[j].x, v[j].y) | ((unsigned long long)pk2(v[j].z, v[j].w) << 32); }
        if (LOGITS) {
            float acc[16];
#pragma unroll
            for (int o = 0; o < 16; ++o) acc[o] = 0.f;
#pragma unroll
            for (int j = 0; j < 4; ++j)
#pragma unroll
                for (int e = 0; e < 4; ++e) { const int k = 4 * C.lane + 256 * j + e; const float hv = v[j][e];
#pragma unroll
                    for (int o4 = 0; o4 < 4; ++o4) { const f32x4 w4 = *(const LAS f32x4*)(wl + ((((j * 4 + e) * 4 + o4) * 64 + C.lane) * 4)); acc[4 * o4] += hv * w4.x; acc[4 * o4 + 1] += hv * w4.y; acc[4 * o4 + 2] += hv * w4.z; acc[4 * o4 + 3] += hv * w4.w; } }
            float mine = 0.f;
#pragma unroll
            for (int o = 0; o < 16; ++o) { const float t = wave_sum(acc[o], C.lane); if (C.lane == o) mine = t; }
            if (C.lane < 16) bg[(size_t)m * 16 + C.lane] = mine;
        }
#pragma unroll
        for (int j = 0; j < 4; ++j) v[j] = vn[j];
    }
    if (LOGITS) __syncthreads();
}

__device__ __forceinline__ void phase_logits(Ctx& C, const bf16* A, const bf16* WL, const float* ss, float* bg) {
    const int r32 = C.lane & 31, hi = C.lane >> 5, tl = C.wave >> 2, kq = C.wave & 3, row0 = (tl * 256 + C.vcu) * 32;
    const GAS bf16* ap = (const GAS bf16*)A + (size_t)(row0 + r32) * DMODEL + kq * 256 + 8 * hi; const GAS bf16* bp = (const GAS bf16*)WL + (size_t)r32 * DMODEL + kq * 256 + 8 * hi;
    bf16x8 af[16], bf_[16];
#pragma unroll
    for (int j = 0; j < 16; ++j) { af[j] = *(const GAS bf16x8*)(ap + 16 * j); bf_[j] = *(const GAS bf16x8*)(bp + 16 * j); }
    f32x16 acc = f32x16{};
#pragma unroll
    for (int j = 0; j < 16; ++j) acc = MFMA32(af[j], bf_[j], acc);
    LAS f32x4* part = (LAS f32x4*)C.lds + (C.wave * 64 + C.lane) * 4;
#pragma unroll
    for (int q = 0; q < 4; ++q) part[q] = (f32x4){acc[4 * q], acc[4 * q + 1], acc[4 * q + 2], acc[4 * q + 3]};
    __syncthreads();
    if (kq == 0 && r32 < 16) {
#pragma unroll
        for (int q = 0; q < 4; ++q) { f32x4 t = part[q];
#pragma unroll
            for (int w = 1; w < 4; ++w) t += ((LAS f32x4*)C.lds + ((C.wave + w) * 64 + C.lane) * 4)[q];
#pragma unroll
            for (int e = 0; e < 4; ++e) { const int r = 4 * q + e, row = row0 + crow(r, hi); const float rs = ss ? pg8::row_rstd(ss, row) : 1.0f; bg[(size_t)row * 16 + r32] = t[e] * rs; } }
    }
    __syncthreads();
}

__device__ __forceinline__ void phase_final_norm(Ctx& C, float* x, const float* nw) {
    const int gw = C.vcu * NWAVES + C.wave, NGW = C.G * NWAVES;
    f32x4 wv[4];
#pragma unroll
    for (int j = 0; j < 4; ++j) wv[j] = ((const f32x4*)nw)[C.lane + 64 * j];
    for (int m = gw; m < MG; m += 2 * NGW) {
        f32x4* xa = (f32x4*)(x + (size_t)m * DMODEL) + C.lane; f32x4* xb = (f32x4*)(x + (size_t)(m + NGW) * DMODEL) + C.lane;
        f32x4 va[4], vb[4]; float sa = 0.f, sb = 0.f;
#pragma unroll
        for (int j = 0; j < 4; ++j) { va[j] = xa[64 * j]; vb[j] = xb[64 * j]; }
#pragma unroll
        for (int j = 0; j < 4; ++j) { sa += (va[j].x * va[j].x + va[j].y * va[j].y) + (va[j].z * va[j].z + va[j].w * va[j].w); sb += (vb[j].x * vb[j].x + vb[j].y * vb[j].y) + (vb[j].z * vb[j].z + vb[j].w * vb[j].w); }
        const float ra = 1.f / sqrtf(wave_sum(sa, C.lane) * (1.f / DMODEL) + EPS), rb = 1.f / sqrtf(wave_sum(sb, C.lane) * (1.f / DMODEL) + EPS);
#pragma unroll
        for (int j = 0; j < 4; ++j) { xa[64 * j] = va[j] * ra * wv[j]; xb[64 * j] = vb[j] * rb * wv[j]; }
    }
}

__device__ __forceinline__ void phase_rope(Ctx& C) {
    const float* cosT = (const float*)(C.ws + WS_ROPE); const float* sinT = cosT + SEQ * 32;
    const int total = MG * 22 * 4, T = C.G * NTHR;
    for (int it0 = C.vcu * NTHR + C.tid; it0 < total; it0 += 4 * T) {
        bf16* p[4]; float sc[4]; v4u a[4], b[4]; f32x4 c0[4], c1[4], s0[4], s1[4]; bool ok[4];
#pragma unroll
        for (int u = 0; u < 4; ++u) {
            const int it = it0 + u * T; ok[u] = it < total; const int itc = ok[u] ? it : it0;
            const int i8 = itc & 3, grp = (itc >> 2) % 22, row = (itc >> 2) / 22, pos = row & (SEQ - 1);
            sc[u] = 1.f;
            if (grp < 8) { p[u] = (bf16*)(C.ws + WS_DFQ) + (size_t)row * 512 + grp * 64; sc[u] = 0.125f * LOG2E; }
            else if (grp < 16) { p[u] = (bf16*)(C.ws + WS_DFK) + (size_t)row * 512 + (grp - 8) * 64; }
            else if (grp < 20) { p[u] = (bf16*)(C.ws + WS_SWQ) + (size_t)row * 256 + (grp - 16) * 64; sc[u] = 0.125f * LOG2E; }
            else { p[u] = (bf16*)(C.ws + WS_SWKV) + (size_t)row * 256 + (grp - 20) * 64; }
            p[u] += i8 * 8;
            a[u] = *(const v4u*)(p[u]); b[u] = *(const v4u*)(p[u] + 32);
            c0[u] = *(const f32x4*)(cosT + pos * 32 + i8 * 8); c1[u] = *(const f32x4*)(cosT + pos * 32 + i8 * 8 + 4);
            s0[u] = *(const f32x4*)(sinT + pos * 32 + i8 * 8); s1[u] = *(const f32x4*)(sinT + pos * 32 + i8 * 8 + 4);
        }
#pragma unroll
        for (int u = 0; u < 4; ++u) {
            v4u oa, ob;
#pragma unroll
            for (int w = 0; w < 4; ++w) {
                const float x1l = __uint_as_float(a[u][w] << 16), x1h = __uint_as_float(a[u][w] & 0xffff0000u), x2l = __uint_as_float(b[u][w] << 16), x2h = __uint_as_float(b[u][w] & 0xffff0000u);
                const float cl = (w < 2) ? c0[u][2 * w] : c1[u][2 * w - 4], ch = (w < 2) ? c0[u][2 * w + 1] : c1[u][2 * w - 3];
                const float sl = (w < 2) ? s0[u][2 * w] : s1[u][2 * w - 4], sh = (w < 2) ? s0[u][2 * w + 1] : s1[u][2 * w - 3];
                oa[w] = pk2((x1l * cl - x2l * sl) * sc[u], (x1h * ch - x2h * sh) * sc[u]);
                ob[w] = pk2((x2l * cl + x1l * sl) * sc[u], (x2h * ch + x1h * sh) * sc[u]);
            }
            if (ok[u]) { *(v4u*)(p[u]) = oa; *(v4u*)(p[u] + 32) = ob; }
        }
    }
}

__device__ __forceinline__ void rope_span(Ctx& C, int beg, int end, int t, int nthr) {
    const float* cosT = (const float*)(C.ws + WS_ROPE); const float* sinT = cosT + SEQ * 32;
    for (int it0 = beg + t; it0 < end; it0 += 2 * nthr) {
        bf16* p[2]; float sc[2]; v4u a[2], b[2]; f32x4 c0[2], c1[2], s0[2], s1[2]; bool ok[2];
#pragma unroll
        for (int u = 0; u < 2; ++u) {
            const int it = it0 + u * nthr; ok[u] = it < end; const int itc = ok[u] ? it : it0;
            const int i8 = itc & 3, grp = (itc >> 2) % 22, row = (itc >> 2) / 22, pos = row & (SEQ - 1);
            sc[u] = 1.f;
            if (grp < 8) { p[u] = (bf16*)(C.ws + WS_DFQ) + (size_t)row * 512 + grp * 64; sc[u] = 0.125f * LOG2E; }
            else if (grp < 16) { p[u] = (bf16*)(C.ws + WS_DFK) + (size_t)row * 512 + (grp - 8) * 64; }
            else if (grp < 20) { p[u] = (bf16*)(C.ws + WS_SWQ) + (size_t)row * 256 + (grp - 16) * 64; sc[u] = 0.125f * LOG2E; }
            else { p[u] = (bf16*)(C.ws + WS_SWKV) + (size_t)row * 256 + (grp - 20) * 64; }
            p[u] += i8 * 8;
            a[u] = *(const v4u*)(p[u]); b[u] = *(const v4u*)(p[u] + 32);
            c0[u] = *(const f32x4*)(cosT + pos * 32 + i8 * 8); c1[u] = *(const f32x4*)(cosT + pos * 32 + i8 * 8 + 4);
            s0[u] = *(const f32x4*)(sinT + pos * 32 + i8 * 8); s1[u] = *(const f32x4*)(sinT + pos * 32 + i8 * 8 + 4);
        }
#pragma unroll
        for (int u = 0; u < 2; ++u) {
            v4u oa, ob;
#pragma unroll
            for (int w = 0; w < 4; ++w) {
                const float x1l = __uint_as_float(a[u][w] << 16), x1h = __uint_as_float(a[u][w] & 0xffff0000u), x2l = __uint_as_float(b[u][w] << 16), x2h = __uint_as_float(b[u][w] & 0xffff0000u);
                const float cl = (w < 2) ? c0[u][2 * w] : c1[u][2 * w - 4], ch = (w < 2) ? c0[u][2 * w + 1] : c1[u][2 * w - 3];
                const float sl = (w < 2) ? s0[u][2 * w] : s1[u][2 * w - 4], sh = (w < 2) ? s0[u][2 * w + 1] : s1[u][2 * w - 3];
                oa[w] = pk2((x1l * cl - x2l * sl) * sc[u], (x1h * ch - x2h * sh) * sc[u]);
                ob[w] = pk2((x2l * cl + x1l * sl) * sc[u], (x2h * ch + x1h * sh) * sc[u]);
            }
            if (ok[u]) { *(v4u*)(p[u]) = oa; *(v4u*)(p[u] + 32) = ob; }
        }
    }
}

__device__ __forceinline__ void phase_dn_prep(Ctx& C, const float* convw, const float* a_log, const float* dt_bias) {
    constexpr int P = 65;
    LAS float* raw = (LAS float*)C.lds;
    LAS float* KK = raw; LAS float* QK = raw + 64 * P; LAS float* Ld = raw + 2 * 64 * P;
    LAS float* qkv = (LAS float*)(C.lds + 66048);
    LAS float* sm = (LAS float*)(C.lds + 66048 + 49920);
    LAS float* betaT = sm, *gT = sm + 128, *Gs = sm + 256, *bs = sm + 384;
    const bf16* dnraw = (const bf16*)(C.ws + WS_DNRAW); const float* bg = (const float*)(C.ws + WS_BG);
    for (int task = C.vcu; task < 2 * 4 * 128; task += C.G) {
        const int nc = task & 127, h = (task >> 7) & 3, seq = task >> 9, c0 = nc * 64;
        __syncthreads();
        int tid_ = C.tid; asm volatile("" : "+v"(tid_));
        const int tidl = tid_, lanel = tid_ & 63, wavel = __builtin_amdgcn_readfirstlane(tid_ >> 6);
        for (int idx = tidl; idx < 3 * 68 * 8; idx += NTHR) {
            const int c8 = idx & 7, rr = (idx >> 3) % 68, part = (idx >> 3) / 68, t = c0 - 2 + rr;
            v4u v = (v4u){0u, 0u, 0u, 0u};
            if (t >= 0 && t < SEQ) v = *(const v4u*)(dnraw + (size_t)(seq * SEQ + t) * 768 + part * 256 + h * 64 + c8 * 8);
            LAS float* d = raw + (part * 68 + rr) * 64 + c8 * 8;
#pragma unroll
            for (int w = 0; w < 4; ++w) { d[2 * w] = __uint_as_float(v[w] << 16); d[2 * w + 1] = __uint_as_float(v[w] & 0xffff0000u); }
        }
        if (tidl < 128) { const int dir = tidl >> 6, i = tidl & 63; const size_t row = (size_t)(seq * SEQ + c0 + i);
            const float bl = bg[row * 16 + dir * 4 + h], al = bg[row * 16 + 8 + dir * 4 + h] + dt_bias[dir * 4 + h];
            betaT[dir * 64 + i] = 1.f / (1.f + __expf(-bl));
            const float e_ = __expf(-fabsf(al)); const float sp = fmaxf(al, 0.f) + ((e_ < 0.01f) ? e_ * (1.f - e_ * (0.5f - e_ * 0.33333333f)) : __logf(1.f + e_));
            gT[dir * 64 + i] = -__expf(a_log[dir * 4 + h]) * sp; }
        __syncthreads();
        { const int c = tidl & 63, i0 = tidl >> 6;
#pragma unroll
          for (int part = 0; part < 3; ++part) { float cw[5];
#pragma unroll
            for (int j = 0; j < 5; ++j) cw[j] = convw[j * 768 + part * 256 + h * 64 + c];
#pragma unroll
            for (int k = 0; k < 8; ++k) { const int i = i0 + 8 * k; float sacc = 0.f;
#pragma unroll
                for (int j = 0; j < 5; ++j) sacc += raw[(part * 68 + i + j) * 64 + c] * cw[j];
                qkv[(part * 64 + i) * P + c] = sacc / (1.f + __expf(-sacc)); } } }
        if (wavel < 2) { const int dir = wavel, il = lanel, it = dir ? 63 - il : il; float a = gT[dir * 64 + it];
#pragma unroll
            for (int o = 1; o < 64; o <<= 1) { const float t = __int_as_float(__builtin_amdgcn_ds_bpermute(((il - o) & 63) << 2, __float_as_int(a))); if (il >= o) a += t; }
            Gs[dir * 64 + il] = a; bs[dir * 64 + il] = betaT[dir * 64 + it]; }
        __syncthreads();
        if (tidl < 128) { LAS float* r = qkv + tidl * P; float s = 0.f;
            for (int c = 0; c < 64; ++c) s += r[c] * r[c];
            const float sc = 1.f / sqrtf(s + EPS);
            for (int c = 0; c < 64; ++c) r[c] *= sc; }
        __syncthreads();
        { const int r32 = lanel & 31, hi = lanel >> 5, mat = wavel >> 2, it = (wavel >> 1) & 1, mt = wavel & 1;
          const LAS float* ar = qkv + ((mat ? 0 : 64) + r32 + 32 * it) * P + 2 * hi; const LAS float* br = qkv + (64 + r32 + 32 * mt) * P + 2 * hi;
          f32x16 acc = f32x16{};
#pragma unroll
          for (int j = 0; j < 16; ++j) { const float a0 = ar[4 * j], a1 = ar[4 * j + 1], b0 = br[4 * j], b1 = br[4 * j + 1];
              acc = __builtin_amdgcn_mfma_f32_32x32x2f32(a0, b0, acc, 0, 0, 0); acc = __builtin_amdgcn_mfma_f32_32x32x2f32(a1, b1, acc, 0, 0, 0); }
          LAS float* dst = (mat ? QK : KK) + (32 * it) * P + r32 + 32 * mt;
#pragma unroll
          for (int r = 0; r < 16; ++r) dst[((r & 3) + 8 * (r >> 2) + 4 * hi) * P] = acc[r]; }
        __syncthreads();
        for (int idx = tidl; idx < 2 * 64 * 64; idx += NTHR) {
            const int ml = idx & 63, il = (idx >> 6) & 63, dir = idx >> 12;
            const int it = dir ? 63 - il : il, mt = dir ? 63 - ml : ml;
            float v = 0.f;
            if (il > ml) v = bs[dir * 64 + il] * KK[it * P + mt] * __expf(Gs[dir * 64 + il] - Gs[dir * 64 + ml]);
            Ld[idx] = v;
        }
        __syncthreads();
        const int blk0 = ((0 * 2 + seq) * 4 + h) * 128 + nc, blk1 = ((1 * 2 + seq) * 4 + h) * 128 + (127 - nc);
        if (wavel < 4) {
            const int dir = wavel >> 1, col = (wavel & 1) * 64 + lanel;
            unsigned lb = (unsigned)(uintptr_t)(Ld + dir * 4096);
            const LAS float* src = (col < 64) ? (qkv + (2 * 64) * P + col) : (qkv + 64 * P + (col - 64));
            float xs[64];
#pragma unroll
            for (int il = 0; il < 64; ++il) {
                const int it = dir ? 63 - il : il;
                float a = src[it * P] * bs[dir * 64 + il];
                if (col >= 64) a *= __expf(Gs[dir * 64 + il]);
#pragma unroll
                for (int m4 = 0; m4 < (il + 3) / 4; ++m4) { const f32x4 l4 = *(const LAS f32x4*)(uintptr_t)(lb + (il * 64 + 4 * m4) * 4);
                    if (4 * m4 < il) a -= l4.x * xs[4 * m4];
                    if (4 * m4 + 1 < il) a -= l4.y * xs[4 * m4 + 1];
                    if (4 * m4 + 2 < il) a -= l4.z * xs[4 * m4 + 2];
                    if (4 * m4 + 3 < il) a -= l4.w * xs[4 * m4 + 3]; }
                xs[il] = a; if (il & 1) asm volatile("" : "+v"(lb) : "v"(a));
            }
            const int blk = dir ? blk1 : blk0;
            if (col < 64) {
                bf16* U = (bf16*)(C.ws + WS_U) + (size_t)blk * 4096;
                const int et = col >> 5, r32 = col & 31;
#pragma unroll
                for (int mt = 0; mt < 2; ++mt)
#pragma unroll
                    for (int hi = 0; hi < 2; ++hi) { v4u o0, o1;
#pragma unroll
                        for (int q = 0; q < 4; ++q) { const int ra = 2 * q, rb = 2 * q + 1, rc = 8 + 2 * q, rd = 9 + 2 * q;
                            o0[q] = pk2(xs[32 * mt + (ra & 3) + 8 * (ra >> 2) + 4 * hi], xs[32 * mt + (rb & 3) + 8 * (rb >> 2) + 4 * hi]);
                            o1[q] = pk2(xs[32 * mt + (rc & 3) + 8 * (rc >> 2) + 4 * hi], xs[32 * mt + (rd & 3) + 8 * (rd >> 2) + 4 * hi]); }
                        bf16* dst = U + ((mt * 2 + et) * 64 + r32 + 32 * hi) * 16; *(v4u*)dst = o0; *(v4u*)(dst + 8) = o1; }
            } else {
                bf16* W = (bf16*)(C.ws + WS_W) + (size_t)blk * 4096; const int d = col - 64;
#pragma unroll
                for (int il = 0; il < 64; ++il) W[il * 64 + d] = (bf16)(pk2(xs[il], 0.f) & 0xffffu);
            }
        } else {
            const int t2 = tidl - 256;
            for (int idx = t2; idx < 2 * 64 * 8; idx += 256) {
                const int d8 = idx & 7, il = (idx >> 3) & 63, dir = idx >> 9;
                const int it = dir ? 63 - il : il; const LAS float* s = qkv + it * P + d8 * 8; const float f = 0.125f * __expf(Gs[dir * 64 + il]);
                v4u o; o.x = pk2(s[0] * f, s[1] * f); o.y = pk2(s[2] * f, s[3] * f); o.z = pk2(s[4] * f, s[5] * f); o.w = pk2(s[6] * f, s[7] * f);
                *(v4u*)((bf16*)(C.ws + WS_QS) + (size_t)(dir ? blk1 : blk0) * 4096 + il * 64 + d8 * 8) = o;
            }
            for (int idx = t2; idx < 2 * 64 * 8; idx += 256) {
                const int i8 = idx & 7, d = (idx >> 3) & 63, dir = idx >> 9; const float gl = Gs[dir * 64 + 63];
                float v[8];
#pragma unroll
                for (int j = 0; j < 8; ++j) { const int il = i8 * 8 + j, it = dir ? 63 - il : il; v[j] = qkv[(64 + it) * P + d] * __expf(gl - Gs[dir * 64 + il]); }
                v4u o; o.x = pk2(v[0], v[1]); o.y = pk2(v[2], v[3]); o.z = pk2(v[4], v[5]); o.w = pk2(v[6], v[7]);
                *(v4u*)((bf16*)(C.ws + WS_KT) + (size_t)(dir ? blk1 : blk0) * 4096 + d * 64 + i8 * 8) = o;
            }
            for (int idx = t2; idx < 2 * 3 * 64 * 2; idx += 256) {
                const int half = idx & 1, ln = (idx >> 1) & 63, tt = (idx >> 7) % 3, dir = (idx >> 7) / 3;
                const int mt = (tt == 2) ? 1 : 0, itl = (tt == 0) ? 0 : 1, r32 = ln & 31, hi = ln >> 5, il = r32 + 32 * itl, itok = dir ? 63 - il : il;
                const float gi = Gs[dir * 64 + il];
                float v[8];
#pragma unroll
                for (int j = 0; j < 8; ++j) { const int r = 8 * half + j, ml = (r & 3) + 8 * (r >> 2) + 4 * hi + 32 * mt, mtok = dir ? 63 - ml : ml;
                    v[j] = (il >= ml) ? 0.125f * QK[itok * P + mtok] * __expf(gi - Gs[dir * 64 + ml]) : 0.f; }
                v4u o; o.x = pk2(v[0], v[1]); o.y = pk2(v[2], v[3]); o.z = pk2(v[4], v[5]); o.w = pk2(v[6], v[7]);
                *(v4u*)((bf16*)(C.ws + WS_KS) + (size_t)(dir ? blk1 : blk0) * 4096 + ((mt * 2 + itl) * 64 + ln) * 16 + 8 * half) = o;
            }
            if (t2 < 2) ((float*)(C.ws + WS_GS))[t2 ? blk1 : blk0] = __expf(Gs[t2 * 64 + 63]);
            { constexpr int PER_TASK = (MG * 22 * 4) / 1024; const int tslot = (task - C.vcu) / C.G; const int beg = (C.vcu * 4 + tslot) * PER_TASK; rope_span(C, beg, beg + PER_TASK, t2, 256); }
        }
    }
    __syncthreads();
}

#define DN_BAR() asm volatile("s_waitcnt lgkmcnt(0)\n\ts_barrier" ::: "memory")
#define LDG(T, base, off) (*(const GAS T*)((const GAS char*)(base) + (off)))
__device__ __forceinline__ void dn_chain(Ctx& C, int ch) {
    constexpr int SP = 72, IMG = 64 * SP;
    LAS bf16* STb = (LAS bf16*)C.lds; LAS v4u* VN = (LAS v4u*)(C.lds + 3 * IMG * 2);
    const int lane = C.lane, r32 = lane & 31, hi = lane >> 5, w = C.wave, wl = w & 3;
    const int dir = ch >> 3, seq = (ch >> 2) & 1, h = ch & 3;
    const GAS bf16* QD = (const GAS bf16*)(C.ws + WS_QS) + (size_t)ch * 128 * 4096; const GAS bf16* AT = (const GAS bf16*)(C.ws + WS_KS) + (size_t)ch * 128 * 4096;
    const GAS bf16* KT = (const GAS bf16*)(C.ws + WS_KT) + (size_t)ch * 128 * 4096; const GAS bf16* UU = (const GAS bf16*)(C.ws + WS_U) + (size_t)ch * 128 * 4096;
    const GAS bf16* WW = (const GAS bf16*)(C.ws + WS_W) + (size_t)ch * 128 * 4096; const GAS float* GL = (const GAS float*)(C.ws + WS_GS) + (size_t)ch * 128;
    GAS float* ODN = (GAS float*)(C.ws + WS_ODN) + (size_t)dir * MG * 256;
    __syncthreads();
    for (int e = C.tid; e < 3 * IMG / 2; e += NTHR) ((LAS unsigned*)STb)[e] = 0u;
    __syncthreads();
    if (w < 4) {
        const int et = wl >> 1, dt = wl & 1;
        f32x16 ST = f32x16{};
        bf16x8 wA0[2][4], kB0[2][2], wA1[2][4], kB1[2][2]; v4u uu0[2][2], uu1[2][2]; float gam0, gam1;
        const unsigned off_w0 = (unsigned)((r32 * 64 + 8 * hi) * 2), off_u0 = (unsigned)((et * 64 + lane) * 32), off_kt = (unsigned)(((r32 + 32 * dt) * 64 + 4 * hi) * 2);
#define CH_LOAD(n_, wA, kB, uu, gam) do { const GAS bf16* Wb = WW + (size_t)(n_) * 4096; const GAS bf16* Ub = UU + (size_t)(n_) * 4096; const GAS bf16* KTb = KT + (size_t)(n_) * 4096; \
            _Pragma("unroll") for (int mt = 0; mt < 2; ++mt) { \
                _Pragma("unroll") for (int kk = 0; kk < 4; ++kk) wA[mt][kk] = LDG(bf16x8, Wb, off_w0 + (unsigned)(mt * 4096 + kk * 32)); \
                uu[mt][0] = LDG(v4u, Ub, off_u0 + (unsigned)(mt * 4096)); uu[mt][1] = LDG(v4u, Ub, off_u0 + (unsigned)(mt * 4096 + 16)); \
                _Pragma("unroll") for (int s = 0; s < 2; ++s) { const v2u lo = LDG(v2u, KTb, off_kt + (unsigned)((32 * mt + 16 * s) * 2)), hh = LDG(v2u, KTb, off_kt + (unsigned)((32 * mt + 16 * s + 8) * 2)); \
                    kB[mt][s] = __builtin_bit_cast(bf16x8, (v4u){lo.x, lo.y, hh.x, hh.y}); } } \
            gam = GL[n_]; } while (0)
#define CH_STEP(n_, wA, kB, uu, gam) do { \
            const int c3 = (n_) % 3, x3 = (c3 == 2) ? 0 : c3 + 1; \
            bf16x8 sB[4]; \
            _Pragma("unroll") for (int kk = 0; kk < 4; ++kk) sB[kk] = *(const LAS bf16x8*)(STb + c3 * IMG + (r32 + 32 * et) * SP + 16 * kk + 8 * hi); \
            f32x16 ws0 = f32x16{}, ws1 = f32x16{}; \
            _Pragma("unroll") for (int kk = 0; kk < 4; ++kk) { ws0 = MFMA32(wA[0][kk], sB[kk], ws0); ws1 = MFMA32(wA[1][kk], sB[kk], ws1); } \
            _Pragma("unroll") for (int r = 0; r < 16; ++r) { \
                const float u0 = (r & 1) ? __uint_as_float(uu[0][r >> 3][(r >> 1) & 3] & 0xffff0000u) : __uint_as_float(uu[0][r >> 3][(r >> 1) & 3] << 16); \
                const float u1 = (r & 1) ? __uint_as_float(uu[1][r >> 3][(r >> 1) & 3] & 0xffff0000u) : __uint_as_float(uu[1][r >> 3][(r >> 1) & 3] << 16); \
                ws0[r] = u0 - ws0[r]; ws1[r] = u1 - ws1[r]; ST[r] *= gam; } \
            const bf16x8 p00 = pack8(ws0, 0), p01 = pack8(ws0, 1), p10 = pack8(ws1, 0), p11 = pack8(ws1, 1); \
            { LAS v4u* vn = VN + ((((n_) & 1) * 2 + et) * 4) * 64 + lane; vn[0] = __builtin_bit_cast(v4u, p00); vn[64] = __builtin_bit_cast(v4u, p01); vn[128] = __builtin_bit_cast(v4u, p10); vn[192] = __builtin_bit_cast(v4u, p11); } \
            ST = MFMA32(p00, kB[0][0], ST); ST = MFMA32(p10, kB[1][0], ST); ST = MFMA32(p01, kB[0][1], ST); ST = MFMA32(p11, kB[1][1], ST); \
            LAS bf16* dst = STb + x3 * IMG + (32 * et) * SP + r32 + 32 * dt; \
            _Pragma("unroll") for (int r = 0; r < 16; ++r) dst[crow(r, hi) * SP] = (bf16)(pk2(ST[r], 0.f) & 0xffffu); \
            DN_BAR(); } while (0)
        CH_LOAD(0, wA0, kB0, uu0, gam0);
        for (int n = 0; n < 128; n += 2) {
            CH_LOAD(n + 1, wA1, kB1, uu1, gam1);
            CH_STEP(n, wA0, kB0, uu0, gam0);
            CH_LOAD((n + 2 < 128) ? n + 2 : 127, wA0, kB0, uu0, gam0);
            CH_STEP(n + 1, wA1, kB1, uu1, gam1);
        }
        DN_BAR();
#undef CH_LOAD
#undef CH_STEP
    } else {
        const int it = wl >> 1, et = wl & 1;
        bf16x8 qA0[4], qA1[4]; v4u at0[2][2], at1[2][2];
        const unsigned off_q = (unsigned)(((r32 + 32 * it) * 64 + 8 * hi) * 2), off_at0 = (unsigned)((it * 64 + lane) * 32);
#define OW_LOAD(n_, qA, at) do { const GAS bf16* Qb = QD + (size_t)(n_) * 4096; const GAS bf16* Ab = AT + (size_t)(n_) * 4096; \
            _Pragma("unroll") for (int kk = 0; kk < 4; ++kk) qA[kk] = LDG(bf16x8, Qb, off_q + (unsigned)(kk * 32)); \
            _Pragma("unroll") for (int mt = 0; mt < 2; ++mt) { if (mt <= it) { at[mt][0] = LDG(v4u, Ab, off_at0 + (unsigned)(mt * 4096)); at[mt][1] = LDG(v4u, Ab, off_at0 + (unsigned)(mt * 4096 + 16)); } } } while (0)
#define OW_STEP(n_, qA, at) do { \
            const int c3 = (n_) % 3; \
            bf16x8 sB[4]; \
            _Pragma("unroll") for (int kk = 0; kk < 4; ++kk) sB[kk] = *(const LAS bf16x8*)(STb + c3 * IMG + (r32 + 32 * et) * SP + 16 * kk + 8 * hi); \
            const LAS v4u* vn = VN + ((((n_) & 1) * 2 + et) * 4) * 64 + lane; \
            f32x16 o = f32x16{}; \
            _Pragma("unroll") for (int kk = 0; kk < 4; ++kk) o = MFMA32(qA[kk], sB[kk], o); \
            _Pragma("unroll") for (int mt = 0; mt < 2; ++mt) { if (mt <= it) { \
                _Pragma("unroll") for (int s = 0; s < 2; ++s) o = MFMA32(__builtin_bit_cast(bf16x8, at[mt][s]), __builtin_bit_cast(bf16x8, vn[(mt * 2 + s) * 64]), o); } } \
            _Pragma("unroll") for (int r = 0; r < 16; ++r) { const int sr = (n_) * 64 + 32 * it + crow(r, hi), t = dir ? (SEQ - 1 - sr) : sr; \
                ODN[(size_t)(seq * SEQ + t) * 256 + h * 64 + 32 * et + r32] = o[r]; } \
            DN_BAR(); } while (0)
        OW_LOAD(0, qA0, at0);
        DN_BAR();
        for (int n = 0; n < 128; n += 2) {
            OW_LOAD(n + 1, qA1, at1);
            OW_STEP(n, qA0, at0);
            OW_LOAD((n + 2 < 128) ? n + 2 : 127, qA0, at0);
            OW_STEP(n + 1, qA1, at1);
        }
#undef OW_LOAD
#undef OW_STEP
    }
    __syncthreads();
}
#undef LDG
__device__ __forceinline__ void phase_finalize(Ctx& C, int li, const float* dn_norm_w, const float* diff_lambda, const float* diff_norm_w) {
    const int gw = C.vcu * NWAVES + C.wave, NGW = C.G * NWAVES, lane = C.lane;
    const float lam_init = 0.8f - 0.6f * __expf(-0.3f * (float)li);
    const float d1 = wave_sum(diff_lambda[lane] * diff_lambda[64 + lane], lane), d2 = wave_sum(diff_lambda[128 + lane] * diff_lambda[192 + lane], lane);
    const float lam = __expf(d1) - __expf(d2) + lam_init;
    const f32x4 nwd = *(const f32x4*)(dn_norm_w + (4 * lane & 63));
    const f32x4 nf0 = *(const f32x4*)(diff_norm_w + (8 * lane & 127)), nf1 = *(const f32x4*)(diff_norm_w + (8 * lane & 127) + 4);
    const float* of = (const float*)(C.ws + WS_ODN); const float* ob = of + (size_t)MG * 256;
    const bf16* zb = (const bf16*)(C.ws + WS_Z); const bf16* odf = (const bf16*)(C.ws + WS_ODF); bf16* mix = (bf16*)(C.ws + WS_MIX);
    const int hh_ = lane >> 4, e0_ = 8 * (lane & 15);
    f32x4 na = *(const f32x4*)(of + (size_t)gw * 256 + 4 * lane), nb = *(const f32x4*)(ob + (size_t)gw * 256 + 4 * lane); v2u nz = *(const v2u*)(zb + (size_t)gw * 256 + 4 * lane);
    v4u nda = *(const v4u*)(odf + (size_t)gw * 1024 + hh_ * 256 + e0_), ndb = *(const v4u*)(odf + (size_t)gw * 1024 + hh_ * 256 + 128 + e0_);
    for (int m = gw; m < MG; m += NGW) {
        const f32x4 ca = na, cb = nb; const v2u cz = nz; const v4u cda = nda, cdb = ndb;
        { const int mn = (m + NGW < MG) ? m + NGW : m;
          na = *(const f32x4*)(of + (size_t)mn * 256 + 4 * lane); nb = *(const f32x4*)(ob + (size_t)mn * 256 + 4 * lane); nz = *(const v2u*)(zb + (size_t)mn * 256 + 4 * lane);
          nda = *(const v4u*)(odf + (size_t)mn * 1024 + hh_ * 256 + e0_); ndb = *(const v4u*)(odf + (size_t)mn * 1024 + hh_ * 256 + 128 + e0_); }
        {
            const f32x4 a = ca, b = cb;
            const f32x4 o = a + b; float s = (o.x * o.x + o.y * o.y) + (o.z * o.z + o.w * o.w);
            s += shx(s, 1, lane); s += shx(s, 2, lane); s += shx(s, 4, lane); s += shx(s, 8, lane);
            const float rstd = 1.f / sqrtf(s * (1.f / 64.f) + EPS);
            const v2u zz = cz;
            const float z0 = __uint_as_float(zz.x << 16), z1 = __uint_as_float(zz.x & 0xffff0000u), z2 = __uint_as_float(zz.y << 16), z3 = __uint_as_float(zz.y & 0xffff0000u);
            v2u w; w.x = pk2(o.x * rstd * nwd.x * (z0 / (1.f + __expf(-z0))), o.y * rstd * nwd.y * (z1 / (1.f + __expf(-z1))));
            w.y = pk2(o.z * rstd * nwd.z * (z2 / (1.f + __expf(-z2))), o.w * rstd * nwd.w * (z3 / (1.f + __expf(-z3))));
            *(v2u*)(mix + (size_t)m * 1024 + 4 * lane) = w;
        }
        {
            const int hh = lane >> 4, e0 = 8 * (lane & 15);
            v4u a = cda; const v4u b = cdb;
            if (hh == 0 && m < SEQ) {
                const int cc = e0 >> 6; const bf16* po = (const bf16*)(C.ws + WS_PO); const float* ps = (const float*)(C.ws + WS_PS);
                float mp[4], lp[4]; v4u pp[4]; float mm = -INFINITY;
#pragma unroll
                for (int p = 0; p < 4; ++p) { pp[p] = *(const v4u*)(po + ((size_t)(p * 2 + cc) * SEQ + m) * 64 + (e0 & 63)); mp[p] = ps[((size_t)(p * 2 + cc) * SEQ + m) * 2]; lp[p] = ps[((size_t)(p * 2 + cc) * SEQ + m) * 2 + 1]; mm = fmaxf(mm, mp[p]); }
                float wsum = 0.f;
#pragma unroll
                for (int p = 0; p < 4; ++p) { lp[p] *= __builtin_amdgcn_exp2f(mp[p] - mm); wsum += lp[p]; }
                const float inv = 1.f / wsum;
#pragma unroll
                for (int w = 0; w < 4; ++w) { float lo = 0.f, hi_ = 0.f;
#pragma unroll
                    for (int p = 0; p < 4; ++p) { lo += lp[p] * __uint_as_float(pp[p][w] << 16); hi_ += lp[p] * __uint_as_float(pp[p][w] & 0xffff0000u); }
                    a[w] = pk2(lo * inv, hi_ * inv); }
            }
            float o[8]; float s = 0.f;
#pragma unroll
            for (int w = 0; w < 4; ++w) { o[2 * w] = __uint_as_float(a[w] << 16) - lam * __uint_as_float(b[w] << 16); o[2 * w + 1] = __uint_as_float(a[w] & 0xffff0000u) - lam * __uint_as_float(b[w] & 0xffff0000u);
                s += o[2 * w] * o[2 * w] + o[2 * w + 1] * o[2 * w + 1]; }
            s += shx(s, 1, lane); s += shx(s, 2, lane); s += shx(s, 4, lane); s += shx(s, 8, lane);
            const float sc = (1.f - lam_init) / sqrtf(s * (1.f / 128.f) + EPS);
            v4u w; w.x = pk2(o[0] * sc * nf0.x, o[1] * sc * nf0.y); w.y = pk2(o[2] * sc * nf0.z, o[3] * sc * nf0.w); w.z = pk2(o[4] * sc * nf1.x, o[5] * sc * nf1.y); w.w = pk2(o[6] * sc * nf1.z, o[7] * sc * nf1.w);
            *(v4u*)(mix + (size_t)m * 1024 + 256 + 8 * lane) = w;
        }
    }
}

struct Args { const float* in[16]; float* out; unsigned char* ws; };
__device__ __forceinline__ const float* ldarg(int k) { const Args* p = (const Args*)__builtin_amdgcn_kernarg_segment_ptr(); asm volatile("" : "+s"(p)); return p->in[k]; }
__device__ __forceinline__ float* ldout() { const Args* p = (const Args*)__builtin_amdgcn_kernarg_segment_ptr(); asm volatile("" : "+s"(p)); return p->out; }
__device__ __forceinline__ unsigned char* ldws() { const Args* p = (const Args*)__builtin_amdgcn_kernarg_segment_ptr(); asm volatile("" : "+s"(p)); return p->ws; }
__device__ __forceinline__ void refresh(Ctx& C, unsigned char* ldsp) {
    int t = threadIdx.x; asm volatile("" : "+v"(t));
    int bx = blockIdx.x; asm volatile("" : "+s"(bx));
    int G = gridDim.x; asm volatile("" : "+s"(G));
    unsigned lo = (unsigned)(uintptr_t)ldsp; asm volatile("" : "+s"(lo));
    C.lds = (LAS unsigned char*)(uintptr_t)lo; C.ldsg = ldsp; C.tid = t; C.lane = t & 63; C.wave = __builtin_amdgcn_readfirstlane(t >> 6);
    C.G = G; C.vcu = (G % 8 == 0) ? (bx % 8) * (G / 8) + bx / 8 : bx; C.bx = bx;
    C.ws = ldws();
}
#define RF() refresh(C, lds)
#define GSYNC() do { RF(); XcdBarrier b_; b_.bar = (unsigned*)C.ws; b_.x = xb_xcc_id(); b_.st = (volatile LAS unsigned*)(C.lds + 131424); xcd_barrier(b_); } while (0)
__global__ void __launch_bounds__(NTHR, 2) hybrid_fwd(Args args) {
    extern __shared__ __attribute__((aligned(16))) unsigned char lds[];
    cg::grid_group grid = cg::this_grid();
    Ctx C; RF();
    if (C.tid < 2) ((volatile LAS unsigned*)(C.lds + 131424))[C.tid] = 0u;
    __syncthreads();
    if (C.tid == 0) (void)xb_add(&((unsigned*)C.ws)[XB_XCNT(xb_xcc_id())], 1u);
#define ARGP(k) (ldarg(k))
#define x_prompt ARGP(0)
#define x_sample ARGP(1)
#define norm1_w ARGP(2)
#define w_in ARGP(3)
#define conv_w ARGP(4)
#define a_log ARGP(5)
#define dt_bias ARGP(6)
#define dn_norm_w ARGP(7)
#define diff_lambda ARGP(8)
#define diff_norm_w ARGP(9)
#define swa_sink ARGP(10)
#define w_out ARGP(11)
#define norm2_w ARGP(12)
#define w_up ARGP(13)
#define w_dn ARGP(14)
#define final_w ARGP(15)
#define HN ((bf16*)(C.ws + WS_HN))
#define MIX ((bf16*)(C.ws + WS_MIX))
#define HID ((bf16*)(C.ws + WS_HID))
    phase_prologue(C, w_in, w_out, w_up, w_dn, norm2_w, norm1_w);
    RF();
    phase_norm<false>(C, x_prompt, norm1_w, HN, nullptr, nullptr);
    grid.sync();
    for (int g = 0; g < NGRP; ++g) {
#define xo (ldout() + (size_t)g * MG * DMODEL)
        for (int li = 0; li < DEPTH; ++li) {
#define xcur (li ? (const float*)xo : ((g < 2) ? x_prompt + (size_t)g * MG * DMODEL : x_sample))
            RF();
            if (li == 0 && g > 0) { phase_norm<false>(C, xcur, norm1_w, HN, nullptr, nullptr); GSYNC(); }
            RF();
            { pg8::Gemm gm{HN, (const bf16*)(C.ws + WS_WIN) + (size_t)li * NPROJ * DMODEL, MG, NPROJ, DMODEL}; pg8::StaticOrder S; S.init(MG, NPROJ, C.G, C.bx);
              phase_logits(C, HN, (const bf16*)(C.ws + WS_WL) + (size_t)li * 32 * DMODEL, li ? (const float*)(C.ws + WS_SS2) : nullptr, (float*)(C.ws + WS_BG));
              pg8::EpiProj E{C.ws, li ? (const float*)(C.ws + WS_SS2) : nullptr};
              pg8::gemm_phase<pg8::EpiProj, pg8::StaticOrder, true, true>(C.lds, gm, S, E); }
            GSYNC();
            RF();
            RF();
#ifndef NO_PREP
            phase_dn_prep(C, conv_w + (size_t)li * 5 * 768, a_log + li * 8, dt_bias + li * 8);
#endif
            GSYNC();
            RF();
            {
#ifndef NO_CHAIN
                if (C.vcu < 16) dn_chain(C, C.vcu);
#endif
                __syncthreads(); RF();
                using abf = attn_body::bf16;
                {
                    const int nun = (C.vcu < 16) ? 0 : 4;
                    for (int i = 0; i < nun; ++i) {
                        const int bh = C.vcu >> 3, s = C.vcu & 7, b = bh >> 4, vh = bh & 15, h = vh >> 2, j = (vh >> 1) & 1, c = vh & 1;
                        const abf* Qb = (const abf*)(C.ws + WS_DFQ) + (size_t)b * SEQ * 512 + h * 128 + j * 64;
                        const abf* Kb = (const abf*)(C.ws + WS_DFK) + (size_t)b * SEQ * 512 + h * 128 + j * 64;
                        const abf* Vb = (const abf*)(C.ws + WS_DFV) + (size_t)b * SEQ * 512 + h * 128 + c * 64;
                        abf* Ob = (abf*)(C.ws + WS_ODF) + (size_t)b * SEQ * 1024 + h * 256 + j * 128 + c * 64;
                        const int qb = (i == 0) ? s : (i == 1) ? 15 - s : (i == 2) ? 16 + s : 31 - s;
                        attn_body::attn_unit<8, 0>(Qb, 512, Kb, 512, Vb, 512, Ob, 1024, qb * 256, 0.f, (char*)C.ldsg, 0, nullptr, i > 0, i + 1 < nun); }
                    {
                        RF();
                        const int qu = (C.vcu < 16) ? 240 + C.vcu : C.vcu - 16, part = qu & 3, un = qu >> 2, v2 = un & 15, i2 = un >> 4, s = v2 & 7, c = v2 >> 3;
                        const int qb = (i2 == 0) ? s : (i2 == 1) ? 15 - s : (i2 == 2) ? 16 + s : 31 - s;
                        const abf* Qb = (const abf*)(C.ws + WS_DFQ); const abf* Kb = (const abf*)(C.ws + WS_DFK); const abf* Vb = (const abf*)(C.ws + WS_DFV) + c * 64;
                        abf* Ob = (abf*)(C.ws + WS_PO) + (size_t)(part * 2 + c) * SEQ * 64;
                        attn_body::attn_unit<8, 2>(Qb, 512, Kb, 512, Vb, 512, Ob, 64, qb * 256, 0.f, (char*)C.ldsg, part * (SEQ / 4), (float*)(C.ws + WS_PS) + (size_t)(part * 2 + c) * SEQ * 2);
                    }
                }
                RF();
                {
                    const int nsw = 1;
                    for (int i = 0; i < nsw; ++i) {
                        const int un = C.vcu;
                        const int b = un >> 7, h = (un >> 5) & 3, qb = un & 31;
                        const abf* Qb = (const abf*)(C.ws + WS_SWQ) + (size_t)b * SEQ * 256 + h * 64;
                        const abf* Kb = (const abf*)(C.ws + WS_SWKV) + (size_t)b * SEQ * 256 + (h >> 1) * 64;
                        const abf* Vb = (const abf*)(C.ws + WS_SWKV) + (size_t)b * SEQ * 256 + 128 + (h >> 1) * 64;
                        abf* Ob = (abf*)(C.ws + WS_MIX) + (size_t)b * SEQ * 1024 + 768 + h * 64;
                        attn_body::attn_unit<8, 1>(Qb, 256, Kb, 256, Vb, 256, Ob, 1024, qb * 256, swa_sink[li * 4 + h] * LOG2E, (char*)C.ldsg);
                    }
                }
            }
            GSYNC();
            RF();
            phase_finalize(C, li, dn_norm_w + li * 64, diff_lambda + li * 256, diff_norm_w + li * 128);
            GSYNC();
            RF();
            { pg8::Gemm gm{MIX, (const bf16*)(C.ws + WS_WOUT) + (size_t)li * DMODEL * DMODEL, MG, DMODEL, DMODEL}; pg8::StaticOrder S; S.init(MG, DMODEL, C.G, C.bx);
              pg8::EpiRes E{li ? nullptr : xcur, li ? (const bf16*)HN : nullptr, nullptr, HN, (float*)(C.ws + WS_SS)};
              pg8::gemm_phase<pg8::EpiRes, pg8::StaticOrder, true, true>(C.lds, gm, S, E); }
            GSYNC();
            RF();
            { pg8::Gemm gm{HN, (const bf16*)(C.ws + WS_WUP) + (size_t)li * DFF * DMODEL, MG, DFF, DMODEL}; pg8::StaticOrder S; S.init(MG, DFF, C.G, C.bx);
              pg8::EpiRelu2S E{HID, (const float*)(C.ws + WS_SS), DFF};
              pg8::gemm_phase<pg8::EpiRelu2S, pg8::StaticOrder, true, true>(C.lds, gm, S, E); }
            GSYNC();
            RF();
            { pg8::Gemm gm{HID, (const bf16*)(C.ws + WS_WDN) + (size_t)li * DMODEL * DFF, MG, DMODEL, DFF}; pg8::StaticOrder S; S.init(MG, DMODEL, C.G, C.bx);
              pg8::EpiRes E{nullptr, HN, li ? xo : nullptr, li ? nullptr : HN, li ? nullptr : (float*)(C.ws + WS_SS2)};
              pg8::gemm_phase<pg8::EpiRes, pg8::StaticOrder, true, true>(C.lds, gm, S, E); }
            GSYNC();
        }
        RF();
        phase_final_norm(C, xo, final_w);
    }
}

extern "C" void kernel_launch(void* const* d_in, const int* in_sizes, int n_in, void* d_out, int out_size, void* d_ws, size_t ws_size, hipStream_t stream) {
    static int grid = 0;
    if (grid == 0) {
        if (n_in != 16 || ws_size < 498 * MiB) { fprintf(stderr, "kernel_launch: unexpected inputs (n_in %d, ws %zu)\n", n_in, ws_size); grid = -1; return; }
        int dev = 0, cus = 0, per_cu = 0;
        hipGetDevice(&dev); hipDeviceGetAttribute(&cus, hipDeviceAttributeMultiprocessorCount, dev);
        if (hipFuncSetAttribute((const void*)hybrid_fwd, hipFuncAttributeMaxDynamicSharedMemorySize, LDS_BYTES) != hipSuccess) { fprintf(stderr, "kernel_launch: hipFuncSetAttribute failed\n"); grid = -1; return; }
        hipOccupancyMaxActiveBlocksPerMultiprocessor(&per_cu, (const void*)hybrid_fwd, NTHR, LDS_BYTES);
        (void)hipGetLastError();
        if (per_cu < 1) per_cu = 1;
        grid = cus;
        if (grid != 256) fprintf(stderr, "kernel_launch: %d CUs (built for 256)\n", grid);
    }
    if (grid < 0) return;
    if (hipMemsetAsync(d_ws, 0, 65536, stream) != hipSuccess) { fprintf(stderr, "kernel_launch: hipMemsetAsync failed\n"); return; }
    Args a{};
    for (int i = 0; i < 16; ++i) a.in[i] = (const float*)d_in[i];
    a.out = (float*)d_out; a.ws = (unsigned char*)d_ws;
    void* kargs[] = {&a};
    hipError_t e = hipLaunchCooperativeKernel((const void*)hybrid_fwd, dim3(grid), dim3(NTHR), kargs, LDS_BYTES, stream);
    if (e != hipSuccess) fprintf(stderr, "cooperative launch failed: %s (grid %d)\n", hipGetErrorString(e), grid);
}
```

```cpp
#include <hip/hip_runtime.h>
#include <cstdio>
#include <cstdint>
namespace pg8 {
#define PG8_LAS __attribute__((address_space(3)))
typedef unsigned short bf16_t;
typedef short bf16x8 __attribute__((ext_vector_type(8)));
typedef float f32x4 __attribute__((ext_vector_type(4)));
typedef unsigned u32x4 __attribute__((ext_vector_type(4)));
constexpr int BM = 256, BK = 64, HALF = 128, HTB = HALF * BK * 2  , STAGE_BYTES = 8 * HTB, NXCD = 8, WGM = 4;

__host__ __device__ __forceinline__ int lds_byte(int r, int c) { const int st = (r >> 4) * 2 + (c >> 5), rr = r & 15, cc = c & 31, ob = rr * 64 + cc * 2; return st * 1024 + (ob ^ (((ob >> 9) & 1) << 5)); }
__host__ __device__ __forceinline__ void stage_rc(int b, int& R, int& C) { const int st = b / 1024, sb = b % 1024, swz = sb ^ (((sb >> 9) & 1) << 5); R = (st >> 1) * 16 + swz / 64; C = (st & 1) * 32 + (swz % 64) / 2; }
__host__ __device__ __forceinline__ int perm32(int rho) { const int n = rho >> 4, i = rho & 15; return 8 * (i >> 2) + 4 * n + (i & 3); }

struct Unit { int pm, pn; };
struct Gemm { const bf16_t* A; const bf16_t* Bt; int M, N, K; };

struct StaticOrder {
    int nM, nN, nwg, G, c;
    __host__ __device__ void init(int M, int N, int G_, int c_) { nM = M / BM; nN = N / BM; nwg = nM * nN; G = G_; c = c_; }
    __host__ __device__ bool next(int i, Unit& u) const {
        const long L = (long)i * G + c; if (L >= nwg) return false;
        int wgid = (int)L; { const int q = nwg / NXCD, r = nwg % NXCD, xcd = wgid % NXCD, off = wgid / NXCD; wgid = (xcd < r ? xcd * (q + 1) : r * (q + 1) + (xcd - r) * q) + off; }
        const int nig = WGM * nN, gid = wgid / nig, fm = gid * WGM, gsz = (nM - fm) < WGM ? (nM - fm) : WGM;
        u.pm = fm + ((wgid % nig) % gsz); u.pn = (wgid % nig) / gsz; return true;
    }
    __device__ __forceinline__ void a_ready(const Unit&) const {}
    __device__ __forceinline__ void done(const Unit&) const {}
};

__device__ __forceinline__ unsigned cvt_pk_bf16(float lo, float hi) { unsigned r; asm volatile("v_cvt_pk_bf16_f32 %0, %1, %2" : "=v"(r) : "v"(lo), "v"(hi)); return r; }

__device__ __forceinline__ float row_rstd(const float* ss, int row) {
    const f32x4* p = (const f32x4*)(ss + (size_t)row * 16); const f32x4 a = p[0], b = p[1], c = p[2], d = p[3];
    const float t = (((a[0] + a[1]) + (a[2] + a[3])) + ((b[0] + b[1]) + (b[2] + b[3]))) + (((c[0] + c[1]) + (c[2] + c[3])) + ((d[0] + d[1]) + (d[2] + d[3])));
    return 1.0f / sqrtf(t * (1.0f / 1024.0f) + 1e-6f);
}
struct EpiProj {
    static constexpr bool PERM = true, AFTER_DRAIN = false;
    unsigned char* ws;
    const float* ss;
    __device__ __forceinline__ void operator()(const f32x4 (&acc)[2][2][4][2], const Unit& u, int wr, int wc, int fr, int fq) const {
        const int row0 = u.pm * BM + wr * 64 + fr; const int pn = u.pn;
        size_t boff; int ldc, colt;
        if (pn < 3) { boff = (size_t)84 << 20; ldc = 768; colt = pn * 256; }
        else if (pn == 3) { boff = (size_t)108 << 20; ldc = 256; colt = 0; }
        else if (pn < 6) { boff = (size_t)116 << 20; ldc = 512; colt = (pn - 4) * 256; }
        else if (pn < 8) { boff = (size_t)132 << 20; ldc = 512; colt = (pn - 6) * 256; }
        else if (pn < 10) { boff = (size_t)148 << 20; ldc = 512; colt = (pn - 8) * 256; }
        else if (pn == 10) { boff = (size_t)164 << 20; ldc = 256; colt = 0; }
        else { boff = (size_t)172 << 20; ldc = 256; colt = 0; }
        bf16_t* base = (bf16_t*)(ws + boff);
        const int col0 = colt + wc * 32 + 8 * fq;
#pragma unroll
        for (int ai = 0; ai < 2; ++ai)
#pragma unroll
            for (int m = 0; m < 4; ++m) { const int row = row0 + ai * HALF + m * 16; bf16_t* rowp = base + (size_t)row * ldc + col0;
                const float rs = ss ? row_rstd(ss, row) : 1.0f;
#pragma unroll
                for (int bj = 0; bj < 2; ++bj) { const f32x4 v0 = acc[ai][bj][m][0] * rs, v1 = acc[ai][bj][m][1] * rs;
                    u32x4 w; w.x = cvt_pk_bf16(v0[0], v0[1]); w.y = cvt_pk_bf16(v0[2], v0[3]); w.z = cvt_pk_bf16(v1[0], v1[1]); w.w = cvt_pk_bf16(v1[2], v1[3]);
                    *(u32x4*)(rowp + bj * HALF) = w; } }
    }
};
struct EpiRelu2 {
    static constexpr bool PERM = true, AFTER_DRAIN = false;
    bf16_t* O; int ldc;
    __device__ __forceinline__ void operator()(const f32x4 (&acc)[2][2][4][2], const Unit& u, int wr, int wc, int fr, int fq) const {
        const int row0 = u.pm * BM + wr * 64 + fr; const int col0 = u.pn * BM + wc * 32 + 8 * fq;
#pragma unroll
        for (int ai = 0; ai < 2; ++ai)
#pragma unroll
            for (int m = 0; m < 4; ++m) { bf16_t* rowp = O + (size_t)(row0 + ai * HALF + m * 16) * ldc + col0;
#pragma unroll
                for (int bj = 0; bj < 2; ++bj) { f32x4 v0 = acc[ai][bj][m][0], v1 = acc[ai][bj][m][1];
#pragma unroll
                    for (int e = 0; e < 4; ++e) { const float a = fmaxf(v0[e], 0.f), b = fmaxf(v1[e], 0.f); v0[e] = a * a; v1[e] = b * b; }
                    u32x4 w; w.x = cvt_pk_bf16(v0[0], v0[1]); w.y = cvt_pk_bf16(v0[2], v0[3]); w.z = cvt_pk_bf16(v1[0], v1[1]); w.w = cvt_pk_bf16(v1[2], v1[3]);
                    *(u32x4*)(rowp + bj * HALF) = w; } }
    }
};
struct EpiResid {
    static constexpr bool PERM = false, AFTER_DRAIN = false;
    const float* base; float* out; int ldc;
    __device__ __forceinline__ void operator()(const f32x4 (&acc)[2][2][4][2], const Unit& u, int wr, int wc, int fr, int fq) const {
        const int col0 = u.pn * BM + wc * 32 + 4 * fq;
#pragma unroll
        for (int ai = 0; ai < 2; ++ai)
#pragma unroll
            for (int m = 0; m < 4; ++m) { const size_t off = (size_t)(u.pm * BM + ai * HALF + wr * 64 + m * 16 + fr) * ldc + col0;
#pragma unroll
                for (int bj = 0; bj < 2; ++bj)
#pragma unroll
                    for (int n = 0; n < 2; ++n) { const f32x4 bs = *(const f32x4*)(base + off + bj * HALF + n * 16); *(f32x4*)(out + off + bj * HALF + n * 16) = bs + acc[ai][bj][m][n]; }  asm volatile("" ::: "memory"); }
    }
};

struct EpiResidN {
    static constexpr bool PERM = false, AFTER_DRAIN = false;
    const float* base; float* out; bf16_t* xb; float* ss; int ldc;
    __device__ __forceinline__ void operator()(const f32x4 (&acc)[2][2][4][2], const Unit& u, int wr, int wc, int fr, int fq) const {
        typedef unsigned u32x2 __attribute__((ext_vector_type(2)));
        const int col0 = u.pn * BM + wc * 32 + 4 * fq, lane = fr + 16 * fq;
#pragma unroll
        for (int ai = 0; ai < 2; ++ai)
#pragma unroll
            for (int m = 0; m < 4; ++m) { const int row = u.pm * BM + ai * HALF + wr * 64 + m * 16 + fr; const size_t off = (size_t)row * ldc + col0; float sq = 0.f;
#pragma unroll
                for (int bj = 0; bj < 2; ++bj)
#pragma unroll
                    for (int n = 0; n < 2; ++n) { const f32x4 bs = *(const f32x4*)(base + off + bj * HALF + n * 16); const f32x4 o = bs + acc[ai][bj][m][n];
                        *(f32x4*)(out + off + bj * HALF + n * 16) = o; sq += (o[0] * o[0] + o[1] * o[1]) + (o[2] * o[2] + o[3] * o[3]);
                        u32x2 w; w.x = cvt_pk_bf16(o[0], o[1]); w.y = cvt_pk_bf16(o[2], o[3]); *(u32x2*)(xb + off + bj * HALF + n * 16) = w; }
                sq += __int_as_float(__builtin_amdgcn_ds_bpermute((lane ^ 16) << 2, __float_as_int(sq))); sq += __int_as_float(__builtin_amdgcn_ds_bpermute((lane ^ 32) << 2, __float_as_int(sq)));
                if (fq == 0) ss[(size_t)row * 16 + u.pn * 4 + wc] = sq;
                asm volatile("" ::: "memory"); }
    }
};
struct EpiRes {
    static constexpr bool PERM = false, AFTER_DRAIN = false;
    const float* basef; const bf16_t* baseb; float* out; bf16_t* xb; float* ss;
    __device__ __forceinline__ void operator()(const f32x4 (&acc)[2][2][4][2], const Unit& u, int wr, int wc, int fr, int fq) const {
        typedef unsigned u32x2 __attribute__((ext_vector_type(2)));
        constexpr int ldc = 1024; const int col0 = u.pn * BM + wc * 32 + 4 * fq, lane = fr + 16 * fq;
#pragma unroll
        for (int ai = 0; ai < 2; ++ai)
#pragma unroll
            for (int m = 0; m < 4; ++m) { const int row = u.pm * BM + ai * HALF + wr * 64 + m * 16 + fr; const size_t off = (size_t)row * ldc + col0; float sq = 0.f;
#pragma unroll
                for (int bj = 0; bj < 2; ++bj)
#pragma unroll
                    for (int n = 0; n < 2; ++n) { const size_t o2 = off + bj * HALF + n * 16; f32x4 bs;
                        if (baseb) { const u32x2 b2 = *(const u32x2*)(baseb + o2); bs = (f32x4){__uint_as_float(b2.x << 16), __uint_as_float(b2.x & 0xffff0000u), __uint_as_float(b2.y << 16), __uint_as_float(b2.y & 0xffff0000u)}; }
                        else bs = *(const f32x4*)(basef + o2);
                        const f32x4 o = bs + acc[ai][bj][m][n];
                        if (out) *(f32x4*)(out + o2) = o;
                        if (xb) { sq += (o[0] * o[0] + o[1] * o[1]) + (o[2] * o[2] + o[3] * o[3]); u32x2 w; w.x = cvt_pk_bf16(o[0], o[1]); w.y = cvt_pk_bf16(o[2], o[3]); *(u32x2*)(xb + o2) = w; } }
                if (xb) { sq += __int_as_float(__builtin_amdgcn_ds_bpermute((lane ^ 16) << 2, __float_as_int(sq))); sq += __int_as_float(__builtin_amdgcn_ds_bpermute((lane ^ 32) << 2, __float_as_int(sq)));
                    if (fq == 0) ss[(size_t)row * 16 + u.pn * 4 + wc] = sq; }
                asm volatile("" ::: "memory"); }
    }
};
struct EpiRelu2S {
    static constexpr bool PERM = true, AFTER_DRAIN = false;
    bf16_t* O; const float* ss; int ldc;
    __device__ __forceinline__ void operator()(const f32x4 (&acc)[2][2][4][2], const Unit& u, int wr, int wc, int fr, int fq) const {
        const int row0 = u.pm * BM + wr * 64 + fr; const int col0 = u.pn * BM + wc * 32 + 8 * fq;
#pragma unroll
        for (int ai = 0; ai < 2; ++ai)
#pragma unroll
            for (int m = 0; m < 4; ++m) { const int row = row0 + ai * HALF + m * 16; bf16_t* rowp = O + (size_t)row * ldc + col0;
                const float rs = row_rstd(ss, row);
#pragma unroll
                for (int bj = 0; bj < 2; ++bj) { f32x4 v0 = acc[ai][bj][m][0], v1 = acc[ai][bj][m][1];
#pragma unroll
                    for (int e = 0; e < 4; ++e) { const float a = fmaxf(v0[e] * rs, 0.f), b = fmaxf(v1[e] * rs, 0.f); v0[e] = a * a; v1[e] = b * b; }
                    u32x4 w; w.x = cvt_pk_bf16(v0[0], v0[1]); w.y = cvt_pk_bf16(v0[2], v0[3]); w.z = cvt_pk_bf16(v1[0], v1[1]); w.w = cvt_pk_bf16(v1[2], v1[3]);
                    *(u32x4*)(rowp + bj * HALF) = w; } }
    }
};

template <class Epi, class Sched, bool ALIGN_EPI = false, bool SP2 = false>
__device__ __forceinline__ void gemm_phase(PG8_LAS unsigned char* lds, const Gemm g, const Sched& S, const Epi& E) {
    int tid_l = threadIdx.x; asm volatile("" : "+v"(tid_l));
    const int tid = tid_l, wid = __builtin_amdgcn_readfirstlane(tid >> 6), lane = tid & 63, wr = wid >> 2, wc = wid & 3, fr = lane & 15, fq = lane >> 4;
    const int K = g.K, nt = K / BK;
    unsigned voffA[2], voffB[2];
#pragma unroll
    for (int i = 0; i < 2; ++i) { int R, C; stage_rc(tid * 16 + i * 8192, R, C); const int Rb = Epi::PERM ? ((R & ~31) + perm32(R & 31)) : R;
        voffA[i] = (unsigned)(R * K + C) * 2u; voffB[i] = (unsigned)(Rb * K + C) * 2u; }
    const size_t kstep = (size_t)(BK * 2);
    const size_t hstep = (size_t)HALF * K * 2;
    const size_t tstep = 2 * hstep;
    const unsigned ldsw = (unsigned)wid * 1024u;
    const int aoff = lds_byte(wr * 64 + fr, fq * 8), boff = lds_byte(wc * 32 + fr, fq * 8);
#define PG8_SA(b, h) (((b) * 2 + (h)) * HTB)
#define PG8_SB(b, h) ((4 + (b) * 2 + (h)) * HTB)
#define PG8_STAGE(bufoff, gbase, voff) do { _Pragma("unroll") for (int _i = 0; _i < 2; ++_i) \
        __builtin_amdgcn_global_load_lds((const unsigned*)((const char*)(gbase) + (voff)[_i]), (PG8_LAS unsigned*)(lds + (bufoff) + ldsw + _i * 8192), 16, 0, 0); } while (0)
#define PG8_LDA(dst, b, h) do { _Pragma("unroll") for (int m = 0; m < 4; ++m) _Pragma("unroll") for (int k = 0; k < 2; ++k) dst[m][k] = *(const PG8_LAS bf16x8*)(lds + PG8_SA(b, h) + aoff + m * 2048 + k * 1024); } while (0)
#define PG8_LDB(dst, b, h) do { _Pragma("unroll") for (int n = 0; n < 2; ++n) _Pragma("unroll") for (int k = 0; k < 2; ++k) dst[n][k] = *(const PG8_LAS bf16x8*)(lds + PG8_SB(b, h) + boff + n * 2048 + k * 1024); } while (0)
#define PG8_MMA(ai, bj, At, Bt) do { __builtin_amdgcn_s_setprio(1); _Pragma("unroll") for (int m = 0; m < 4; ++m) _Pragma("unroll") for (int n = 0; n < 2; ++n) _Pragma("unroll") for (int k = 0; k < 2; ++k) \
        acc[ai][bj][m][n] = __builtin_amdgcn_mfma_f32_16x16x32_bf16(Bt[n][k], At[m][k], acc[ai][bj][m][n], 0, 0, 0); __builtin_amdgcn_s_setprio(0); } while (0)
#define PG8_WAIT_V(n) asm volatile("s_waitcnt vmcnt(" #n ")" ::: "memory")
#define PG8_WAIT_L(n) asm volatile("s_waitcnt lgkmcnt(" #n ")" ::: "memory")
#define PG8_BAR __builtin_amdgcn_s_barrier()
#define PG8_SCHED __builtin_amdgcn_sched_barrier(0)
    Unit cur, nxt; int ui = 0;
    if (!S.next(0, cur)) return;
    f32x4 acc[2][2][4][2];
#pragma unroll
    for (int a = 0; a < 2; ++a)
#pragma unroll
        for (int b = 0; b < 2; ++b)
#pragma unroll
            for (int m = 0; m < 4; ++m)
#pragma unroll
                for (int n = 0; n < 2; ++n) acc[a][b][m][n] = (f32x4){0.f, 0.f, 0.f, 0.f};
    bf16x8 At[4][2], B0[2][2], B1[2][2];
    const char* cA = (const char*)g.A + (size_t)cur.pm * tstep; const char* cB = (const char*)g.Bt + (size_t)cur.pn * tstep;
    S.a_ready(cur);
    if constexpr (SP2) {
        PG8_STAGE(PG8_SB(0, 0), cB, voffB); PG8_STAGE(PG8_SB(0, 1), cB + hstep, voffB); PG8_STAGE(PG8_SA(0, 0), cA, voffA); PG8_STAGE(PG8_SA(0, 1), cA + hstep, voffA);
        if (wr == 1) PG8_BAR;
        PG8_WAIT_V(2); PG8_BAR;
        PG8_STAGE(PG8_SB(1, 0), cB + kstep, voffB); PG8_STAGE(PG8_SA(1, 0), cA + kstep, voffA); PG8_STAGE(PG8_SB(1, 1), cB + hstep + kstep, voffB);
        PG8_WAIT_V(6); PG8_BAR;
    } else {
        PG8_STAGE(PG8_SB(0, 0), cB, voffB); PG8_STAGE(PG8_SA(0, 0), cA, voffA); PG8_STAGE(PG8_SB(0, 1), cB + hstep, voffB); PG8_STAGE(PG8_SA(0, 1), cA + hstep, voffA);
        if (wr == 1) PG8_BAR;
        PG8_WAIT_V(4); PG8_BAR;
        PG8_STAGE(PG8_SB(1, 0), cB + kstep, voffB); PG8_STAGE(PG8_SA(1, 0), cA + kstep, voffA); PG8_STAGE(PG8_SB(1, 1), cB + hstep + kstep, voffB);
        PG8_WAIT_V(6); PG8_BAR;
    }
    for (;;) {
        const bool has_next = S.next(ui + 1, nxt);
        const char* nA = has_next ? (const char*)g.A + (size_t)nxt.pm * tstep : cA; const char* nB = has_next ? (const char*)g.Bt + (size_t)nxt.pn * tstep : cB;
        for (int t = 0; t < nt; t += 2) {
            const bool last = (t == nt - 2);
            const char* a1 = cA + (size_t)(t + 1) * kstep;
            const char* a2 = last ? nA : cA + (size_t)(t + 2) * kstep; const char* b2 = last ? nB : cB + (size_t)(t + 2) * kstep;
            const char* a3 = a2 + kstep; const char* b3 = b2 + kstep;
            if (last && has_next) S.a_ready(nxt);
            if constexpr (SP2) {
            PG8_LDB(B0, 0, 0); PG8_LDB(B1, 0, 1); PG8_SCHED; PG8_LDA(At, 0, 0); PG8_STAGE(PG8_SA(1, 1), a1 + hstep, voffA);
            PG8_WAIT_V(8); PG8_WAIT_L(0); PG8_BAR; PG8_MMA(0, 0, At, B0); PG8_MMA(0, 1, At, B1); PG8_BAR; PG8_SCHED;
            PG8_LDA(At, 0, 1); PG8_STAGE(PG8_SB(0, 0), b2, voffB); PG8_STAGE(PG8_SB(0, 1), b2 + hstep, voffB); PG8_STAGE(PG8_SA(0, 0), a2, voffA);
            PG8_WAIT_V(8); PG8_WAIT_L(0); PG8_BAR; PG8_MMA(1, 0, At, B0); PG8_MMA(1, 1, At, B1); PG8_BAR; PG8_SCHED;
            PG8_LDB(B0, 1, 0); PG8_LDB(B1, 1, 1); PG8_SCHED; PG8_LDA(At, 1, 0); PG8_STAGE(PG8_SA(0, 1), a2 + hstep, voffA);
            PG8_WAIT_V(8); PG8_WAIT_L(0); PG8_BAR; PG8_MMA(0, 0, At, B0); PG8_MMA(0, 1, At, B1); PG8_BAR; PG8_SCHED;
            PG8_LDA(At, 1, 1); PG8_STAGE(PG8_SB(1, 0), b3, voffB); PG8_STAGE(PG8_SB(1, 1), b3 + hstep, voffB); PG8_STAGE(PG8_SA(1, 0), a3, voffA);
            PG8_WAIT_V(8); PG8_WAIT_L(0); PG8_BAR; PG8_MMA(1, 0, At, B0); PG8_MMA(1, 1, At, B1); PG8_BAR; PG8_SCHED;
            } else {
            PG8_LDB(B0, 0, 0); PG8_SCHED; PG8_LDA(At, 0, 0); PG8_STAGE(PG8_SA(1, 1), a1 + hstep, voffA);
            PG8_WAIT_L(8); PG8_BAR; PG8_WAIT_L(0); PG8_MMA(0, 0, At, B0); PG8_BAR; PG8_SCHED;
            PG8_LDB(B1, 0, 1); PG8_STAGE(PG8_SB(0, 0), b2, voffB);
            PG8_BAR; PG8_WAIT_L(0); PG8_MMA(0, 1, At, B1); PG8_BAR;
            PG8_LDA(At, 0, 1); PG8_STAGE(PG8_SA(0, 0), a2, voffA);
            PG8_BAR; PG8_WAIT_L(0); PG8_MMA(1, 0, At, B0); PG8_BAR; PG8_SCHED;
            PG8_STAGE(PG8_SB(0, 1), b2 + hstep, voffB);
            PG8_WAIT_V(6); PG8_BAR; PG8_MMA(1, 1, At, B1); PG8_BAR;
            PG8_LDB(B0, 1, 0); PG8_SCHED; PG8_LDA(At, 1, 0); PG8_STAGE(PG8_SA(0, 1), a2 + hstep, voffA);
            PG8_WAIT_L(8); PG8_BAR; PG8_WAIT_L(0); PG8_MMA(0, 0, At, B0); PG8_BAR; PG8_SCHED;
            PG8_LDB(B1, 1, 1); PG8_STAGE(PG8_SB(1, 0), b3, voffB);
            PG8_BAR; PG8_WAIT_L(0); PG8_MMA(0, 1, At, B1); PG8_BAR;
            PG8_LDA(At, 1, 1); PG8_STAGE(PG8_SA(1, 0), a3, voffA);
            PG8_BAR; PG8_WAIT_L(0); PG8_MMA(1, 0, At, B0); PG8_BAR; PG8_SCHED;
            PG8_STAGE(PG8_SB(1, 1), b3 + hstep, voffB);
            PG8_WAIT_V(6); PG8_BAR; PG8_MMA(1, 1, At, B1); PG8_BAR;
            }
        }
        if constexpr (ALIGN_EPI) { if (wr == 0) PG8_BAR; }
        if constexpr (!Epi::AFTER_DRAIN) { E(acc, cur, wr, wc, fr, fq); S.done(cur); }
        if (!has_next) break;
#pragma unroll
        for (int a = 0; a < 2; ++a)
#pragma unroll
            for (int b = 0; b < 2; ++b)
#pragma unroll
                for (int m = 0; m < 4; ++m)
#pragma unroll
                    for (int n = 0; n < 2; ++n) acc[a][b][m][n] = (f32x4){0.f, 0.f, 0.f, 0.f};
        cur = nxt; cA = nA; cB = nB; ++ui;
        if constexpr (ALIGN_EPI) { if (wr == 1) PG8_BAR; }
    }
    PG8_WAIT_V(0);
    if constexpr (!ALIGN_EPI) { if (wr == 0) PG8_BAR; }
    PG8_BAR;
    if constexpr (Epi::AFTER_DRAIN) { E.fused(acc, cur, wr, wc, fr, fq, lds, wid, lane); S.done(cur); }
#undef PG8_SA
#undef PG8_SB
#undef PG8_STAGE
#undef PG8_LDA
#undef PG8_LDB
#undef PG8_MMA
#undef PG8_WAIT_V
#undef PG8_WAIT_L
#undef PG8_BAR
#undef PG8_SCHED
}
}

#ifndef PG8_SP2
#define PG8_SP2 true
#endif
#ifndef PG8_ALIGN
#define PG8_ALIGN true
#endif
#include <hip/hip_bf16.h>
#include <cmath>
namespace attn_body {
using bf16=__hip_bfloat16;
using bf16x8=__attribute__((ext_vector_type(8)))short;
using s16x4=__attribute__((ext_vector_type(4)))short;
using f32x16=__attribute__((ext_vector_type(16)))float;
using u32x4=__attribute__((ext_vector_type(4)))unsigned;
constexpr int SEQ=8192,D=64;
constexpr int NW=8,QBLK=32,QB=QBLK*NW,KVBLK=64,NQB=SEQ/QB;
constexpr int ATTN_UNIT_ROWS=QB;
__device__ __forceinline__ int crow(int r,int hi){return (r&3)+8*(r>>2)+4*hi;}
#define SBAR() __builtin_amdgcn_sched_barrier(0)
__device__ __forceinline__ void cmask(f32x16&p0,f32x16&p1,int jb,int qrel,int hi){
  const float NEG=-INFINITY; int kb=64*jb+4*hi;
  #pragma unroll
  for(int r=0;r<16;++r){int kv=kb+(r&3)+8*(r>>2); if(kv>qrel)p0[r]=NEG; if(kv+32>qrel)p1[r]=NEG;}
}

constexpr int NSLOT=3, SLOTB=8192;
constexpr int LDS_K=0, LDS_V=NSLOT*SLOTB, LDS_WS=2*NSLOT*SLOTB, LDS_OST=LDS_WS+NW*64*4, LDS_BYTES=LDS_OST+NW*4096;
constexpr float C2=0.125f*1.4426950408889634f;
__device__ __forceinline__ void glds16(const void*gsrc,unsigned lds_dst){unsigned keep;
  asm volatile("s_mov_b32 %0, m0\n\ts_mov_b32 m0, %2\n\ts_nop 0\n\tglobal_load_lds_dwordx4 %1, off\n\ts_mov_b32 m0, %0":"=&s"(keep):"v"(gsrc),"s"(lds_dst):"memory");}
__device__ __forceinline__ float max3f(float a,float b,float c){float r;asm("v_max3_f32 %0, %1, %2, %3":"=v"(r):"v"(a),"v"(b),"v"(c));return r;}
__device__ __forceinline__ float max2f(float a,float b){float r;asm("v_max_f32_e32 %0, %1, %2":"=v"(r):"v"(a),"v"(b));return r;}
__device__ __forceinline__ float fadd_s(float a,float b){float r;asm("v_add_f32_e32 %0, %1, %2":"=v"(r):"v"(a),"v"(b));return r;}
__device__ __forceinline__ float fsub_s(float a,float b){float r;asm("v_sub_f32_e32 %0, %1, %2":"=v"(r):"v"(a),"v"(b));return r;}
typedef float f32x2_t __attribute__((ext_vector_type(2))); typedef __bf16 bf16x2_t __attribute__((ext_vector_type(2)));
__device__ __forceinline__ unsigned cvtpk_s(float lo,float hi){f32x2_t v={lo,hi};bf16x2_t b=__builtin_convertvector(v,bf16x2_t);return __builtin_bit_cast(unsigned,b);}
#define WAIT_BAR(N) asm volatile("s_waitcnt vmcnt(" #N ") lgkmcnt(0)\n\ts_barrier":::"memory")

__device__ __forceinline__ void qkt(f32x16&p0,f32x16&p1,const char*Kslot,const bf16x8*qr,const f32x16&negm,int r32,int hi){
  const char*kb=Kslot+hi*1024+r32*16;
  #pragma unroll
  for(int d0=0;d0<4;++d0){
    const bf16x8 b0=*reinterpret_cast<const bf16x8*>(kb+d0*2048);
    const bf16x8 b1=*reinterpret_cast<const bf16x8*>(kb+d0*2048+512);
    if(d0==0){p0=__builtin_amdgcn_mfma_f32_32x32x16_bf16(b0,qr[0],negm,0,0,0);p1=__builtin_amdgcn_mfma_f32_32x32x16_bf16(b1,qr[0],negm,0,0,0);}
    else{p0=__builtin_amdgcn_mfma_f32_32x32x16_bf16(b0,qr[d0],p0,0,0,0);p1=__builtin_amdgcn_mfma_f32_32x32x16_bf16(b1,qr[d0],p1,0,0,0);}}
}
typedef __attribute__((address_space(3))) const char* lds_cptr;
typedef short v4i16_t __attribute__((ext_vector_type(4)));
__device__ __forceinline__ void kload8(bf16x8*kf,lds_cptr kp){
  kf[0]=*(const __attribute__((address_space(3))) bf16x8*)(kp);      kf[1]=*(const __attribute__((address_space(3))) bf16x8*)(kp+512);
  kf[2]=*(const __attribute__((address_space(3))) bf16x8*)(kp+2048); kf[3]=*(const __attribute__((address_space(3))) bf16x8*)(kp+2560);
  kf[4]=*(const __attribute__((address_space(3))) bf16x8*)(kp+4096); kf[5]=*(const __attribute__((address_space(3))) bf16x8*)(kp+4608);
  kf[6]=*(const __attribute__((address_space(3))) bf16x8*)(kp+6144); kf[7]=*(const __attribute__((address_space(3))) bf16x8*)(kp+6656);
}
__device__ __forceinline__ void kload2(bf16x8*kf,lds_cptr kp,int j){ kf[2*j]=*(const __attribute__((address_space(3))) bf16x8*)(kp+j*2048); kf[2*j+1]=*(const __attribute__((address_space(3))) bf16x8*)(kp+j*2048+512); }
__device__ __forceinline__ s16x4 vtr(lds_cptr p){ return __builtin_bit_cast(s16x4,__builtin_amdgcn_ds_read_tr16_b64_v4i16((__attribute__((address_space(3))) v4i16_t*)p)); }
__device__ __forceinline__ float rowmax(const f32x16&p0,const f32x16&p1){
  float a=max3f(p0[0],p0[1],p1[0]),b=max3f(p0[2],p0[3],p1[1]);a=max3f(a,p1[2],p1[3]);
  #pragma unroll
  for(int r=4;r<16;r+=4){a=max3f(a,p0[r],p0[r+1]);b=max3f(b,p0[r+2],p0[r+3]);a=max3f(a,p1[r],p1[r+1]);b=max3f(b,p1[r+2],p1[r+3]);}
  const float m=max2f(a,b);
  auto rr=__builtin_amdgcn_permlane32_swap(__float_as_uint(m),__float_as_uint(m),false,false);
  return max2f(__uint_as_float(rr[0]),__uint_as_float(rr[1]));
}
__device__ __forceinline__ void pv(f32x16*o,int vb,bf16x8 pa0,bf16x8 pa1,bf16x8 pa2,bf16x8 pa3){
  #pragma unroll
  for(int d0=0;d0<2;++d0){s16x4 lo[4],hi[4];
    #pragma unroll
    for(int ks=0;ks<4;++ks){
      asm volatile("ds_read_b64_tr_b16 %0,%1 offset:%c2":"=&v"(lo[ks]):"v"(vb),"i"(d0*4096+ks*1024):"memory");
      asm volatile("ds_read_b64_tr_b16 %0,%1 offset:%c2":"=&v"(hi[ks]):"v"(vb),"i"(d0*4096+ks*1024+512):"memory");}
    asm volatile("s_waitcnt lgkmcnt(0)":::"memory");SBAR();
    #define PK(k) (bf16x8){lo[k][0],lo[k][1],lo[k][2],lo[k][3],hi[k][0],hi[k][1],hi[k][2],hi[k][3]}
    o[d0]=__builtin_amdgcn_mfma_f32_32x32x16_bf16(pa0,PK(0),o[d0],0,0,0);
    o[d0]=__builtin_amdgcn_mfma_f32_32x32x16_bf16(pa1,PK(1),o[d0],0,0,0);
    o[d0]=__builtin_amdgcn_mfma_f32_32x32x16_bf16(pa2,PK(2),o[d0],0,0,0);
    o[d0]=__builtin_amdgcn_mfma_f32_32x32x16_bf16(pa3,PK(3),o[d0],0,0,0);
    #undef PK
  }
}

#ifndef ATTN_STORE16
#define ATTN_STORE16(p,v) (*(u32x4*)(p)=(v))
#endif
__device__ __forceinline__ void swamask(f32x16&p0,f32x16&p1,int kvrel,int qrel,int hi){
  const float NEG=-INFINITY; const int kb=kvrel+4*hi-qrel;
  #pragma unroll
  for(int r=0;r<16;++r){int dl=kb+(r&3)+8*(r>>2); if(dl>128||dl<-128)p0[r]=NEG; if(dl+32>128||dl+32<-128)p1[r]=NEG;}
}
template<int THRL,int MODE> __device__ __forceinline__ void attn_unit(const bf16*Qb,int qp,const bf16*__restrict__ Kh,int kp,const bf16*__restrict__ Vh,int vp,bf16*Ob,int op,int q0,float sink_l2,char*shm,int kv0=0,float*stats=nullptr,bool primed=false,bool prime_next=false){
  int tid_l=threadIdx.x; asm volatile("":"+v"(tid_l));
  const int tid=tid_l,lane=tid&63,r32=lane&31,hi=lane>>5; const int wid=__builtin_amdgcn_readfirstlane(tid>>6);
  const bf16*Qw=Qb+(long)(q0+wid*QBLK)*qp;
  const unsigned ord=(MODE==1)?((q0==0)?0x765243u:((q0==SEQ-QB)?0x015243u:0x70615243u)):0u;
  #define KVS(t) ((MODE==1)?(q0-128+64*(int)((ord>>(4*(t)))&15u)):((MODE==2)?(kv0+64*(t)):(64*(t))))
  const unsigned lds0=(unsigned)(uintptr_t)shm;
  float*wsf=(float*)(shm+LDS_WS)+wid*64;
  const bf16*ksrc=Kh+(long)lane*kp+wid*8;
  const bf16*vsrc=Vh+(long)(16*(wid&3)+(lane>>2))*vp+(wid>>2)*32+(lane&3)*8;
  const unsigned kdst=lds0+LDS_K+wid*1024, vdst=lds0+LDS_V+wid*1024;
  #define DMA_K(t,slot) glds16(ksrc+(long)KVS(t)*kp,(unsigned)__builtin_amdgcn_readfirstlane(kdst+(slot)))
  #define DMA_V(t,slot) glds16(vsrc+(long)KVS(t)*vp,(unsigned)__builtin_amdgcn_readfirstlane(vdst+(slot)))
  const int vb0=(int)(lds0+LDS_V)+((lane>>4)&1)*32+(lane&3)*8+(4*hi+((lane&15)>>2))*64;
  const char*Kbase=shm+LDS_K; bf16x8 kf[8];
  const lds_cptr shm3=(lds_cptr)shm; const lds_cptr kp0=shm3+LDS_K+hi*1024+r32*16; const lds_cptr vp0=shm3+LDS_V+((lane>>4)&1)*32+(lane&3)*8+(4*hi+((lane&15)>>2))*64;
  const int NT=(MODE==1)?((q0==0||q0==SEQ-QB)?6:8):((MODE==2)?(SEQ/KVBLK/4):(SEQ/KVBLK));
  if(!primed){DMA_K(0,0);DMA_V(0,0);DMA_K(1,SLOTB);}
  bf16x8 qr[4];
  #pragma unroll
  for(int d0=0;d0<4;++d0)qr[d0]=*reinterpret_cast<const bf16x8*>(&Qw[(long)r32*qp+d0*16+hi*8]);
  float mhat=0.f,l_reg=0.f;float z0_=0.f;asm volatile("":"+v"(z0_));f32x16 o[2],negm;
  #pragma unroll
  for(int r=0;r<16;++r){o[0][r]=z0_;o[1][r]=z0_;negm[r]=z0_;}
  asm volatile("":"+v"(negm));
  const int qrel=wid*QBLK+r32;
  #define CMASK(P0,P1,t) do{ if constexpr(MODE==1) swamask(P0,P1,KVS(t)-q0,qrel,hi); }while(0)
  bool resc=false;
  #define START(P0,P1) do{ const float rm=rowmax(P0,P1); resc=false; \
    { const float dl=rm; mhat=fadd_s(mhat,dl); \
      _Pragma("unroll") for(int r=0;r<16;++r){P0[r]=fsub_s(P0[r],dl);P1[r]=fsub_s(P1[r],dl);} \
      _Pragma("unroll") for(int r=0;r<16;++r)negm[r]=-mhat; asm volatile("":"+v"(negm)); } \
    _Pragma("unroll") for(int r=0;r<16;++r)P0[r]=__builtin_amdgcn_exp2f(P0[r]); }while(0)
  #define RESC() do{ if(resc){ asm volatile("s_waitcnt lgkmcnt(0)":::"memory"); \
      _Pragma("unroll") for(int d_=0;d_<2;++d_) _Pragma("unroll") for(int r=0;r<16;++r)o[d_][r]*=wsf[crow(r,hi)]; } }while(0)
  f32x16 pA0,pA1,pB0,pB1;
  int sl_prev=0,sl_cur=0,sl_next=SLOTB;
  #define ROT() do{sl_prev=sl_cur;sl_cur=sl_next;sl_next=(sl_next==(NSLOT-1)*SLOTB)?0:sl_next+SLOTB;}while(0)
  DMA_K(2,2*SLOTB);
  WAIT_BAR(3);
  qkt(pA0,pA1,Kbase,qr,negm,r32,hi);asm volatile("s_nop 15\n\ts_nop 7":"+v"(pA0),"+v"(pA1));CMASK(pA0,pA1,0);
  START(pA0,pA1);
  _Pragma("unroll") for(int r=0;r<16;++r)pA1[r]=__builtin_amdgcn_exp2f(pA1[r]);
  WAIT_BAR(0);
  DMA_K(3,0);DMA_V(1,SLOTB);
  ROT();
  kload8(kf,kp0+sl_cur);
  WAIT_BAR(2);
  s16x4 vlo[8],vhi[8]; u32x4 pw0,pw1,pw2,pw3;
  #define PKW(P,B) cvtpk_s(P[B],P[B+1])
  #define PAF(k) __builtin_bit_cast(bf16x8,pw##k)
  #define VFR(i) (bf16x8){vlo[i][0],vlo[i][1],vlo[i][2],vlo[i][3],vhi[i][0],vhi[i][1],vhi[i][2],vhi[i][3]}
  #define PIN(x) asm volatile("":"+v"(x))
  #define MX3(a,b,c) __builtin_fmaxf(__builtin_fmaxf((a),(b)),(c))
  #define GAPA(MF,A0,A1,A2,A3,W0,W1,PW) do{ MF; sacc+=A0; sacc+=A1; sacc+=A2; sacc+=A3; PIN(sacc); W0; W1; PIN(PW); SBAR(); }while(0)
  #define EX(v) __builtin_amdgcn_exp2f(v)
  #define GAPB(MF,X,B) do{ MF; X[B]=EX(X[B]); X[B+1]=EX(X[B+1]); X[B+2]=EX(X[B+2]); X[B+3]=EX(X[B+3]); PIN(X); SBAR(); }while(0)
  #define VRD(i) do{ vlo[i]=vtr(vp_+(((i)>>2)*4096+((i)&3)*1024)); vhi[i]=vtr(vp_+(((i)>>2)*4096+((i)&3)*1024+512)); }while(0)
  #define KRD(G,j) do{ if(G){ kload2(kf,kp0+sl_next,j); SBAR(); } }while(0)
  #define STEP(C0,C1,P0,P1,t,GK,GV,GL) do{ SBAR(); \
    const lds_cptr vp_=vp0+sl_prev; \
    __builtin_amdgcn_s_setprio(1); VRD(0); SBAR(); float sacc=(P0[0]+P0[1]); \
    GAPA(C0=__builtin_amdgcn_mfma_f32_32x32x16_bf16(kf[0],qr[0],negm,0,0,0), P0[2],P0[3],P0[4],P0[5],     pw0[0]=PKW(P0,0), pw0[1]=PKW(P0,2), pw0); \
    VRD(4); SBAR(); GAPA(C1=__builtin_amdgcn_mfma_f32_32x32x16_bf16(kf[1],qr[0],negm,0,0,0), P0[6],P0[7],P0[8],P0[9],     pw0[2]=PKW(P0,4), pw0[3]=PKW(P0,6), pw0); \
    VRD(1); SBAR(); GAPA(C0=__builtin_amdgcn_mfma_f32_32x32x16_bf16(kf[2],qr[1],C0,0,0,0),   P0[10],P0[11],P0[12],P0[13], pw1[0]=PKW(P0,8), pw1[1]=PKW(P0,10), pw1); \
    VRD(5); SBAR(); GAPA(C1=__builtin_amdgcn_mfma_f32_32x32x16_bf16(kf[3],qr[1],C1,0,0,0),   P0[14],P0[15],P1[0],P1[1],   pw1[2]=PKW(P0,12),pw1[3]=PKW(P0,14), pw1); \
    VRD(2); SBAR(); GAPA(C0=__builtin_amdgcn_mfma_f32_32x32x16_bf16(kf[4],qr[2],C0,0,0,0),   P1[2],P1[3],P1[4],P1[5],     pw2[0]=PKW(P1,0), pw2[1]=PKW(P1,2), pw2); \
    VRD(6); SBAR(); GAPA(C1=__builtin_amdgcn_mfma_f32_32x32x16_bf16(kf[5],qr[2],C1,0,0,0),   P1[6],P1[7],P1[8],P1[9],     pw2[2]=PKW(P1,4), pw2[3]=PKW(P1,6), pw2); \
    VRD(3); SBAR(); GAPA(C0=__builtin_amdgcn_mfma_f32_32x32x16_bf16(kf[6],qr[3],C0,0,0,0),   P1[10],P1[11],P1[12],P1[13], pw3[0]=PKW(P1,8), pw3[1]=PKW(P1,10), pw3); \
    VRD(7); SBAR(); GAPA(C1=__builtin_amdgcn_mfma_f32_32x32x16_bf16(kf[7],qr[3],C1,0,0,0),   P1[14],P1[15],0.f,0.f,       pw3[2]=PKW(P1,12),pw3[3]=PKW(P1,14), pw3); \
    l_reg+=sacc; __builtin_amdgcn_s_setprio(0); \
    if(GK){DMA_K((t)+3,sl_cur);} if(GV){DMA_V((t)+1,sl_next);} \
    CMASK(C0,C1,t); \
    { float a=MX3(C0[0],C0[1],C1[0]),b=MX3(C0[2],C0[3],C1[1]); a=MX3(a,C1[2],C1[3]); \
      _Pragma("unroll") for(int r=4;r<16;r+=4){a=MX3(a,C0[r],C0[r+1]);b=MX3(b,C0[r+2],C0[r+3]);a=MX3(a,C1[r],C1[r+1]);b=MX3(b,C1[r+2],C1[r+3]);} \
      float rm=__builtin_fmaxf(a,b); { auto rr=__builtin_amdgcn_permlane32_swap(__float_as_uint(rm),__float_as_uint(rm),false,false); rm=__builtin_fmaxf(__uint_as_float(rr[0]),__uint_as_float(rr[1])); } \
      resc=false; \
      if(__builtin_expect(__any(rm>(float)THRL),0)){ const float dl=__builtin_fmaxf(rm,0.f); mhat+=dl; \
        _Pragma("unroll") for(int r=0;r<16;++r){C0[r]-=dl;C1[r]-=dl;} \
        _Pragma("unroll") for(int r=0;r<16;++r)negm[r]=-mhat; asm volatile("":"+v"(negm)); \
        const float f=__builtin_amdgcn_exp2f(-dl); l_reg*=f; if(hi==0)wsf[r32]=f; resc=true; } } \
    SBAR(); \
    __builtin_amdgcn_s_setprio(1); \
    GAPB(o[0]=__builtin_amdgcn_mfma_f32_32x32x16_bf16(PAF(0),VFR(0),o[0],0,0,0), C0,0); \
    GAPB(o[1]=__builtin_amdgcn_mfma_f32_32x32x16_bf16(PAF(0),VFR(4),o[1],0,0,0), C0,4); \
    KRD(GL,0); GAPB(o[0]=__builtin_amdgcn_mfma_f32_32x32x16_bf16(PAF(1),VFR(1),o[0],0,0,0), C0,8); \
    KRD(GL,1); GAPB(o[1]=__builtin_amdgcn_mfma_f32_32x32x16_bf16(PAF(1),VFR(5),o[1],0,0,0), C0,12); \
    KRD(GL,2); GAPB(o[0]=__builtin_amdgcn_mfma_f32_32x32x16_bf16(PAF(2),VFR(2),o[0],0,0,0), C1,0); \
    KRD(GL,3); GAPB(o[1]=__builtin_amdgcn_mfma_f32_32x32x16_bf16(PAF(2),VFR(6),o[1],0,0,0), C1,4); \
    GAPB(o[0]=__builtin_amdgcn_mfma_f32_32x32x16_bf16(PAF(3),VFR(3),o[0],0,0,0), C1,8); \
    GAPB(o[1]=__builtin_amdgcn_mfma_f32_32x32x16_bf16(PAF(3),VFR(7),o[1],0,0,0), C1,12); \
    __builtin_amdgcn_s_setprio(0); \
    }while(0)
  int t=1;
  for(;t+5<NT;t+=2){
    STEP(pB0,pB1,pA0,pA1,t,true,true,true);     WAIT_BAR(2); RESC(); ROT();
    STEP(pA0,pA1,pB0,pB1,t+1,true,true,true);   WAIT_BAR(2); RESC(); ROT();
  }
  #undef CMASK
  #define CMASK(P0,P1,t) do{ if constexpr(MODE==1) swamask(P0,P1,KVS(t)-q0,qrel,hi); }while(0)
  #define ENDW(tt) do{ if((tt)+3<NT){WAIT_BAR(2);} else if((tt)+2<NT){WAIT_BAR(1);} else {WAIT_BAR(0);} }while(0)
  for(;t+1<NT;t+=2){
    STEP(pB0,pB1,pA0,pA1,t,(t+3<NT),(t+1<NT),(t+1<NT));       ENDW(t);   RESC(); ROT();
    STEP(pA0,pA1,pB0,pB1,t+1,(t+4<NT),(t+2<NT),(t+2<NT));     ENDW(t+1); RESC(); ROT();
  }
  STEP(pB0,pB1,pA0,pA1,NT-1,false,false,false); RESC();
  { float sacc=pB0[0]+pB0[1]; _Pragma("unroll") for(int r=2;r<16;++r)sacc+=pB0[r]; _Pragma("unroll") for(int r=0;r<16;++r)sacc+=pB1[r]; l_reg+=sacc;
    pw0=(u32x4){PKW(pB0,0),PKW(pB0,2),PKW(pB0,4),PKW(pB0,6)};pw1=(u32x4){PKW(pB0,8),PKW(pB0,10),PKW(pB0,12),PKW(pB0,14)};pw2=(u32x4){PKW(pB1,0),PKW(pB1,2),PKW(pB1,4),PKW(pB1,6)};pw3=(u32x4){PKW(pB1,8),PKW(pB1,10),PKW(pB1,12),PKW(pB1,14)};
    SBAR(); pv(o,vb0+sl_cur,PAF(0),PAF(1),PAF(2),PAF(3)); }
  #undef PKW
  #undef PAF
  #undef VFR
  #undef PIN
  #undef MX3
  #undef GAPA
  #undef GAPB
  #undef EX
  #undef VRD
  #undef KRD
  #undef STEP
  #undef ENDW
  asm volatile("s_waitcnt lgkmcnt(0)\n\ts_barrier":::"memory");
  if(prime_next){DMA_K(0,0);DMA_V(0,0);DMA_K(1,SLOTB);}
  {auto rr=__builtin_amdgcn_permlane32_swap(__float_as_uint(l_reg),__float_as_uint(l_reg),false,false);l_reg=__uint_as_float(rr[0])+__uint_as_float(rr[1]);}
  if constexpr(MODE==1) l_reg+=__builtin_amdgcn_exp2f(sink_l2-mhat);
  if constexpr(MODE==2){ if(hi==0){ float*sp=stats+2*(long)(q0+wid*QBLK+r32); sp[0]=mhat; sp[1]=l_reg; } }
  if(hi==0)wsf[32+r32]=l_reg;asm volatile("s_waitcnt lgkmcnt(0)":::"memory");
  float rli[16];
  #pragma unroll
  for(int r=0;r<16;++r)rli[r]=__builtin_amdgcn_rcpf(wsf[32+crow(r,hi)]);
  bf16*Ow=Ob+(long)(q0+wid*QBLK)*op;
  { bf16*stg=(bf16*)(shm+LDS_OST)+wid*2048;
    #pragma unroll
    for(int r=0;r<16;++r){const int orow=crow(r,hi);
      #pragma unroll
      for(int d0=0;d0<2;++d0)stg[orow*64+d0*32+r32]=__float2bfloat16(o[d0][r]*rli[r]);}
    asm volatile("s_waitcnt lgkmcnt(0)":::"memory");
    #pragma unroll
    for(int i=0;i<4;++i){const int row=i*8+(lane>>3),ch=lane&7; const u32x4 v=*(const u32x4*)(stg+row*64+ch*8); ATTN_STORE16(Ow+(long)row*op+ch*8,v);} }
  asm volatile("s_waitcnt lgkmcnt(0)\n\ts_barrier":::"memory");
  #undef DMA_K
  #undef KVS
  #undef DMA_V
  #undef CMASK
  #undef START
  #undef RESC
  #undef ROT
}
constexpr int ATTN_LDS_BYTES=LDS_BYTES;
#undef SBAR
#undef WAIT_BAR
}
#include <hip/hip_cooperative_groups.h>
namespace cg = cooperative_groups;
#define LAS __attribute__((address_space(3)))
#define GAS __attribute__((address_space(1)))
typedef unsigned short bf16;
typedef unsigned v4u __attribute__((ext_vector_type(4)));
typedef unsigned v2u __attribute__((ext_vector_type(2)));
typedef float f32x4 __attribute__((ext_vector_type(4)));
typedef float f32x16 __attribute__((ext_vector_type(16)));
typedef short bf16x8 __attribute__((ext_vector_type(8)));
constexpr int NWAVES = 8, NTHR = 512;
constexpr int DMODEL = 1024, SEQ = 8192, MG = 2 * SEQ, NGRP = 3, DEPTH = 2, INC = 3088, NPROJ = 3072, DFF = 4096;
constexpr float EPS = 1e-6f;
constexpr float LOG2E = 1.4426950408889634f;
constexpr size_t MiB = 1u << 20;
constexpr size_t WS_ROPE = 1 * MiB;
constexpr size_t WS_WIN = 4 * MiB, WS_WOUT = 16 * MiB, WS_WUP = 20 * MiB, WS_WDN = 36 * MiB;
constexpr size_t WS_HN = 52 * MiB, WS_DNRAW = 84 * MiB, WS_Z = 108 * MiB, WS_DFQ = 116 * MiB, WS_DFK = 132 * MiB, WS_DFV = 148 * MiB;
constexpr size_t WS_SWQ = 164 * MiB, WS_SWKV = 172 * MiB, WS_BG = 180 * MiB, WS_GS = 181 * MiB;
constexpr size_t WS_QS = 182 * MiB, WS_KS = 198 * MiB, WS_KT = 214 * MiB, WS_U = 230 * MiB, WS_W = 246 * MiB;
constexpr size_t WS_ODN = 262 * MiB, WS_ODF = 294 * MiB, WS_MIX = 326 * MiB, WS_HID = 358 * MiB, WS_END = 486 * MiB;
constexpr size_t WS_WL = 3 * MiB;
constexpr size_t WS_SS2 = 497 * MiB;
constexpr size_t WS_SS = 496 * MiB;
constexpr size_t WS_PO = 486 * MiB, WS_PS = 494 * MiB;
constexpr int LDS_BYTES = 147456;
static_assert(WS_DNRAW == 84 * MiB && WS_Z == 108 * MiB && WS_DFQ == 116 * MiB && WS_DFK == 132 * MiB && WS_DFV == 148 * MiB && WS_SWQ == 164 * MiB && WS_SWKV == 172 * MiB, "EpiProj offsets");

__device__ __forceinline__ float bf2f(unsigned short b) { return __uint_as_float((unsigned)b << 16); }
__device__ __forceinline__ unsigned f2bf(float f) { unsigned u = __builtin_bit_cast(unsigned, f); return (u + 0x7fffu + ((u >> 16) & 1u)) >> 16; }
typedef float f32x2_ __attribute__((ext_vector_type(2))); typedef __bf16 bf16x2_ __attribute__((ext_vector_type(2)));
__device__ __forceinline__ unsigned pk2(float lo, float hi) { f32x2_ v = {lo, hi}; bf16x2_ b = __builtin_convertvector(v, bf16x2_); return __builtin_bit_cast(unsigned, b); }
__device__ __forceinline__ float shx(float v, int o, int lane) { return __int_as_float(__builtin_amdgcn_ds_bpermute((lane ^ o) << 2, __float_as_int(v))); }
__device__ __forceinline__ float wave_sum(float v, int lane) {
#pragma unroll
    for (int o = 1; o < 64; o <<= 1) v += shx(v, o, lane);
    return v;
}
#define MFMA32(a, b, c) __builtin_amdgcn_mfma_f32_32x32x16_bf16((a), (b), (c), 0, 0, 0)
__device__ __forceinline__ int crow(int r, int hi) { return (r & 3) + 8 * (r >> 2) + 4 * hi; }
__device__ __forceinline__ bf16x8 pack8(const f32x16& x, int s) {
    v4u p; p.x = pk2(x[8 * s], x[8 * s + 1]); p.y = pk2(x[8 * s + 2], x[8 * s + 3]); p.z = pk2(x[8 * s + 4], x[8 * s + 5]); p.w = pk2(x[8 * s + 6], x[8 * s + 7]);
    return __builtin_bit_cast(bf16x8, p);
}

#define XB_TMO      128
#define XB_XCNT(j)  (256  + 64 * (j))
#define XB_XSUB(j)  (1280 + 64 * (j))
#define XB_XGEN(j)  (2304 + 64 * (j))
#define XB_TOP      3328
#define XB_TOPGEN   3392
#define XCD_BAR_WORDS 3456
#define XB_SPIN_CAP (1u << 18)

__device__ __forceinline__ unsigned xb_ld(unsigned* p)              { return __hip_atomic_load(p, __ATOMIC_RELAXED, __HIP_MEMORY_SCOPE_AGENT); }
__device__ __forceinline__ unsigned xb_add(unsigned* p, unsigned v) { return __hip_atomic_fetch_add(p, v, __ATOMIC_RELAXED, __HIP_MEMORY_SCOPE_AGENT); }
__device__ __forceinline__ unsigned xb_xcc_id() { return (unsigned)__builtin_amdgcn_s_getreg((3 << 11) | 20) & 0xFu; }
#define XB_SPIN(cond, bar) do { unsigned _sp = 0; while (cond) { __builtin_amdgcn_s_sleep(1); \
    if ((++_sp & 255u) == 0u) { if (xb_ld(&(bar)[XB_TMO])) break; if (_sp > XB_SPIN_CAP) { atomicAdd(&(bar)[XB_TMO], 1u); break; } } } } while (0)

struct XcdBarrier {
    unsigned* bar; unsigned x;
    volatile LAS unsigned* st;
};

__device__ __forceinline__ XcdBarrier xcd_barrier_post(unsigned* bar, volatile LAS unsigned* st) {
    XcdBarrier b; b.bar = bar; b.x = xb_xcc_id(); b.st = st;
    if (threadIdx.x == 0) (void)xb_add(&bar[XB_XCNT(b.x)], 1u);
    return b;
}
__device__ __forceinline__ void xcd_barrier_complete(unsigned* bar, unsigned x, unsigned& nloc, unsigned& nx) {
    const unsigned G = gridDim.x * gridDim.y * gridDim.z;
    unsigned sum, cnt, mine, sp = 0u;
    for (;;) {
        sum = 0u; cnt = 0u; mine = 0u;
#pragma unroll
        for (unsigned j = 0; j < 16; ++j) { const unsigned c = xb_ld(&bar[XB_XCNT(j)]); sum += c; cnt += (c > 0u) ? 1u : 0u; mine = (j == x) ? c : mine; }
        if (sum == G) break;
        __builtin_amdgcn_s_sleep(1);
        if ((++sp & 255u) == 0u) { if (xb_ld(&bar[XB_TMO])) break; if (sp > XB_SPIN_CAP) { atomicAdd(&bar[XB_TMO], 1u); break; } }
    }
    nloc = mine > 0u ? mine : 1u; nx = cnt > 0u ? cnt : 1u;
}

__device__ __forceinline__ void xcd_barrier(const XcdBarrier& b) {
    asm volatile("s_waitcnt vmcnt(0)" ::: "memory");
    __syncthreads();
    if (threadIdx.x == 0) {
        unsigned* bar = b.bar;
        __builtin_amdgcn_s_waitcnt(0);
        unsigned nloc = b.st[0], nx = b.st[1];
        if (nloc == 0u) { xcd_barrier_complete(bar, b.x, nloc, nx); b.st[0] = nloc; b.st[1] = nx; }
        const unsigned old = xb_add(&bar[XB_XSUB(b.x)], 1u);
        const unsigned gen = old / nloc;
        if (old + 1u == (gen + 1u) * nloc) {
            __builtin_amdgcn_fence(__ATOMIC_RELEASE, "agent");
            asm volatile("s_waitcnt vmcnt(0)" ::: "memory");
            const unsigned og = xb_add(&bar[XB_TOP], 1u);
            const unsigned tg = og / nx;
            if (og + 1u == (tg + 1u) * nx) xb_add(&bar[XB_TOPGEN], 1u);
            else XB_SPIN(xb_ld(&bar[XB_TOPGEN]) == tg, bar);
            __builtin_amdgcn_fence(__ATOMIC_ACQUIRE, "agent");
            xb_add(&bar[XB_XGEN(b.x)], 1u);
            asm volatile("s_waitcnt vmcnt(0)" ::: "memory");
        } else {
            XB_SPIN(xb_ld(&bar[XB_XGEN(b.x)]) == gen, bar);
            __builtin_amdgcn_fence(__ATOMIC_ACQUIRE, "agent");
            asm volatile("s_waitcnt vmcnt(0)" ::: "memory");
        }
    }
    __syncthreads();
}

struct Ctx {
    LAS unsigned char* lds; unsigned char* ldsg;
    int tid, lane, wave, vcu, G, bx;
    unsigned char* ws;
};

__device__ __forceinline__ void transpose_item(const float* W, int K, int Nsrc, bf16* WT, int nblk, int item, int skip_from, int skip, LAS float* scr, int lane, const float* kscale = nullptr) {
    const int kb = item / nblk, nb = item % nblk, k0 = 64 * kb, n0 = 32 * nb, c0 = n0 + (n0 >= skip_from ? skip : 0);
    { const int kk0 = lane >> 3, c4 = (lane & 7) * 4;
      f32x4 v[8];
#pragma unroll
      for (int i = 0; i < 8; ++i) v[i] = *(const f32x4*)(W + (size_t)(k0 + kk0 + 8 * i) * Nsrc + c0 + c4);
#pragma unroll
      for (int i = 0; i < 8; ++i) { const int kk = kk0 + 8 * i; const float sc = kscale ? kscale[k0 + kk] : 1.f; LAS float* d = scr + kk * 33 + c4; d[0] = v[i].x * sc; d[1] = v[i].y * sc; d[2] = v[i].z * sc; d[3] = v[i].w * sc; } }
    asm volatile("s_waitcnt lgkmcnt(0)" ::: "memory");
    const int c = lane & 7;
#pragma unroll
    for (int j = 0; j < 4; ++j) { const int n = (lane >> 3) + 8 * j; const LAS float* s = scr + (8 * c) * 33 + n;
        v4u o; o.x = pk2(s[0 * 33], s[1 * 33]); o.y = pk2(s[2 * 33], s[3 * 33]); o.z = pk2(s[4 * 33], s[5 * 33]); o.w = pk2(s[6 * 33], s[7 * 33]);
        *(v4u*)(WT + (size_t)(n0 + n) * K + k0 + 8 * c) = o; }
    asm volatile("s_waitcnt lgkmcnt(0)" ::: "memory");
}

__device__ __forceinline__ void phase_prologue(Ctx& C, const float* w_in, const float* w_out, const float* w_up, const float* w_dn, const float* n2w, const float* n1w) {
    LAS float* scr = (LAS float*)(C.lds + C.wave * 16384);
    const int gw = C.vcu * NWAVES + C.wave, NGW = C.G * NWAVES;
    constexpr int I_IN = (DMODEL / 64) * (NPROJ / 32), I_OUT = (DMODEL / 64) * (DMODEL / 32), I_UP = (DMODEL / 64) * (DFF / 32), I_DN = (DFF / 64) * (DMODEL / 32);
    constexpr int PER = I_IN + I_OUT + I_UP + I_DN;
    for (int it = gw; it < DEPTH * PER; it += NGW) {
        const int l = it / PER; int r = it % PER;
        if (r < I_IN) { transpose_item(w_in + (size_t)l * DMODEL * INC, DMODEL, INC, (bf16*)(C.ws + WS_WIN) + (size_t)l * NPROJ * DMODEL, NPROJ / 32, r, 1024, 16, scr, C.lane, l ? n1w + DMODEL : nullptr); continue; } r -= I_IN;
        if (r < I_OUT) { transpose_item(w_out + (size_t)l * DMODEL * DMODEL, DMODEL, DMODEL, (bf16*)(C.ws + WS_WOUT) + (size_t)l * DMODEL * DMODEL, DMODEL / 32, r, 1 << 30, 0, scr, C.lane); continue; } r -= I_OUT;
        if (r < I_UP) { transpose_item(w_up + (size_t)l * DMODEL * DFF, DMODEL, DFF, (bf16*)(C.ws + WS_WUP) + (size_t)l * DFF * DMODEL, DFF / 32, r, 1 << 30, 0, scr, C.lane, n2w + l * DMODEL); continue; } r -= I_UP;
        transpose_item(w_dn + (size_t)l * DFF * DMODEL, DFF, DMODEL, (bf16*)(C.ws + WS_WDN) + (size_t)l * DMODEL * DFF, DMODEL / 32, r, 1 << 30, 0, scr, C.lane);
    }
    for (int e = C.vcu * NTHR + C.tid; e < DEPTH * 32 * DMODEL; e += C.G * NTHR) { const int k = e & (DMODEL - 1), o = (e >> 10) & 31, l = e >> 15;
        const float v = (o < 16) ? w_in[(size_t)l * DMODEL * INC + (size_t)k * INC + 1024 + o] * (l ? n1w[DMODEL + k] : 1.f) : 0.f;
        ((bf16*)(C.ws + WS_WL))[e] = (bf16)(pk2(v, 0.f) & 0xffffu); }
    float* cosT = (float*)(C.ws + WS_ROPE); float* sinT = cosT + SEQ * 32;
    for (int e = C.vcu * NTHR + C.tid; e < SEQ * 32; e += C.G * NTHR) {
        const int pos = e >> 5, i = e & 31;
        const double inv = exp(-(double)i * (9.210340371976184 / 32.0));
        double rev = (double)pos * inv * 0.15915494309189535;
        rev -= floor(rev);
        const float fr = (float)rev;
        cosT[e] = __builtin_amdgcn_cosf(fr); sinT[e] = __builtin_amdgcn_sinf(fr);
    }
}

template <bool LOGITS>
__device__ __forceinline__ void phase_norm(Ctx& C, const float* x, const float* nw, bf16* hn, const float* w_in_l, float* bg) {
    LAS float* wl = (LAS float*)C.lds;
    if (LOGITS) {
        for (int e = C.tid; e < DMODEL * 16; e += NTHR) { const int k = e >> 4, o = e & 15;
            wl[(((((k >> 8) * 4 + (k & 3)) * 4 + (o >> 2)) * 64 + ((k >> 2) & 63)) * 4) + (o & 3)] = w_in_l[(size_t)k * INC + 1024 + o]; }
        __syncthreads();
    }
    const int gw = C.vcu * NWAVES + C.wave, NGW = C.G * NWAVES;
    f32x4 wv[4];
#pragma unroll
    for (int j = 0; j < 4; ++j) wv[j] = ((const f32x4*)nw)[C.lane + 64 * j];
    f32x4 v[4];
    { const f32x4* xr = (const f32x4*)(x + (size_t)gw * DMODEL) + C.lane;
#pragma unroll
      for (int j = 0; j < 4; ++j) v[j] = xr[64 * j]; }
    for (int m = gw; m < MG; m += NGW) {
        f32x4 vn[4]; { const int mn = (m + NGW < MG) ? m + NGW : m; const f32x4* xr = (const f32x4*)(x + (size_t)mn * DMODEL) + C.lane;
#pragma unroll
          for (int j = 0; j < 4; ++j) vn[j] = xr[64 * j]; }
        float s = 0.f;
#pragma unroll
        for (int j = 0; j < 4; ++j) s += (v[j].x * v[j].x + v[j].y * v[j].y) + (v[j].z * v[j].z + v[j].w * v[j].w);
        const float rstd = 1.f / sqrtf(wave_sum(s, C.lane) * (1.f / DMODEL) + EPS);
        unsigned long long* o8 = (unsigned long long*)(hn + (size_t)m * DMODEL) + C.lane;
#pragma unroll
        for (int j = 0; j < 4; ++j) { v[j] = v[j] * rstd * wv[j]; o8[64 * j] = (unsigned long long)pk2(v[j].x, v[j].y) | ((unsigned long long)pk2(v[j].z, v[j].w) << 32); }
        if (LOGITS) {
            float acc[16];
#pragma unroll
            for (int o = 0; o < 16; ++o) acc[o] = 0.f;
#pragma unroll
            for (int j = 0; j < 4; ++j)
#pragma unroll
                for (int e = 0; e < 4; ++e) { const int k = 4 * C.lane + 256 * j + e; const float hv = v[j][e];
#pragma unroll
                    for (int o4 = 0; o4 < 4; ++o4) { const f32x4 w4 = *(const LAS f32x4*)(wl + ((((j * 4 + e) * 4 + o4) * 64 + C.lane) * 4)); acc[4 * o4] += hv * w4.x; acc[4 * o4 + 1] += hv * w4.y; acc[4 * o4 + 2] += hv * w4.z; acc[4 * o4 + 3] += hv * w4.w; } }
            float mine = 0.f;
#pragma unroll
            for (int o = 0; o < 16; ++o) { const float t = wave_sum(acc[o], C.lane); if (C.lane == o) mine = t; }
            if (C.lane < 16) bg[(size_t)m * 16 + C.lane] = mine;
        }
#pragma unroll
        for (int j = 0; j < 4; ++j) v[j] = vn[j];
    }
    if (LOGITS) __syncthreads();
}

__device__ __forceinline__ void phase_logits(Ctx& C, const bf16* A, const bf16* WL, const float* ss, float* bg) {
    const int r32 = C.lane & 31, hi = C.lane >> 5, tl = C.wave >> 2, kq = C.wave & 3, row0 = (tl * 256 + C.vcu) * 32;
    const GAS bf16* ap = (const GAS bf16*)A + (size_t)(row0 + r32) * DMODEL + kq * 256 + 8 * hi; const GAS bf16* bp = (const GAS bf16*)WL + (size_t)r32 * DMODEL + kq * 256 + 8 * hi;
    bf16x8 af[16], bf_[16];
#pragma unroll
    for (int j = 0; j < 16; ++j) { af[j] = *(const GAS bf16x8*)(ap + 16 * j); bf_[j] = *(const GAS bf16x8*)(bp + 16 * j); }
    f32x16 acc = f32x16{};
#pragma unroll
    for (int j = 0; j < 16; ++j) acc = MFMA32(af[j], bf_[j], acc);
    LAS f32x4* part = (LAS f32x4*)C.lds + (C.wave * 64 + C.lane) * 4;
#pragma unroll
    for (int q = 0; q < 4; ++q) part[q] = (f32x4){acc[4 * q], acc[4 * q + 1], acc[4 * q + 2], acc[4 * q + 3]};
    __syncthreads();
    if (kq == 0 && r32 < 16) {
#pragma unroll
        for (int q = 0; q < 4; ++q) { f32x4 t = part[q];
#pragma unroll
            for (int w = 1; w < 4; ++w) t += ((LAS f32x4*)C.lds + ((C.wave + w) * 64 + C.lane) * 4)[q];
#pragma unroll
            for (int e = 0; e < 4; ++e) { const int r = 4 * q + e, row = row0 + crow(r, hi); const float rs = ss ? pg8::row_rstd(ss, row) : 1.0f; bg[(size_t)row * 16 + r32] = t[e] * rs; } }
    }
    __syncthreads();
}

__device__ __forceinline__ void phase_final_norm(Ctx& C, float* x, const float* nw) {
    const int gw = C.vcu * NWAVES + C.wave, NGW = C.G * NWAVES;
    f32x4 wv[4];
#pragma unroll
    for (int j = 0; j < 4; ++j) wv[j] = ((const f32x4*)nw)[C.lane + 64 * j];
    for (int m = gw; m < MG; m += 2 * NGW) {
        f32x4* xa = (f32x4*)(x + (size_t)m * DMODEL) + C.lane; f32x4* xb = (f32x4*)(x + (size_t)(m + NGW) * DMODEL) + C.lane;
        f32x4 va[4], vb[4]; float sa = 0.f, sb = 0.f;
#pragma unroll
        for (int j = 0; j < 4; ++j) { va[j] = xa[64 * j]; vb[j] = xb[64 * j]; }
#pragma unroll
        for (int j = 0; j < 4; ++j) { sa += (va[j].x * va[j].x + va[j].y * va[j].y) + (va[j].z * va[j].z + va[j].w * va[j].w); sb += (vb[j].x * vb[j].x + vb[j].y * vb[j].y) + (vb[j].z * vb[j].z + vb[j].w * vb[j].w); }
        const float ra = 1.f / sqrtf(wave_sum(sa, C.lane) * (1.f / DMODEL) + EPS), rb = 1.f / sqrtf(wave_sum(sb, C.lane) * (1.f / DMODEL) + EPS);
#pragma unroll
        for (int j = 0; j < 4; ++j) { xa[64 * j] = va[j] * ra * wv[j]; xb[64 * j] = vb[j] * rb * wv[j]; }
    }
}

__device__ __forceinline__ void phase_rope(Ctx& C) {
    const float* cosT = (const float*)(C.ws + WS_ROPE); const float* sinT = cosT + SEQ * 32;
    const int total = MG * 22 * 4, T = C.G * NTHR;
    for (int it0 = C.vcu * NTHR + C.tid; it0 < total; it0 += 4 * T) {
        bf16* p[4]; float sc[4]; v4u a[4], b[4]; f32x4 c0[4], c1[4], s0[4], s1[4]; bool ok[4];
#pragma unroll
        for (int u = 0; u < 4; ++u) {
            const int it = it0 + u * T; ok[u] = it < total; const int itc = ok[u] ? it : it0;
            const int i8 = itc & 3, grp = (itc >> 2) % 22, row = (itc >> 2) / 22, pos = row & (SEQ - 1);
            sc[u] = 1.f;
            if (grp < 8) { p[u] = (bf16*)(C.ws + WS_DFQ) + (size_t)row * 512 + grp * 64; sc[u] = 0.125f * LOG2E; }
            else if (grp < 16) { p[u] = (bf16*)(C.ws + WS_DFK) + (size_t)row * 512 + (grp - 8) * 64; }
            else if (grp < 20) { p[u] = (bf16*)(C.ws + WS_SWQ) + (size_t)row * 256 + (grp - 16) * 64; sc[u] = 0.125f * LOG2E; }
            else { p[u] = (bf16*)(C.ws + WS_SWKV) + (size_t)row * 256 + (grp - 20) * 64; }
            p[u] += i8 * 8;
            a[u] = *(const v4u*)(p[u]); b[u] = *(const v4u*)(p[u] + 32);
            c0[u] = *(const f32x4*)(cosT + pos * 32 + i8 * 8); c1[u] = *(const f32x4*)(cosT + pos * 32 + i8 * 8 + 4);
            s0[u] = *(const f32x4*)(sinT + pos * 32 + i8 * 8); s1[u] = *(const f32x4*)(sinT + pos * 32 + i8 * 8 + 4);
        }
#pragma unroll
        for (int u = 0; u < 4; ++u) {
            v4u oa, ob;
#pragma unroll
            for (int w = 0; w < 4; ++w) {
                const float x1l = __uint_as_float(a[u][w] << 16), x1h = __uint_as_float(a[u][w] & 0xffff0000u), x2l = __uint_as_float(b[u][w] << 16), x2h = __uint_as_float(b[u][w] & 0xffff0000u);
                const float cl = (w < 2) ? c0[u][2 * w] : c1[u][2 * w - 4], ch = (w < 2) ? c0[u][2 * w + 1] : c1[u][2 * w - 3];
                const float sl = (w < 2) ? s0[u][2 * w] : s1[u][2 * w - 4], sh = (w < 2) ? s0[u][2 * w + 1] : s1[u][2 * w - 3];
                oa[w] = pk2((x1l * cl - x2l * sl) * sc[u], (x1h * ch - x2h * sh) * sc[u]);
                ob[w] = pk2((x2l * cl + x1l * sl) * sc[u], (x2h * ch + x1h * sh) * sc[u]);
            }
            if (ok[u]) { *(v4u*)(p[u]) = oa; *(v4u*)(p[u] + 32) = ob; }
        }
    }
}

__device__ __forceinline__ void rope_span(Ctx& C, int beg, int end, int t, int nthr) {
    const float* cosT = (const float*)(C.ws + WS_ROPE); const float* sinT = cosT + SEQ * 32;
    for (int it0 = beg + t; it0 < end; it0 += 2 * nthr) {
        bf16* p[2]; float sc[2]; v4u a[2], b[2]; f32x4 c0[2], c1[2], s0[2], s1[2]; bool ok[2];
#pragma unroll
        for (int u = 0; u < 2; ++u) {
            const int it = it0 + u * nthr; ok[u] = it < end; const int itc = ok[u] ? it : it0;
            const int i8 = itc & 3, grp = (itc >> 2) % 22, row = (itc >> 2) / 22, pos = row & (SEQ - 1);
            sc[u] = 1.f;
            if (grp < 8) { p[u] = (bf16*)(C.ws + WS_DFQ) + (size_t)row * 512 + grp * 64; sc[u] = 0.125f * LOG2E; }
            else if (grp < 16) { p[u] = (bf16*)(C.ws + WS_DFK) + (size_t)row * 512 + (grp - 8) * 64; }
            else if (grp < 20) { p[u] = (bf16*)(C.ws + WS_SWQ) + (size_t)row * 256 + (grp - 16) * 64; sc[u] = 0.125f * LOG2E; }
            else { p[u] = (bf16*)(C.ws + WS_SWKV) + (size_t)row * 256 + (grp - 20) * 64; }
            p[u] += i8 * 8;
            a[u] = *(const v4u*)(p[u]); b[u] = *(const v4u*)(p[u] + 32);
            c0[u] = *(const f32x4*)(cosT + pos * 32 + i8 * 8); c1[u] = *(const f32x4*)(cosT + pos * 32 + i8 * 8 + 4);
            s0[u] = *(const f32x4*)(sinT + pos * 32 + i8 * 8); s1[u] = *(const f32x4*)(sinT + pos * 32 + i8 * 8 + 4);
        }
#pragma unroll
        for (int u = 0; u < 2; ++u) {
            v4u oa, ob;
#pragma unroll
            for (int w = 0; w < 4; ++w) {
                const float x1l = __uint_as_float(a[u][w] << 16), x1h = __uint_as_float(a[u][w] & 0xffff0000u), x2l = __uint_as_float(b[u][w] << 16), x2h = __uint_as_float(b[u][w] & 0xffff0000u);
                const float cl = (w < 2) ? c0[u][2 * w] : c1[u][2 * w - 4], ch = (w < 2) ? c0[u][2 * w + 1] : c1[u][2 * w - 3];
                const float sl = (w < 2) ? s0[u][2 * w] : s1[u][2 * w - 4], sh = (w < 2) ? s0[u][2 * w + 1] : s1[u][2 * w - 3];
                oa[w] = pk2((x1l * cl - x2l * sl) * sc[u], (x1h * ch - x2h * sh) * sc[u]);
                ob[w] = pk2((x2l * cl + x1l * sl) * sc[u], (x2h * ch + x1h * sh) * sc[u]);
            }
            if (ok[u]) { *(v4u*)(p[u]) = oa; *(v4u*)(p[u] + 32) = ob; }
        }
    }
}

__device__ __forceinline__ void phase_dn_prep(Ctx& C, const float* convw, const float* a_log, const float* dt_bias) {
    constexpr int P = 65;
    LAS float* raw = (LAS float*)C.lds;
    LAS float* KK = raw; LAS float* QK = raw + 64 * P; LAS float* Ld = raw + 2 * 64 * P;
    LAS float* qkv = (LAS float*)(C.lds + 66048);
    LAS float* sm = (LAS float*)(C.lds + 66048 + 49920);
    LAS float* betaT = sm, *gT = sm + 128, *Gs = sm + 256, *bs = sm + 384;
    const bf16* dnraw = (const bf16*)(C.ws + WS_DNRAW); const float* bg = (const float*)(C.ws + WS_BG);
    for (int task = C.vcu; task < 2 * 4 * 128; task += C.G) {
        const int nc = task & 127, h = (task >> 7) & 3, seq = task >> 9, c0 = nc * 64;
        __syncthreads();
        int tid_ = C.tid; asm volatile("" : "+v"(tid_));
        const int tidl = tid_, lanel = tid_ & 63, wavel = __builtin_amdgcn_readfirstlane(tid_ >> 6);
        for (int idx = tidl; idx < 3 * 68 * 8; idx += NTHR) {
            const int c8 = idx & 7, rr = (idx >> 3) % 68, part = (idx >> 3) / 68, t = c0 - 2 + rr;
            v4u v = (v4u){0u, 0u, 0u, 0u};
            if (t >= 0 && t < SEQ) v = *(const v4u*)(dnraw + (size_t)(seq * SEQ + t) * 768 + part * 256 + h * 64 + c8 * 8);
            LAS float* d = raw + (part * 68 + rr) * 64 + c8 * 8;
#pragma unroll
            for (int w = 0; w < 4; ++w) { d[2 * w] = __uint_as_float(v[w] << 16); d[2 * w + 1] = __uint_as_float(v[w] & 0xffff0000u); }
        }
        if (tidl < 128) { const int dir = tidl >> 6, i = tidl & 63; const size_t row = (size_t)(seq * SEQ + c0 + i);
            const float bl = bg[row * 16 + dir * 4 + h], al = bg[row * 16 + 8 + dir * 4 + h] + dt_bias[dir * 4 + h];
            betaT[dir * 64 + i] = 1.f / (1.f + __expf(-bl));
            const float e_ = __expf(-fabsf(al)); const float sp = fmaxf(al, 0.f) + ((e_ < 0.01f) ? e_ * (1.f - e_ * (0.5f - e_ * 0.33333333f)) : __logf(1.f + e_));
            gT[dir * 64 + i] = -__expf(a_log[dir * 4 + h]) * sp; }
        __syncthreads();
        { const int c = tidl & 63, i0 = tidl >> 6;
#pragma unroll
          for (int part = 0; part < 3; ++part) { float cw[5];
#pragma unroll
            for (int j = 0; j < 5; ++j) cw[j] = convw[j * 768 + part * 256 + h * 64 + c];
#pragma unroll
            for (int k = 0; k < 8; ++k) { const int i = i0 + 8 * k; float sacc = 0.f;
#pragma unroll
                for (int j = 0; j < 5; ++j) sacc += raw[(part * 68 + i + j) * 64 + c] * cw[j];
                qkv[(part * 64 + i) * P + c] = sacc / (1.f + __expf(-sacc)); } } }
        if (wavel < 2) { const int dir = wavel, il = lanel, it = dir ? 63 - il : il; float a = gT[dir * 64 + it];
#pragma unroll
            for (int o = 1; o < 64; o <<= 1) { const float t = __int_as_float(__builtin_amdgcn_ds_bpermute(((il - o) & 63) << 2, __float_as_int(a))); if (il >= o) a += t; }
            Gs[dir * 64 + il] = a; bs[dir * 64 + il] = betaT[dir * 64 + it]; }
        __syncthreads();
        { LAS float* r = qkv + (tidl >> 2) * P + 16 * (tidl & 3); float v[16]; float sq = 0.f;
#pragma unroll
          for (int c = 0; c < 16; ++c) { v[c] = r[c]; sq += v[c] * v[c]; }
          sq += shx(sq, 1, lanel); sq += shx(sq, 2, lanel);
          const float sc = 1.f / sqrtf(sq + EPS);
#pragma unroll
          for (int c = 0; c < 16; ++c) r[c] = v[c] * sc; }
        __syncthreads();
        { const int r32 = lanel & 31, hi = lanel >> 5, mat = wavel >> 2, it = (wavel >> 1) & 1, mt = wavel & 1;
          const LAS float* ar = qkv + ((mat ? 0 : 64) + r32 + 32 * it) * P + 2 * hi; const LAS float* br = qkv + (64 + r32 + 32 * mt) * P + 2 * hi;
          f32x16 acc = f32x16{};
#pragma unroll
          for (int j = 0; j < 16; ++j) { const float a0 = ar[4 * j], a1 = ar[4 * j + 1], b0 = br[4 * j], b1 = br[4 * j + 1];
              acc = __builtin_amdgcn_mfma_f32_32x32x2f32(a0, b0, acc, 0, 0, 0); acc = __builtin_amdgcn_mfma_f32_32x32x2f32(a1, b1, acc, 0, 0, 0); }
          LAS float* dst = (mat ? QK : KK) + (32 * it) * P + r32 + 32 * mt;
#pragma unroll
          for (int r = 0; r < 16; ++r) dst[((r & 3) + 8 * (r >> 2) + 4 * hi) * P] = acc[r]; }
        __syncthreads();
        for (int idx = tidl; idx < 2 * 64 * 64; idx += NTHR) {
            const int ml = idx & 63, il = (idx >> 6) & 63, dir = idx >> 12;
            const int it = dir ? 63 - il : il, mt = dir ? 63 - ml : ml;
            float v = 0.f;
            if (il > ml) v = bs[dir * 64 + il] * KK[it * P + mt] * __expf(Gs[dir * 64 + il] - Gs[dir * 64 + ml]);
            Ld[idx] = v;
        }
        __syncthreads();
        const int blk0 = ((0 * 2 + seq) * 4 + h) * 128 + nc, blk1 = ((1 * 2 + seq) * 4 + h) * 128 + (127 - nc);
        if (wavel < 4) {
            const int dir = wavel >> 1, col = (wavel & 1) * 64 + lanel;
            unsigned lb = (unsigned)(uintptr_t)(Ld + dir * 4096);
            const LAS float* src = (col < 64) ? (qkv + (2 * 64) * P + col) : (qkv + 64 * P + (col - 64));
            float xs[64];
#pragma unroll
            for (int il = 0; il < 64; ++il) {
                const int it = dir ? 63 - il : il;
                float a = src[it * P] * bs[dir * 64 + il];
                if (col >= 64) a *= __expf(Gs[dir * 64 + il]);
#pragma unroll
                for (int m4 = 0; m4 < (il + 3) / 4; ++m4) { const f32x4 l4 = *(const LAS f32x4*)(uintptr_t)(lb + (il * 64 + 4 * m4) * 4);
                    if (4 * m4 < il) a -= l4.x * xs[4 * m4];
                    if (4 * m4 + 1 < il) a -= l4.y * xs[4 * m4 + 1];
                    if (4 * m4 + 2 < il) a -= l4.z * xs[4 * m4 + 2];
                    if (4 * m4 + 3 < il) a -= l4.w * xs[4 * m4 + 3]; }
                xs[il] = a; if (il & 1) asm volatile("" : "+v"(lb) : "v"(a));
            }
            const int blk = dir ? blk1 : blk0;
            if (col < 64) {
                bf16* U = (bf16*)(C.ws + WS_U) + (size_t)blk * 4096;
                const int et = col >> 5, r32 = col & 31;
#pragma unroll
                for (int mt = 0; mt < 2; ++mt)
#pragma unroll
                    for (int hi = 0; hi < 2; ++hi) { v4u o0, o1;
#pragma unroll
                        for (int q = 0; q < 4; ++q) { const int ra = 2 * q, rb = 2 * q + 1, rc = 8 + 2 * q, rd = 9 + 2 * q;
                            o0[q] = pk2(xs[32 * mt + (ra & 3) + 8 * (ra >> 2) + 4 * hi], xs[32 * mt + (rb & 3) + 8 * (rb >> 2) + 4 * hi]);
                            o1[q] = pk2(xs[32 * mt + (rc & 3) + 8 * (rc >> 2) + 4 * hi], xs[32 * mt + (rd & 3) + 8 * (rd >> 2) + 4 * hi]); }
                        bf16* dst = U + ((mt * 2 + et) * 64 + r32 + 32 * hi) * 16; *(v4u*)dst = o0; *(v4u*)(dst + 8) = o1; }
            } else {
                bf16* W = (bf16*)(C.ws + WS_W) + (size_t)blk * 4096; const int d = col - 64;
#pragma unroll
                for (int il = 0; il < 64; ++il) W[il * 64 + d] = (bf16)(pk2(xs[il], 0.f) & 0xffffu);
            }
        } else {
            const int t2 = tidl - 256;
            for (int idx = t2; idx < 2 * 64 * 8; idx += 256) {
                const int d8 = idx & 7, il = (idx >> 3) & 63, dir = idx >> 9;
                const int it = dir ? 63 - il : il; const LAS float* s = qkv + it * P + d8 * 8; const float f = 0.125f * __expf(Gs[dir * 64 + il]);
                v4u o; o.x = pk2(s[0] * f, s[1] * f); o.y = pk2(s[2] * f, s[3] * f); o.z = pk2(s[4] * f, s[5] * f); o.w = pk2(s[6] * f, s[7] * f);
                *(v4u*)((bf16*)(C.ws + WS_QS) + (size_t)(dir ? blk1 : blk0) * 4096 + il * 64 + d8 * 8) = o;
            }
            for (int idx = t2; idx < 2 * 64 * 8; idx += 256) {
                const int i8 = idx & 7, d = (idx >> 3) & 63, dir = idx >> 9; const float gl = Gs[dir * 64 + 63];
                float v[8];
#pragma unroll
                for (int j = 0; j < 8; ++j) { const int il = i8 * 8 + j, it = dir ? 63 - il : il; v[j] = qkv[(64 + it) * P + d] * __expf(gl - Gs[dir * 64 + il]); }
                v4u o; o.x = pk2(v[0], v[1]); o.y = pk2(v[2], v[3]); o.z = pk2(v[4], v[5]); o.w = pk2(v[6], v[7]);
                *(v4u*)((bf16*)(C.ws + WS_KT) + (size_t)(dir ? blk1 : blk0) * 4096 + d * 64 + i8 * 8) = o;
            }
            for (int idx = t2; idx < 2 * 3 * 64 * 2; idx += 256) {
                const int half = idx & 1, ln = (idx >> 1) & 63, tt = (idx >> 7) % 3, dir = (idx >> 7) / 3;
                const int mt = (tt == 2) ? 1 : 0, itl = (tt == 0) ? 0 : 1, r32 = ln & 31, hi = ln >> 5, il = r32 + 32 * itl, itok = dir ? 63 - il : il;
                const float gi = Gs[dir * 64 + il];
                float v[8];
#pragma unroll
                for (int j = 0; j < 8; ++j) { const int r = 8 * half + j, ml = (r & 3) + 8 * (r >> 2) + 4 * hi + 32 * mt, mtok = dir ? 63 - ml : ml;
                    v[j] = (il >= ml) ? 0.125f * QK[itok * P + mtok] * __expf(gi - Gs[dir * 64 + ml]) : 0.f; }
                v4u o; o.x = pk2(v[0], v[1]); o.y = pk2(v[2], v[3]); o.z = pk2(v[4], v[5]); o.w = pk2(v[6], v[7]);
                *(v4u*)((bf16*)(C.ws + WS_KS) + (size_t)(dir ? blk1 : blk0) * 4096 + ((mt * 2 + itl) * 64 + ln) * 16 + 8 * half) = o;
            }
            if (t2 < 2) ((float*)(C.ws + WS_GS))[t2 ? blk1 : blk0] = __expf(Gs[t2 * 64 + 63]);
            { constexpr int PER_TASK = (MG * 22 * 4) / 1024; const int tslot = (task - C.vcu) / C.G; const int beg = (C.vcu * 4 + tslot) * PER_TASK; rope_span(C, beg, beg + PER_TASK, t2, 256); }
        }
    }
    __syncthreads();
}

#define DN_BAR() asm volatile("s_waitcnt lgkmcnt(0)\n\ts_barrier" ::: "memory")
#define LDG(T, base, off) (*(const GAS T*)((const GAS char*)(base) + (off)))
__device__ __forceinline__ void dn_chain(Ctx& C, int ch) {
    constexpr int SP = 72, IMG = 64 * SP;
    LAS bf16* STb = (LAS bf16*)C.lds; LAS v4u* VN = (LAS v4u*)(C.lds + 3 * IMG * 2);
    const int lane = C.lane, r32 = lane & 31, hi = lane >> 5, w = C.wave, wl = w & 3;
    const int dir = ch >> 3, seq = (ch >> 2) & 1, h = ch & 3;
    const GAS bf16* QD = (const GAS bf16*)(C.ws + WS_QS) + (size_t)ch * 128 * 4096; const GAS bf16* AT = (const GAS bf16*)(C.ws + WS_KS) + (size_t)ch * 128 * 4096;
    const GAS bf16* KT = (const GAS bf16*)(C.ws + WS_KT) + (size_t)ch * 128 * 4096; const GAS bf16* UU = (const GAS bf16*)(C.ws + WS_U) + (size_t)ch * 128 * 4096;
    const GAS bf16* WW = (const GAS bf16*)(C.ws + WS_W) + (size_t)ch * 128 * 4096; const GAS float* GL = (const GAS float*)(C.ws + WS_GS) + (size_t)ch * 128;
    GAS float* ODN = (GAS float*)(C.ws + WS_ODN) + (size_t)dir * MG * 256;
    __syncthreads();
    for (int e = C.tid; e < 3 * IMG / 2; e += NTHR) ((LAS unsigned*)STb)[e] = 0u;
    __syncthreads();
    if (w < 4) {
        const int et = wl >> 1, dt = wl & 1;
        f32x16 ST = f32x16{};
        bf16x8 wA0[2][4], kB0[2][2], wA1[2][4], kB1[2][2]; v4u uu0[2][2], uu1[2][2]; float gam0, gam1;
        const unsigned off_w0 = (unsigned)((r32 * 64 + 8 * hi) * 2), off_u0 = (unsigned)((et * 64 + lane) * 32), off_kt = (unsigned)(((r32 + 32 * dt) * 64 + 4 * hi) * 2);
#define CH_LOAD(n_, wA, kB, uu, gam) do { const GAS bf16* Wb = WW + (size_t)(n_) * 4096; const GAS bf16* Ub = UU + (size_t)(n_) * 4096; const GAS bf16* KTb = KT + (size_t)(n_) * 4096; \
            _Pragma("unroll") for (int mt = 0; mt < 2; ++mt) { \
                _Pragma("unroll") for (int kk = 0; kk < 4; ++kk) wA[mt][kk] = LDG(bf16x8, Wb, off_w0 + (unsigned)(mt * 4096 + kk * 32)); \
                uu[mt][0] = LDG(v4u, Ub, off_u0 + (unsigned)(mt * 4096)); uu[mt][1] = LDG(v4u, Ub, off_u0 + (unsigned)(mt * 4096 + 16)); \
                _Pragma("unroll") for (int s = 0; s < 2; ++s) { const v2u lo = LDG(v2u, KTb, off_kt + (unsigned)((32 * mt + 16 * s) * 2)), hh = LDG(v2u, KTb, off_kt + (unsigned)((32 * mt + 16 * s + 8) * 2)); \
                    kB[mt][s] = __builtin_bit_cast(bf16x8, (v4u){lo.x, lo.y, hh.x, hh.y}); } } \
            gam = GL[n_]; } while (0)
#define CH_STEP(n_, wA, kB, uu, gam) do { \
            const int c3 = (n_) % 3, x3 = (c3 == 2) ? 0 : c3 + 1; \
            bf16x8 sB[4]; \
            _Pragma("unroll") for (int kk = 0; kk < 4; ++kk) sB[kk] = *(const LAS bf16x8*)(STb + c3 * IMG + (r32 + 32 * et) * SP + 16 * kk + 8 * hi); \
            f32x16 ws0 = f32x16{}, ws1 = f32x16{}; \
            _Pragma("unroll") for (int kk = 0; kk < 4; ++kk) { ws0 = MFMA32(wA[0][kk], sB[kk], ws0); ws1 = MFMA32(wA[1][kk], sB[kk], ws1); } \
            _Pragma("unroll") for (int r = 0; r < 16; ++r) { \
                const float u0 = (r & 1) ? __uint_as_float(uu[0][r >> 3][(r >> 1) & 3] & 0xffff0000u) : __uint_as_float(uu[0][r >> 3][(r >> 1) & 3] << 16); \
                const float u1 = (r & 1) ? __uint_as_float(uu[1][r >> 3][(r >> 1) & 3] & 0xffff0000u) : __uint_as_float(uu[1][r >> 3][(r >> 1) & 3] << 16); \
                ws0[r] = u0 - ws0[r]; ws1[r] = u1 - ws1[r]; ST[r] *= gam; } \
            const bf16x8 p00 = pack8(ws0, 0), p01 = pack8(ws0, 1), p10 = pack8(ws1, 0), p11 = pack8(ws1, 1); \
            { LAS v4u* vn = VN + ((((n_) & 1) * 2 + et) * 4) * 64 + lane; vn[0] = __builtin_bit_cast(v4u, p00); vn[64] = __builtin_bit_cast(v4u, p01); vn[128] = __builtin_bit_cast(v4u, p10); vn[192] = __builtin_bit_cast(v4u, p11); } \
            ST = MFMA32(p00, kB[0][0], ST); ST = MFMA32(p10, kB[1][0], ST); ST = MFMA32(p01, kB[0][1], ST); ST = MFMA32(p11, kB[1][1], ST); \
            LAS bf16* dst = STb + x3 * IMG + (32 * et) * SP + r32 + 32 * dt; \
            _Pragma("unroll") for (int r = 0; r < 16; ++r) dst[crow(r, hi) * SP] = (bf16)(pk2(ST[r], 0.f) & 0xffffu); \
            DN_BAR(); } while (0)
        CH_LOAD(0, wA0, kB0, uu0, gam0);
        for (int n = 0; n < 128; n += 2) {
            CH_LOAD(n + 1, wA1, kB1, uu1, gam1);
            CH_STEP(n, wA0, kB0, uu0, gam0);
            CH_LOAD((n + 2 < 128) ? n + 2 : 127, wA0, kB0, uu0, gam0);
            CH_STEP(n + 1, wA1, kB1, uu1, gam1);
        }
        DN_BAR();
#undef CH_LOAD
#undef CH_STEP
    } else {
        const int it = wl >> 1, et = wl & 1;
        bf16x8 qA0[4], qA1[4]; v4u at0[2][2], at1[2][2];
        const unsigned off_q = (unsigned)(((r32 + 32 * it) * 64 + 8 * hi) * 2), off_at0 = (unsigned)((it * 64 + lane) * 32);
#define OW_LOAD(n_, qA, at) do { const GAS bf16* Qb = QD + (size_t)(n_) * 4096; const GAS bf16* Ab = AT + (size_t)(n_) * 4096; \
            _Pragma("unroll") for (int kk = 0; kk < 4; ++kk) qA[kk] = LDG(bf16x8, Qb, off_q + (unsigned)(kk * 32)); \
            _Pragma("unroll") for (int mt = 0; mt < 2; ++mt) { if (mt <= it) { at[mt][0] = LDG(v4u, Ab, off_at0 + (unsigned)(mt * 4096)); at[mt][1] = LDG(v4u, Ab, off_at0 + (unsigned)(mt * 4096 + 16)); } } } while (0)
#define OW_STEP(n_, qA, at) do { \
            const int c3 = (n_) % 3; \
            bf16x8 sB[4]; \
            _Pragma("unroll") for (int kk = 0; kk < 4; ++kk) sB[kk] = *(const LAS bf16x8*)(STb + c3 * IMG + (r32 + 32 * et) * SP + 16 * kk + 8 * hi); \
            const LAS v4u* vn = VN + ((((n_) & 1) * 2 + et) * 4) * 64 + lane; \
            f32x16 o = f32x16{}; \
            _Pragma("unroll") for (int kk = 0; kk < 4; ++kk) o = MFMA32(qA[kk], sB[kk], o); \
            _Pragma("unroll") for (int mt = 0; mt < 2; ++mt) { if (mt <= it) { \
                _Pragma("unroll") for (int s = 0; s < 2; ++s) o = MFMA32(__builtin_bit_cast(bf16x8, at[mt][s]), __builtin_bit_cast(bf16x8, vn[(mt * 2 + s) * 64]), o); } } \
            _Pragma("unroll") for (int r = 0; r < 16; ++r) { const int sr = (n_) * 64 + 32 * it + crow(r, hi), t = dir ? (SEQ - 1 - sr) : sr; \
                ODN[(size_t)(seq * SEQ + t) * 256 + h * 64 + 32 * et + r32] = o[r]; } \
            DN_BAR(); } while (0)
        OW_LOAD(0, qA0, at0);
        DN_BAR();
        for (int n = 0; n < 128; n += 2) {
            OW_LOAD(n + 1, qA1, at1);
            OW_STEP(n, qA0, at0);
            OW_LOAD((n + 2 < 128) ? n + 2 : 127, qA0, at0);
            OW_STEP(n + 1, qA1, at1);
        }
#undef OW_LOAD
#undef OW_STEP
    }
    __syncthreads();
}
#undef LDG
__device__ __forceinline__ void phase_finalize(Ctx& C, int li, const float* dn_norm_w, const float* diff_lambda, const float* diff_norm_w) {
    const int gw = C.vcu * NWAVES + C.wave, NGW = C.G * NWAVES, lane = C.lane;
    const float lam_init = 0.8f - 0.6f * __expf(-0.3f * (float)li);
    const float d1 = wave_sum(diff_lambda[lane] * diff_lambda[64 + lane], lane), d2 = wave_sum(diff_lambda[128 + lane] * diff_lambda[192 + lane], lane);
    const float lam = __expf(d1) - __expf(d2) + lam_init;
    const f32x4 nwd = *(const f32x4*)(dn_norm_w + (4 * lane & 63));
    const f32x4 nf0 = *(const f32x4*)(diff_norm_w + (8 * lane & 127)), nf1 = *(const f32x4*)(diff_norm_w + (8 * lane & 127) + 4);
    const float* of = (const float*)(C.ws + WS_ODN); const float* ob = of + (size_t)MG * 256;
    const bf16* zb = (const bf16*)(C.ws + WS_Z); const bf16* odf = (const bf16*)(C.ws + WS_ODF); bf16* mix = (bf16*)(C.ws + WS_MIX);
    const int hh_ = lane >> 4, e0_ = 8 * (lane & 15);
    f32x4 na = *(const f32x4*)(of + (size_t)gw * 256 + 4 * lane), nb = *(const f32x4*)(ob + (size_t)gw * 256 + 4 * lane); v2u nz = *(const v2u*)(zb + (size_t)gw * 256 + 4 * lane);
    v4u nda = *(const v4u*)(odf + (size_t)gw * 1024 + hh_ * 256 + e0_), ndb = *(const v4u*)(odf + (size_t)gw * 1024 + hh_ * 256 + 128 + e0_);
    for (int m = gw; m < MG; m += NGW) {
        const f32x4 ca = na, cb = nb; const v2u cz = nz; const v4u cda = nda, cdb = ndb;
        { const int mn = (m + NGW < MG) ? m + NGW : m;
          na = *(const f32x4*)(of + (size_t)mn * 256 + 4 * lane); nb = *(const f32x4*)(ob + (size_t)mn * 256 + 4 * lane); nz = *(const v2u*)(zb + (size_t)mn * 256 + 4 * lane);
          nda = *(const v4u*)(odf + (size_t)mn * 1024 + hh_ * 256 + e0_); ndb = *(const v4u*)(odf + (size_t)mn * 1024 + hh_ * 256 + 128 + e0_); }
        {
            const f32x4 a = ca, b = cb;
            const f32x4 o = a + b; float s = (o.x * o.x + o.y * o.y) + (o.z * o.z + o.w * o.w);
            s += shx(s, 1, lane); s += shx(s, 2, lane); s += shx(s, 4, lane); s += shx(s, 8, lane);
            const float rstd = 1.f / sqrtf(s * (1.f / 64.f) + EPS);
            const v2u zz = cz;
            const float z0 = __uint_as_float(zz.x << 16), z1 = __uint_as_float(zz.x & 0xffff0000u), z2 = __uint_as_float(zz.y << 16), z3 = __uint_as_float(zz.y & 0xffff0000u);
            v2u w; w.x = pk2(o.x * rstd * nwd.x * (z0 / (1.f + __expf(-z0))), o.y * rstd * nwd.y * (z1 / (1.f + __expf(-z1))));
            w.y = pk2(o.z * rstd * nwd.z * (z2 / (1.f + __expf(-z2))), o.w * rstd * nwd.w * (z3 / (1.f + __expf(-z3))));
            *(v2u*)(mix + (size_t)m * 1024 + 4 * lane) = w;
        }
        {
            const int hh = lane >> 4, e0 = 8 * (lane & 15);
            v4u a = cda; const v4u b = cdb;
            if (hh == 0 && m < SEQ) {
                const int cc = e0 >> 6; const bf16* po = (const bf16*)(C.ws + WS_PO); const float* ps = (const float*)(C.ws + WS_PS);
                float mp[4], lp[4]; v4u pp[4]; float mm = -INFINITY;
#pragma unroll
                for (int p = 0; p < 4; ++p) { pp[p] = *(const v4u*)(po + ((size_t)(p * 2 + cc) * SEQ + m) * 64 + (e0 & 63)); mp[p] = ps[((size_t)(p * 2 + cc) * SEQ + m) * 2]; lp[p] = ps[((size_t)(p * 2 + cc) * SEQ + m) * 2 + 1]; mm = fmaxf(mm, mp[p]); }
                float wsum = 0.f;
#pragma unroll
                for (int p = 0; p < 4; ++p) { lp[p] *= __builtin_amdgcn_exp2f(mp[p] - mm); wsum += lp[p]; }
                const float inv = 1.f / wsum;
#pragma unroll
                for (int w = 0; w < 4; ++w) { float lo = 0.f, hi_ = 0.f;
#pragma unroll
                    for (int p = 0; p < 4; ++p) { lo += lp[p] * __uint_as_float(pp[p][w] << 16); hi_ += lp[p] * __uint_as_float(pp[p][w] & 0xffff0000u); }
                    a[w] = pk2(lo * inv, hi_ * inv); }
            }
            float o[8]; float s = 0.f;
#pragma unroll
            for (int w = 0; w < 4; ++w) { o[2 * w] = __uint_as_float(a[w] << 16) - lam * __uint_as_float(b[w] << 16); o[2 * w + 1] = __uint_as_float(a[w] & 0xffff0000u) - lam * __uint_as_float(b[w] & 0xffff0000u);
                s += o[2 * w] * o[2 * w] + o[2 * w + 1] * o[2 * w + 1]; }
            s += shx(s, 1, lane); s += shx(s, 2, lane); s += shx(s, 4, lane); s += shx(s, 8, lane);
            const float sc = (1.f - lam_init) / sqrtf(s * (1.f / 128.f) + EPS);
            v4u w; w.x = pk2(o[0] * sc * nf0.x, o[1] * sc * nf0.y); w.y = pk2(o[2] * sc * nf0.z, o[3] * sc * nf0.w); w.z = pk2(o[4] * sc * nf1.x, o[5] * sc * nf1.y); w.w = pk2(o[6] * sc * nf1.z, o[7] * sc * nf1.w);
            *(v4u*)(mix + (size_t)m * 1024 + 256 + 8 * lane) = w;
        }
    }
}

struct Args { const float* in[16]; float* out; unsigned char* ws; };
__device__ __forceinline__ const float* ldarg(int k) { const Args* p = (const Args*)__builtin_amdgcn_kernarg_segment_ptr(); asm volatile("" : "+s"(p)); return p->in[k]; }
__device__ __forceinline__ float* ldout() { const Args* p = (const Args*)__builtin_amdgcn_kernarg_segment_ptr(); asm volatile("" : "+s"(p)); return p->out; }
__device__ __forceinline__ unsigned char* ldws() { const Args* p = (const Args*)__builtin_amdgcn_kernarg_segment_ptr(); asm volatile("" : "+s"(p)); return p->ws; }
__device__ __forceinline__ void refresh(Ctx& C, unsigned char* ldsp) {
    int t = threadIdx.x; asm volatile("" : "+v"(t));
    int bx = blockIdx.x; asm volatile("" : "+s"(bx));
    int G = gridDim.x; asm volatile("" : "+s"(G));
    unsigned lo = (unsigned)(uintptr_t)ldsp; asm volatile("" : "+s"(lo));
    C.lds = (LAS unsigned char*)(uintptr_t)lo; C.ldsg = ldsp; C.tid = t; C.lane = t & 63; C.wave = __builtin_amdgcn_readfirstlane(t >> 6);
    C.G = G; C.vcu = (G % 8 == 0) ? (bx % 8) * (G / 8) + bx / 8 : bx; C.bx = bx;
    C.ws = ldws();
}
#define RF() refresh(C, lds)
#define GSYNC() do { RF(); XcdBarrier b_; b_.bar = (unsigned*)C.ws; b_.x = xb_xcc_id(); b_.st = (volatile LAS unsigned*)(C.lds + 131424); xcd_barrier(b_); } while (0)
__global__ void __launch_bounds__(NTHR, 2) hybrid_fwd(Args args) {
    extern __shared__ __attribute__((aligned(16))) unsigned char lds[];
    cg::grid_group grid = cg::this_grid();
    Ctx C; RF();
    if (C.tid < 2) ((volatile LAS unsigned*)(C.lds + 131424))[C.tid] = 0u;
    __syncthreads();
    if (C.tid == 0) (void)xb_add(&((unsigned*)C.ws)[XB_XCNT(xb_xcc_id())], 1u);
#define ARGP(k) (ldarg(k))
#define x_prompt ARGP(0)
#define x_sample ARGP(1)
#define norm1_w ARGP(2)
#define w_in ARGP(3)
#define conv_w ARGP(4)
#define a_log ARGP(5)
#define dt_bias ARGP(6)
#define dn_norm_w ARGP(7)
#define diff_lambda ARGP(8)
#define diff_norm_w ARGP(9)
#define swa_sink ARGP(10)
#define w_out ARGP(11)
#define norm2_w ARGP(12)
#define w_up ARGP(13)
#define w_dn ARGP(14)
#define final_w ARGP(15)
#define HN ((bf16*)(C.ws + WS_HN))
#define MIX ((bf16*)(C.ws + WS_MIX))
#define HID ((bf16*)(C.ws + WS_HID))
    phase_prologue(C, w_in, w_out, w_up, w_dn, norm2_w, norm1_w);
    RF();
    phase_norm<false>(C, x_prompt, norm1_w, HN, nullptr, nullptr);
    grid.sync();
    for (int g = 0; g < NGRP; ++g) {
#define xo (ldout() + (size_t)g * MG * DMODEL)
        for (int li = 0; li < DEPTH; ++li) {
#define xcur (li ? (const float*)xo : ((g < 2) ? x_prompt + (size_t)g * MG * DMODEL : x_sample))
            RF();
            if (li == 0 && g > 0) { phase_norm<false>(C, xcur, norm1_w, HN, nullptr, nullptr); GSYNC(); }
            RF();
            { pg8::Gemm gm{HN, (const bf16*)(C.ws + WS_WIN) + (size_t)li * NPROJ * DMODEL, MG, NPROJ, DMODEL}; pg8::StaticOrder S; S.init(MG, NPROJ, C.G, C.bx);
              phase_logits(C, HN, (const bf16*)(C.ws + WS_WL) + (size_t)li * 32 * DMODEL, li ? (const float*)(C.ws + WS_SS2) : nullptr, (float*)(C.ws + WS_BG));
              pg8::EpiProj E{C.ws, li ? (const float*)(C.ws + WS_SS2) : nullptr};
              pg8::gemm_phase<pg8::EpiProj, pg8::StaticOrder, true, true>(C.lds, gm, S, E); }
            GSYNC();
            RF();
            RF();
#ifndef NO_PREP
            phase_dn_prep(C, conv_w + (size_t)li * 5 * 768, a_log + li * 8, dt_bias + li * 8);
#endif
            GSYNC();
            RF();
            {
#ifndef NO_CHAIN
                if (C.vcu < 16) dn_chain(C, C.vcu);
#endif
                __syncthreads(); RF();
                using abf = attn_body::bf16;
                {
                    const int nun = (C.vcu < 16) ? 0 : 4;
                    for (int i = 0; i < nun; ++i) {
                        const int bh = C.vcu >> 3, s = C.vcu & 7, b = bh >> 4, vh = bh & 15, h = vh >> 2, j = (vh >> 1) & 1, c = vh & 1;
                        const abf* Qb = (const abf*)(C.ws + WS_DFQ) + (size_t)b * SEQ * 512 + h * 128 + j * 64;
                        const abf* Kb = (const abf*)(C.ws + WS_DFK) + (size_t)b * SEQ * 512 + h * 128 + j * 64;
                        const abf* Vb = (const abf*)(C.ws + WS_DFV) + (size_t)b * SEQ * 512 + h * 128 + c * 64;
                        abf* Ob = (abf*)(C.ws + WS_ODF) + (size_t)b * SEQ * 1024 + h * 256 + j * 128 + c * 64;
                        const int qb = (i == 0) ? s : (i == 1) ? 15 - s : (i == 2) ? 16 + s : 31 - s;
                        attn_body::attn_unit<8, 0>(Qb, 512, Kb, 512, Vb, 512, Ob, 1024, qb * 256, 0.f, (char*)C.ldsg, 0, nullptr, i > 0, i + 1 < nun); }
                    {
                        RF();
                        const int qu = (C.vcu < 16) ? 240 + C.vcu : C.vcu - 16, part = qu & 3, un = qu >> 2, v2 = un & 15, i2 = un >> 4, s = v2 & 7, c = v2 >> 3;
                        const int qb = (i2 == 0) ? s : (i2 == 1) ? 15 - s : (i2 == 2) ? 16 + s : 31 - s;
                        const abf* Qb = (const abf*)(C.ws + WS_DFQ); const abf* Kb = (const abf*)(C.ws + WS_DFK); const abf* Vb = (const abf*)(C.ws + WS_DFV) + c * 64;
                        abf* Ob = (abf*)(C.ws + WS_PO) + (size_t)(part * 2 + c) * SEQ * 64;
                        attn_body::attn_unit<8, 2>(Qb, 512, Kb, 512, Vb, 512, Ob, 64, qb * 256, 0.f, (char*)C.ldsg, part * (SEQ / 4), (float*)(C.ws + WS_PS) + (size_t)(part * 2 + c) * SEQ * 2);
                    }
                }
                RF();
                {
                    const int nsw = 1;
                    for (int i = 0; i < nsw; ++i) {
                        const int un = C.vcu;
                        const int b = un >> 7, h = (un >> 5) & 3, qb = un & 31;
                        const abf* Qb = (const abf*)(C.ws + WS_SWQ) + (size_t)b * SEQ * 256 + h * 64;
                        const abf* Kb = (const abf*)(C.ws + WS_SWKV) + (size_t)b * SEQ * 256 + (h >> 1) * 64;
                        const abf* Vb = (const abf*)(C.ws + WS_SWKV) + (size_t)b * SEQ * 256 + 128 + (h >> 1) * 64;
                        abf* Ob = (abf*)(C.ws + WS_MIX) + (size_t)b * SEQ * 1024 + 768 + h * 64;
                        attn_body::attn_unit<8, 1>(Qb, 256, Kb, 256, Vb, 256, Ob, 1024, qb * 256, swa_sink[li * 4 + h] * LOG2E, (char*)C.ldsg);
                    }
                }
            }
            GSYNC();
            RF();
            phase_finalize(C, li, dn_norm_w + li * 64, diff_lambda + li * 256, diff_norm_w + li * 128);
            GSYNC();
            RF();
            { pg8::Gemm gm{MIX, (const bf16*)(C.ws + WS_WOUT) + (size_t)li * DMODEL * DMODEL, MG, DMODEL, DMODEL}; pg8::StaticOrder S; S.init(MG, DMODEL, C.G, C.bx);
              pg8::EpiRes E{li ? nullptr : xcur, li ? (const bf16*)HN : nullptr, nullptr, HN, (float*)(C.ws + WS_SS)};
              pg8::gemm_phase<pg8::EpiRes, pg8::StaticOrder, true, true>(C.lds, gm, S, E); }
            GSYNC();
            RF();
            { pg8::Gemm gm{HN, (const bf16*)(C.ws + WS_WUP) + (size_t)li * DFF * DMODEL, MG, DFF, DMODEL}; pg8::StaticOrder S; S.init(MG, DFF, C.G, C.bx);
              pg8::EpiRelu2S E{HID, (const float*)(C.ws + WS_SS), DFF};
              pg8::gemm_phase<pg8::EpiRelu2S, pg8::StaticOrder, true, true>(C.lds, gm, S, E); }
            GSYNC();
            RF();
            { pg8::Gemm gm{HID, (const bf16*)(C.ws + WS_WDN) + (size_t)li * DMODEL * DFF, MG, DMODEL, DFF}; pg8::StaticOrder S; S.init(MG, DMODEL, C.G, C.bx);
              pg8::EpiRes E{nullptr, HN, li ? xo : nullptr, li ? nullptr : HN, li ? nullptr : (float*)(C.ws + WS_SS2)};
              pg8::gemm_phase<pg8::EpiRes, pg8::StaticOrder, true, true>(C.lds, gm, S, E); }
            GSYNC();
        }
        RF();
        phase_final_norm(C, xo, final_w);
    }
}

extern "C" void kernel_launch(void* const* d_in, const int* in_sizes, int n_in, void* d_out, int out_size, void* d_ws, size_t ws_size, hipStream_t stream) {
    static int grid = 0;
    if (grid == 0) {
        if (n_in != 16 || ws_size < 498 * MiB) { fprintf(stderr, "kernel_launch: unexpected inputs (n_in %d, ws %zu)\n", n_in, ws_size); grid = -1; return; }
        int dev = 0, cus = 0, per_cu = 0;
        hipGetDevice(&dev); hipDeviceGetAttribute(&cus, hipDeviceAttributeMultiprocessorCount, dev);
        if (hipFuncSetAttribute((const void*)hybrid_fwd, hipFuncAttributeMaxDynamicSharedMemorySize, LDS_BYTES) != hipSuccess) { fprintf(stderr, "kernel_launch: hipFuncSetAttribute failed\n"); grid = -1; return; }
        hipOccupancyMaxActiveBlocksPerMultiprocessor(&per_cu, (const void*)hybrid_fwd, NTHR, LDS_BYTES);
        (void)hipGetLastError();
        if (per_cu < 1) per_cu = 1;
        grid = cus;
        if (grid != 256) fprintf(stderr, "kernel_launch: %d CUs (built for 256)\n", grid);
    }
    if (grid < 0) return;
    if (hipMemsetAsync(d_ws, 0, 65536, stream) != hipSuccess) { fprintf(stderr, "kernel_launch: hipMemsetAsync failed\n"); return; }
    Args a{};
    for (int i = 0; i < 16; ++i) a.in[i] = (const float*)d_in[i];
    a.out = (float*)d_out; a.ws = (unsigned char*)d_ws;
    void* kargs[] = {&a};
    hipError_t e = hipLaunchCooperativeKernel((const void*)hybrid_fwd, dim3(grid), dim3(NTHR), kargs, LDS_BYTES, stream);
    if (e != hipSuccess) fprintf(stderr, "cooperative launch failed: %s (grid %d)\n", hipGetErrorString(e), grid);
}
```

```cpp
#include <hip/hip_runtime.h>
#include <cstdio>
#include <cstdint>
namespace pg8 {
#define PG8_LAS __attribute__((address_space(3)))
typedef unsigned short bf16_t;
typedef short bf16x8 __attribute__((ext_vector_type(8)));
typedef float f32x4 __attribute__((ext_vector_type(4)));
typedef unsigned u32x4 __attribute__((ext_vector_type(4)));
constexpr int BM = 256, BK = 64, HALF = 128, HTB = HALF * BK * 2  , STAGE_BYTES = 8 * HTB, NXCD = 8, WGM = 4;

__host__ __device__ __forceinline__ int lds_byte(int r, int c) { const int st = (r >> 4) * 2 + (c >> 5), rr = r & 15, cc = c & 31, ob = rr * 64 + cc * 2; return st * 1024 + (ob ^ (((ob >> 9) & 1) << 5)); }
__host__ __device__ __forceinline__ void stage_rc(int b, int& R, int& C) { const int st = b / 1024, sb = b % 1024, swz = sb ^ (((sb >> 9) & 1) << 5); R = (st >> 1) * 16 + swz / 64; C = (st & 1) * 32 + (swz % 64) / 2; }
__host__ __device__ __forceinline__ int perm32(int rho) { const int n = rho >> 4, i = rho & 15; return 8 * (i >> 2) + 4 * n + (i & 3); }

struct Unit { int pm, pn; };
struct Gemm { const bf16_t* A; const bf16_t* Bt; int M, N, K; };

struct StaticOrder {
    int nM, nN, nwg, G, c;
    __host__ __device__ void init(int M, int N, int G_, int c_) { nM = M / BM; nN = N / BM; nwg = nM * nN; G = G_; c = c_; }
    __host__ __device__ bool next(int i, Unit& u) const {
        const long L = (long)i * G + c; if (L >= nwg) return false;
        int wgid = (int)L; { const int q = nwg / NXCD, r = nwg % NXCD, xcd = wgid % NXCD, off = wgid / NXCD; wgid = (xcd < r ? xcd * (q + 1) : r * (q + 1) + (xcd - r) * q) + off; }
        const int nig = WGM * nN, gid = wgid / nig, fm = gid * WGM, gsz = (nM - fm) < WGM ? (nM - fm) : WGM;
        u.pm = fm + ((wgid % nig) % gsz); u.pn = (wgid % nig) / gsz; return true;
    }
    __device__ __forceinline__ void a_ready(const Unit&) const {}
    __device__ __forceinline__ void done(const Unit&) const {}
};

__device__ __forceinline__ unsigned cvt_pk_bf16(float lo, float hi) { unsigned r; asm volatile("v_cvt_pk_bf16_f32 %0, %1, %2" : "=v"(r) : "v"(lo), "v"(hi)); return r; }

__device__ __forceinline__ float row_rstd(const float* ss, int row) {
    const f32x4* p = (const f32x4*)(ss + (size_t)row * 16); const f32x4 a = p[0], b = p[1], c = p[2], d = p[3];
    const float t = (((a[0] + a[1]) + (a[2] + a[3])) + ((b[0] + b[1]) + (b[2] + b[3]))) + (((c[0] + c[1]) + (c[2] + c[3])) + ((d[0] + d[1]) + (d[2] + d[3])));
    return 1.0f / sqrtf(t * (1.0f / 1024.0f) + 1e-6f);
}
struct EpiProj {
    static constexpr bool PERM = true, AFTER_DRAIN = false;
    unsigned char* ws;
    const float* ss;
    __device__ __forceinline__ void operator()(const f32x4 (&acc)[2][2][4][2], const Unit& u, int wr, int wc, int fr, int fq) const {
        const int row0 = u.pm * BM + wr * 64 + fr; const int pn = u.pn;
        size_t boff; int ldc, colt;
        if (pn < 3) { boff = (size_t)84 << 20; ldc = 768; colt = pn * 256; }
        else if (pn == 3) { boff = (size_t)108 << 20; ldc = 256; colt = 0; }
        else if (pn < 6) { boff = (size_t)116 << 20; ldc = 512; colt = (pn - 4) * 256; }
        else if (pn < 8) { boff = (size_t)132 << 20; ldc = 512; colt = (pn - 6) * 256; }
        else if (pn < 10) { boff = (size_t)148 << 20; ldc = 512; colt = (pn - 8) * 256; }
        else if (pn == 10) { boff = (size_t)164 << 20; ldc = 256; colt = 0; }
        else { boff = (size_t)172 << 20; ldc = 256; colt = 0; }
        bf16_t* base = (bf16_t*)(ws + boff);
        const int col0 = colt + wc * 32 + 8 * fq;
#pragma unroll
        for (int ai = 0; ai < 2; ++ai)
#pragma unroll
            for (int m = 0; m < 4; ++m) { const int row = row0 + ai * HALF + m * 16; bf16_t* rowp = base + (size_t)row * ldc + col0;
                const float rs = ss ? row_rstd(ss, row) : 1.0f;
#pragma unroll
                for (int bj = 0; bj < 2; ++bj) { const f32x4 v0 = acc[ai][bj][m][0] * rs, v1 = acc[ai][bj][m][1] * rs;
                    u32x4 w; w.x = cvt_pk_bf16(v0[0], v0[1]); w.y = cvt_pk_bf16(v0[2], v0[3]); w.z = cvt_pk_bf16(v1[0], v1[1]); w.w = cvt_pk_bf16(v1[2], v1[3]);
                    *(u32x4*)(rowp + bj * HALF) = w; } }
    }
};
struct EpiRelu2 {
    static constexpr bool PERM = true, AFTER_DRAIN = false;
    bf16_t* O; int ldc;
    __device__ __forceinline__ void operator()(const f32x4 (&acc)[2][2][4][2], const Unit& u, int wr, int wc, int fr, int fq) const {
        const int row0 = u.pm * BM + wr * 64 + fr; const int col0 = u.pn * BM + wc * 32 + 8 * fq;
#pragma unroll
        for (int ai = 0; ai < 2; ++ai)
#pragma unroll
            for (int m = 0; m < 4; ++m) { bf16_t* rowp = O + (size_t)(row0 + ai * HALF + m * 16) * ldc + col0;
#pragma unroll
                for (int bj = 0; bj < 2; ++bj) { f32x4 v0 = acc[ai][bj][m][0], v1 = acc[ai][bj][m][1];
#pragma unroll
                    for (int e = 0; e < 4; ++e) { const float a = fmaxf(v0[e], 0.f), b = fmaxf(v1[e], 0.f); v0[e] = a * a; v1[e] = b * b; }
                    u32x4 w; w.x = cvt_pk_bf16(v0[0], v0[1]); w.y = cvt_pk_bf16(v0[2], v0[3]); w.z = cvt_pk_bf16(v1[0], v1[1]); w.w = cvt_pk_bf16(v1[2], v1[3]);
                    *(u32x4*)(rowp + bj * HALF) = w; } }
    }
};
struct EpiResid {
    static constexpr bool PERM = false, AFTER_DRAIN = false;
    const float* base; float* out; int ldc;
    __device__ __forceinline__ void operator()(const f32x4 (&acc)[2][2][4][2], const Unit& u, int wr, int wc, int fr, int fq) const {
        const int col0 = u.pn * BM + wc * 32 + 4 * fq;
#pragma unroll
        for (int ai = 0; ai < 2; ++ai)
#pragma unroll
            for (int m = 0; m < 4; ++m) { const size_t off = (size_t)(u.pm * BM + ai * HALF + wr * 64 + m * 16 + fr) * ldc + col0;
#pragma unroll
                for (int bj = 0; bj < 2; ++bj)
#pragma unroll
                    for (int n = 0; n < 2; ++n) { const f32x4 bs = *(const f32x4*)(base + off + bj * HALF + n * 16); *(f32x4*)(out + off + bj * HALF + n * 16) = bs + acc[ai][bj][m][n]; }  asm volatile("" ::: "memory"); }
    }
};

struct EpiResidN {
    static constexpr bool PERM = false, AFTER_DRAIN = false;
    const float* base; float* out; bf16_t* xb; float* ss; int ldc;
    __device__ __forceinline__ void operator()(const f32x4 (&acc)[2][2][4][2], const Unit& u, int wr, int wc, int fr, int fq) const {
        typedef unsigned u32x2 __attribute__((ext_vector_type(2)));
        const int col0 = u.pn * BM + wc * 32 + 4 * fq, lane = fr + 16 * fq;
#pragma unroll
        for (int ai = 0; ai < 2; ++ai)
#pragma unroll
            for (int m = 0; m < 4; ++m) { const int row = u.pm * BM + ai * HALF + wr * 64 + m * 16 + fr; const size_t off = (size_t)row * ldc + col0; float sq = 0.f;
#pragma unroll
                for (int bj = 0; bj < 2; ++bj)
#pragma unroll
                    for (int n = 0; n < 2; ++n) { const f32x4 bs = *(const f32x4*)(base + off + bj * HALF + n * 16); const f32x4 o = bs + acc[ai][bj][m][n];
                        *(f32x4*)(out + off + bj * HALF + n * 16) = o; sq += (o[0] * o[0] + o[1] * o[1]) + (o[2] * o[2] + o[3] * o[3]);
                        u32x2 w; w.x = cvt_pk_bf16(o[0], o[1]); w.y = cvt_pk_bf16(o[2], o[3]); *(u32x2*)(xb + off + bj * HALF + n * 16) = w; }
                sq += __int_as_float(__builtin_amdgcn_ds_bpermute((lane ^ 16) << 2, __float_as_int(sq))); sq += __int_as_float(__builtin_amdgcn_ds_bpermute((lane ^ 32) << 2, __float_as_int(sq)));
                if (fq == 0) ss[(size_t)row * 16 + u.pn * 4 + wc] = sq;
                asm volatile("" ::: "memory"); }
    }
};
struct EpiRes {
    static constexpr bool PERM = false, AFTER_DRAIN = false;
    const float* basef; const bf16_t* baseb; float* out; bf16_t* xb; float* ss;
    __device__ __forceinline__ void operator()(const f32x4 (&acc)[2][2][4][2], const Unit& u, int wr, int wc, int fr, int fq) const {
        typedef unsigned u32x2 __attribute__((ext_vector_type(2)));
        constexpr int ldc = 1024; const int col0 = u.pn * BM + wc * 32 + 4 * fq, lane = fr + 16 * fq;
#pragma unroll
        for (int ai = 0; ai < 2; ++ai)
#pragma unroll
            for (int m = 0; m < 4; ++m) { const int row = u.pm * BM + ai * HALF + wr * 64 + m * 16 + fr; const size_t off = (size_t)row * ldc + col0; float sq = 0.f;
#pragma unroll
                for (int bj = 0; bj < 2; ++bj)
#pragma unroll
                    for (int n = 0; n < 2; ++n) { const size_t o2 = off + bj * HALF + n * 16; f32x4 bs;
                        if (baseb) { const u32x2 b2 = *(const u32x2*)(baseb + o2); bs = (f32x4){__uint_as_float(b2.x << 16), __uint_as_float(b2.x & 0xffff0000u), __uint_as_float(b2.y << 16), __uint_as_float(b2.y & 0xffff0000u)}; }
                        else bs = *(const f32x4*)(basef + o2);
                        const f32x4 o = bs + acc[ai][bj][m][n];
                        if (out) *(f32x4*)(out + o2) = o;
                        if (xb) { sq += (o[0] * o[0] + o[1] * o[1]) + (o[2] * o[2] + o[3] * o[3]); u32x2 w; w.x = cvt_pk_bf16(o[0], o[1]); w.y = cvt_pk_bf16(o[2], o[3]); *(u32x2*)(xb + o2) = w; } }
                if (xb) { sq += __int_as_float(__builtin_amdgcn_ds_bpermute((lane ^ 16) << 2, __float_as_int(sq))); sq += __int_as_float(__builtin_amdgcn_ds_bpermute((lane ^ 32) << 2, __float_as_int(sq)));
                    if (fq == 0) ss[(size_t)row * 16 + u.pn * 4 + wc] = sq; }
                asm volatile("" ::: "memory"); }
    }
};
struct EpiRelu2S {
    static constexpr bool PERM = true, AFTER_DRAIN = false;
    bf16_t* O; const float* ss; int ldc;
    __device__ __forceinline__ void operator()(const f32x4 (&acc)[2][2][4][2], const Unit& u, int wr, int wc, int fr, int fq) const {
        const int row0 = u.pm * BM + wr * 64 + fr; const int col0 = u.pn * BM + wc * 32 + 8 * fq;
#pragma unroll
        for (int ai = 0; ai < 2; ++ai)
#pragma unroll
            for (int m = 0; m < 4; ++m) { const int row = row0 + ai * HALF + m * 16; bf16_t* rowp = O + (size_t)row * ldc + col0;
                const float rs = row_rstd(ss, row);
#pragma unroll
                for (int bj = 0; bj < 2; ++bj) { f32x4 v0 = acc[ai][bj][m][0], v1 = acc[ai][bj][m][1];
#pragma unroll
                    for (int e = 0; e < 4; ++e) { const float a = fmaxf(v0[e] * rs, 0.f), b = fmaxf(v1[e] * rs, 0.f); v0[e] = a * a; v1[e] = b * b; }
                    u32x4 w; w.x = cvt_pk_bf16(v0[0], v0[1]); w.y = cvt_pk_bf16(v0[2], v0[3]); w.z = cvt_pk_bf16(v1[0], v1[1]); w.w = cvt_pk_bf16(v1[2], v1[3]);
                    *(u32x4*)(rowp + bj * HALF) = w; } }
    }
};

template <class Epi, class Sched, bool ALIGN_EPI = false, bool SP2 = false>
__device__ __forceinline__ void gemm_phase(PG8_LAS unsigned char* lds, const Gemm g, const Sched& S, const Epi& E) {
    int tid_l = threadIdx.x; asm volatile("" : "+v"(tid_l));
    const int tid = tid_l, wid = __builtin_amdgcn_readfirstlane(tid >> 6), lane = tid & 63, wr = wid >> 2, wc = wid & 3, fr = lane & 15, fq = lane >> 4;
    const int K = g.K, nt = K / BK;
    unsigned voffA[2], voffB[2];
#pragma unroll
    for (int i = 0; i < 2; ++i) { int R, C; stage_rc(tid * 16 + i * 8192, R, C); const int Rb = Epi::PERM ? ((R & ~31) + perm32(R & 31)) : R;
        voffA[i] = (unsigned)(R * K + C) * 2u; voffB[i] = (unsigned)(Rb * K + C) * 2u; }
    const size_t kstep = (size_t)(BK * 2);
    const size_t hstep = (size_t)HALF * K * 2;
    const size_t tstep = 2 * hstep;
    const unsigned ldsw = (unsigned)wid * 1024u;
    const int aoff = lds_byte(wr * 64 + fr, fq * 8), boff = lds_byte(wc * 32 + fr, fq * 8);
#define PG8_SA(b, h) (((b) * 2 + (h)) * HTB)
#define PG8_SB(b, h) ((4 + (b) * 2 + (h)) * HTB)
#define PG8_STAGE(bufoff, gbase, voff) do { _Pragma("unroll") for (int _i = 0; _i < 2; ++_i) \
        __builtin_amdgcn_global_load_lds((const unsigned*)((const char*)(gbase) + (voff)[_i]), (PG8_LAS unsigned*)(lds + (bufoff) + ldsw + _i * 8192), 16, 0, 0); } while (0)
#define PG8_LDA(dst, b, h) do { _Pragma("unroll") for (int m = 0; m < 4; ++m) _Pragma("unroll") for (int k = 0; k < 2; ++k) dst[m][k] = *(const PG8_LAS bf16x8*)(lds + PG8_SA(b, h) + aoff + m * 2048 + k * 1024); } while (0)
#define PG8_LDB(dst, b, h) do { _Pragma("unroll") for (int n = 0; n < 2; ++n) _Pragma("unroll") for (int k = 0; k < 2; ++k) dst[n][k] = *(const PG8_LAS bf16x8*)(lds + PG8_SB(b, h) + boff + n * 2048 + k * 1024); } while (0)
#define PG8_MMA(ai, bj, At, Bt) do { __builtin_amdgcn_s_setprio(1); _Pragma("unroll") for (int m = 0; m < 4; ++m) _Pragma("unroll") for (int n = 0; n < 2; ++n) _Pragma("unroll") for (int k = 0; k < 2; ++k) \
        acc[ai][bj][m][n] = __builtin_amdgcn_mfma_f32_16x16x32_bf16(Bt[n][k], At[m][k], acc[ai][bj][m][n], 0, 0, 0); __builtin_amdgcn_s_setprio(0); } while (0)
#define PG8_WAIT_V(n) asm volatile("s_waitcnt vmcnt(" #n ")" ::: "memory")
#define PG8_WAIT_L(n) asm volatile("s_waitcnt lgkmcnt(" #n ")" ::: "memory")
#define PG8_BAR __builtin_amdgcn_s_barrier()
#define PG8_SCHED __builtin_amdgcn_sched_barrier(0)
    Unit cur, nxt; int ui = 0;
    if (!S.next(0, cur)) return;
    f32x4 acc[2][2][4][2];
#pragma unroll
    for (int a = 0; a < 2; ++a)
#pragma unroll
        for (int b = 0; b < 2; ++b)
#pragma unroll
            for (int m = 0; m < 4; ++m)
#pragma unroll
                for (int n = 0; n < 2; ++n) acc[a][b][m][n] = (f32x4){0.f, 0.f, 0.f, 0.f};
    bf16x8 At[4][2], B0[2][2], B1[2][2];
    const char* cA = (const char*)g.A + (size_t)cur.pm * tstep; const char* cB = (const char*)g.Bt + (size_t)cur.pn * tstep;
    S.a_ready(cur);
    if constexpr (SP2) {
        PG8_STAGE(PG8_SB(0, 0), cB, voffB); PG8_STAGE(PG8_SB(0, 1), cB + hstep, voffB); PG8_STAGE(PG8_SA(0, 0), cA, voffA); PG8_STAGE(PG8_SA(0, 1), cA + hstep, voffA);
        if (wr == 1) PG8_BAR;
        PG8_WAIT_V(2); PG8_BAR;
        PG8_STAGE(PG8_SB(1, 0), cB + kstep, voffB); PG8_STAGE(PG8_SA(1, 0), cA + kstep, voffA); PG8_STAGE(PG8_SB(1, 1), cB + hstep + kstep, voffB);
        PG8_WAIT_V(6); PG8_BAR;
    } else {
        PG8_STAGE(PG8_SB(0, 0), cB, voffB); PG8_STAGE(PG8_SA(0, 0), cA, voffA); PG8_STAGE(PG8_SB(0, 1), cB + hstep, voffB); PG8_STAGE(PG8_SA(0, 1), cA + hstep, voffA);
        if (wr == 1) PG8_BAR;
        PG8_WAIT_V(4); PG8_BAR;
        PG8_STAGE(PG8_SB(1, 0), cB + kstep, voffB); PG8_STAGE(PG8_SA(1, 0), cA + kstep, voffA); PG8_STAGE(PG8_SB(1, 1), cB + hstep + kstep, voffB);
        PG8_WAIT_V(6); PG8_BAR;
    }
    for (;;) {
        const bool has_next = S.next(ui + 1, nxt);
        const char* nA = has_next ? (const char*)g.A + (size_t)nxt.pm * tstep : cA; const char* nB = has_next ? (const char*)g.Bt + (size_t)nxt.pn * tstep : cB;
        for (int t = 0; t < nt; t += 2) {
            const bool last = (t == nt - 2);
            const char* a1 = cA + (size_t)(t + 1) * kstep;
            const char* a2 = last ? nA : cA + (size_t)(t + 2) * kstep; const char* b2 = last ? nB : cB + (size_t)(t + 2) * kstep;
            const char* a3 = a2 + kstep; const char* b3 = b2 + kstep;
            if (last && has_next) S.a_ready(nxt);
            if constexpr (SP2) {
            PG8_LDB(B0, 0, 0); PG8_LDB(B1, 0, 1); PG8_SCHED; PG8_LDA(At, 0, 0); PG8_STAGE(PG8_SA(1, 1), a1 + hstep, voffA);
            PG8_WAIT_V(8); PG8_WAIT_L(0); PG8_BAR; PG8_MMA(0, 0, At, B0); PG8_MMA(0, 1, At, B1); PG8_BAR; PG8_SCHED;
            PG8_LDA(At, 0, 1); PG8_STAGE(PG8_SB(0, 0), b2, voffB); PG8_STAGE(PG8_SB(0, 1), b2 + hstep, voffB); PG8_STAGE(PG8_SA(0, 0), a2, voffA);
            PG8_WAIT_V(8); PG8_WAIT_L(0); PG8_BAR; PG8_MMA(1, 0, At, B0); PG8_MMA(1, 1, At, B1); PG8_BAR; PG8_SCHED;
            PG8_LDB(B0, 1, 0); PG8_LDB(B1, 1, 1); PG8_SCHED; PG8_LDA(At, 1, 0); PG8_STAGE(PG8_SA(0, 1), a2 + hstep, voffA);
            PG8_WAIT_V(8); PG8_WAIT_L(0); PG8_BAR; PG8_MMA(0, 0, At, B0); PG8_MMA(0, 1, At, B1); PG8_BAR; PG8_SCHED;
            PG8_LDA(At, 1, 1); PG8_STAGE(PG8_SB(1, 0), b3, voffB); PG8_STAGE(PG8_SB(1, 1), b3 + hstep, voffB); PG8_STAGE(PG8_SA(1, 0), a3, voffA);
            PG8_WAIT_V(8); PG8_WAIT_L(0); PG8_BAR; PG8_MMA(1, 0, At, B0); PG8_MMA(1, 1, At, B1); PG8_BAR; PG8_SCHED;
            } else {
            PG8_LDB(B0, 0, 0); PG8_SCHED; PG8_LDA(At, 0, 0); PG8_STAGE(PG8_SA(1, 1), a1 + hstep, voffA);
            PG8_WAIT_L(8); PG8_BAR; PG8_WAIT_L(0); PG8_MMA(0, 0, At, B0); PG8_BAR; PG8_SCHED;
            PG8_LDB(B1, 0, 1); PG8_STAGE(PG8_SB(0, 0), b2, voffB);
            PG8_BAR; PG8_WAIT_L(0); PG8_MMA(0, 1, At, B1); PG8_BAR;
            PG8_LDA(At, 0, 1); PG8_STAGE(PG8_SA(0, 0), a2, voffA);
            PG8_BAR; PG8_WAIT_L(0); PG8_MMA(1, 0, At, B0); PG8_BAR; PG8_SCHED;
            PG8_STAGE(PG8_SB(0, 1), b2 + hstep, voffB);
            PG8_WAIT_V(6); PG8_BAR; PG8_MMA(1, 1, At, B1); PG8_BAR;
            PG8_LDB(B0, 1, 0); PG8_SCHED; PG8_LDA(At, 1, 0); PG8_STAGE(PG8_SA(0, 1), a2 + hstep, voffA);
            PG8_WAIT_L(8); PG8_BAR; PG8_WAIT_L(0); PG8_MMA(0, 0, At, B0); PG8_BAR; PG8_SCHED;
            PG8_LDB(B1, 1, 1); PG8_STAGE(PG8_SB(1, 0), b3, voffB);
            PG8_BAR; PG8_WAIT_L(0); PG8_MMA(0, 1, At, B1); PG8_BAR;
            PG8_LDA(At, 1, 1); PG8_STAGE(PG8_SA(1, 0), a3, voffA);
            PG8_BAR; PG8_WAIT_L(0); PG8_MMA(1, 0, At, B0); PG8_BAR; PG8_SCHED;
            PG8_STAGE(PG8_SB(1, 1), b3 + hstep, voffB);
            PG8_WAIT_V(6); PG8_BAR; PG8_MMA(1, 1, At, B1); PG8_BAR;
            }
        }
        if constexpr (ALIGN_EPI) { if (wr == 0) PG8_BAR; }
        if constexpr (!Epi::AFTER_DRAIN) { E(acc, cur, wr, wc, fr, fq); S.done(cur); }
        if (!has_next) break;
#pragma unroll
        for (int a = 0; a < 2; ++a)
#pragma unroll
            for (int b = 0; b < 2; ++b)
#pragma unroll
                for (int m = 0; m < 4; ++m)
#pragma unroll
                    for (int n = 0; n < 2; ++n) acc[a][b][m][n] = (f32x4){0.f, 0.f, 0.f, 0.f};
        cur = nxt; cA = nA; cB = nB; ++ui;
        if constexpr (ALIGN_EPI) { if (wr == 1) PG8_BAR; }
    }
    PG8_WAIT_V(0);
    if constexpr (!ALIGN_EPI) { if (wr == 0) PG8_BAR; }
    PG8_BAR;
    if constexpr (Epi::AFTER_DRAIN) { E.fused(acc, cur, wr, wc, fr, fq, lds, wid, lane); S.done(cur); }
#undef PG8_SA
#undef PG8_SB
#undef PG8_STAGE
#undef PG8_LDA
#undef PG8_LDB
#undef PG8_MMA
#undef PG8_WAIT_V
#undef PG8_WAIT_L
#undef PG8_BAR
#undef PG8_SCHED
}
}

#ifndef PG8_SP2
#define PG8_SP2 true
#endif
#ifndef PG8_ALIGN
#define PG8_ALIGN true
#endif
#include <hip/hip_bf16.h>
#include <cmath>
namespace attn_body {
using bf16=__hip_bfloat16;
using bf16x8=__attribute__((ext_vector_type(8)))short;
using s16x4=__attribute__((ext_vector_type(4)))short;
using f32x16=__attribute__((ext_vector_type(16)))float;
using u32x4=__attribute__((ext_vector_type(4)))unsigned;
constexpr int SEQ=8192,D=64;
constexpr int NW=8,QBLK=32,QB=QBLK*NW,KVBLK=64,NQB=SEQ/QB;
constexpr int ATTN_UNIT_ROWS=QB;
__device__ __forceinline__ int crow(int r,int hi){return (r&3)+8*(r>>2)+4*hi;}
#define SBAR() __builtin_amdgcn_sched_barrier(0)
__device__ __forceinline__ void cmask(f32x16&p0,f32x16&p1,int jb,int qrel,int hi){
  const float NEG=-INFINITY; int kb=64*jb+4*hi;
  #pragma unroll
  for(int r=0;r<16;++r){int kv=kb+(r&3)+8*(r>>2); if(kv>qrel)p0[r]=NEG; if(kv+32>qrel)p1[r]=NEG;}
}

constexpr int NSLOT=3, SLOTB=8192;
constexpr int LDS_K=0, LDS_V=NSLOT*SLOTB, LDS_WS=2*NSLOT*SLOTB, LDS_OST=LDS_WS+NW*64*4, LDS_BYTES=LDS_OST+NW*4096;
constexpr float C2=0.125f*1.4426950408889634f;
__device__ __forceinline__ void glds16(const void*gsrc,unsigned lds_dst){unsigned keep;
  asm volatile("s_mov_b32 %0, m0\n\ts_mov_b32 m0, %2\n\ts_nop 0\n\tglobal_load_lds_dwordx4 %1, off\n\ts_mov_b32 m0, %0":"=&s"(keep):"v"(gsrc),"s"(lds_dst):"memory");}
__device__ __forceinline__ float max3f(float a,float b,float c){float r;asm("v_max3_f32 %0, %1, %2, %3":"=v"(r):"v"(a),"v"(b),"v"(c));return r;}
__device__ __forceinline__ float max2f(float a,float b){float r;asm("v_max_f32_e32 %0, %1, %2":"=v"(r):"v"(a),"v"(b));return r;}
__device__ __forceinline__ float fadd_s(float a,float b){float r;asm("v_add_f32_e32 %0, %1, %2":"=v"(r):"v"(a),"v"(b));return r;}
__device__ __forceinline__ float fsub_s(float a,float b){float r;asm("v_sub_f32_e32 %0, %1, %2":"=v"(r):"v"(a),"v"(b));return r;}
typedef float f32x2_t __attribute__((ext_vector_type(2))); typedef __bf16 bf16x2_t __attribute__((ext_vector_type(2)));
__device__ __forceinline__ unsigned cvtpk_s(float lo,float hi){f32x2_t v={lo,hi};bf16x2_t b=__builtin_convertvector(v,bf16x2_t);return __builtin_bit_cast(unsigned,b);}
#define WAIT_BAR(N) asm volatile("s_waitcnt vmcnt(" #N ") lgkmcnt(0)\n\ts_barrier":::"memory")

__device__ __forceinline__ void qkt(f32x16&p0,f32x16&p1,const char*Kslot,const bf16x8*qr,const f32x16&negm,int r32,int hi){
  const char*kb=Kslot+hi*1024+r32*16;
  #pragma unroll
  for(int d0=0;d0<4;++d0){
    const bf16x8 b0=*reinterpret_cast<const bf16x8*>(kb+d0*2048);
    const bf16x8 b1=*reinterpret_cast<const bf16x8*>(kb+d0*2048+512);
    if(d0==0){p0=__builtin_amdgcn_mfma_f32_32x32x16_bf16(b0,qr[0],negm,0,0,0);p1=__builtin_amdgcn_mfma_f32_32x32x16_bf16(b1,qr[0],negm,0,0,0);}
    else{p0=__builtin_amdgcn_mfma_f32_32x32x16_bf16(b0,qr[d0],p0,0,0,0);p1=__builtin_amdgcn_mfma_f32_32x32x16_bf16(b1,qr[d0],p1,0,0,0);}}
}
typedef __attribute__((address_space(3))) const char* lds_cptr;
typedef short v4i16_t __attribute__((ext_vector_type(4)));
__device__ __forceinline__ void kload8(bf16x8*kf,lds_cptr kp){
  kf[0]=*(const __attribute__((address_space(3))) bf16x8*)(kp);      kf[1]=*(const __attribute__((address_space(3))) bf16x8*)(kp+512);
  kf[2]=*(const __attribute__((address_space(3))) bf16x8*)(kp+2048); kf[3]=*(const __attribute__((address_space(3))) bf16x8*)(kp+2560);
  kf[4]=*(const __attribute__((address_space(3))) bf16x8*)(kp+4096); kf[5]=*(const __attribute__((address_space(3))) bf16x8*)(kp+4608);
  kf[6]=*(const __attribute__((address_space(3))) bf16x8*)(kp+6144); kf[7]=*(const __attribute__((address_space(3))) bf16x8*)(kp+6656);
}
__device__ __forceinline__ void kload2(bf16x8*kf,lds_cptr kp,int j){ kf[2*j]=*(const __attribute__((address_space(3))) bf16x8*)(kp+j*2048); kf[2*j+1]=*(const __attribute__((address_space(3))) bf16x8*)(kp+j*2048+512); }
__device__ __forceinline__ s16x4 vtr(lds_cptr p){ return __builtin_bit_cast(s16x4,__builtin_amdgcn_ds_read_tr16_b64_v4i16((__attribute__((address_space(3))) v4i16_t*)p)); }
__device__ __forceinline__ float rowmax(const f32x16&p0,const f32x16&p1){
  float a=max3f(p0[0],p0[1],p1[0]),b=max3f(p0[2],p0[3],p1[1]);a=max3f(a,p1[2],p1[3]);
  #pragma unroll
  for(int r=4;r<16;r+=4){a=max3f(a,p0[r],p0[r+1]);b=max3f(b,p0[r+2],p0[r+3]);a=max3f(a,p1[r],p1[r+1]);b=max3f(b,p1[r+2],p1[r+3]);}
  const float m=max2f(a,b);
  auto rr=__builtin_amdgcn_permlane32_swap(__float_as_uint(m),__float_as_uint(m),false,false);
  return max2f(__uint_as_float(rr[0]),__uint_as_float(rr[1]));
}
__device__ __forceinline__ void pv(f32x16*o,int vb,bf16x8 pa0,bf16x8 pa1,bf16x8 pa2,bf16x8 pa3){
  #pragma unroll
  for(int d0=0;d0<2;++d0){s16x4 lo[4],hi[4];
    #pragma unroll
    for(int ks=0;ks<4;++ks){
      asm volatile("ds_read_b64_tr_b16 %0,%1 offset:%c2":"=&v"(lo[ks]):"v"(vb),"i"(d0*4096+ks*1024):"memory");
      asm volatile("ds_read_b64_tr_b16 %0,%1 offset:%c2":"=&v"(hi[ks]):"v"(vb),"i"(d0*4096+ks*1024+512):"memory");}
    asm volatile("s_waitcnt lgkmcnt(0)":::"memory");SBAR();
    #define PK(k) (bf16x8){lo[k][0],lo[k][1],lo[k][2],lo[k][3],hi[k][0],hi[k][1],hi[k][2],hi[k][3]}
    o[d0]=__builtin_amdgcn_mfma_f32_32x32x16_bf16(pa0,PK(0),o[d0],0,0,0);
    o[d0]=__builtin_amdgcn_mfma_f32_32x32x16_bf16(pa1,PK(1),o[d0],0,0,0);
    o[d0]=__builtin_amdgcn_mfma_f32_32x32x16_bf16(pa2,PK(2),o[d0],0,0,0);
    o[d0]=__builtin_amdgcn_mfma_f32_32x32x16_bf16(pa3,PK(3),o[d0],0,0,0);
    #undef PK
  }
}

#ifndef ATTN_STORE16
#define ATTN_STORE16(p,v) (*(u32x4*)(p)=(v))
#endif
__device__ __forceinline__ void swamask(f32x16&p0,f32x16&p1,int kvrel,int qrel,int hi){
  const float NEG=-INFINITY; const int kb=kvrel+4*hi-qrel;
  #pragma unroll
  for(int r=0;r<16;++r){int dl=kb+(r&3)+8*(r>>2); if(dl>128||dl<-128)p0[r]=NEG; if(dl+32>128||dl+32<-128)p1[r]=NEG;}
}
template<int THRL,int MODE> __device__ __forceinline__ void attn_unit(const bf16*Qb,int qp,const bf16*__restrict__ Kh,int kp,const bf16*__restrict__ Vh,int vp,bf16*Ob,int op,int q0,float sink_l2,char*shm,int kv0=0,float*stats=nullptr,bool primed=false,bool prime_next=false){
  int tid_l=threadIdx.x; asm volatile("":"+v"(tid_l));
  const int tid=tid_l,lane=tid&63,r32=lane&31,hi=lane>>5; const int wid=__builtin_amdgcn_readfirstlane(tid>>6);
  const bf16*Qw=Qb+(long)(q0+wid*QBLK)*qp;
  const unsigned ord=(MODE==1)?((q0==0)?0x765243u:((q0==SEQ-QB)?0x015243u:0x70615243u)):0u;
  #define KVS(t) ((MODE==1)?(q0-128+64*(int)((ord>>(4*(t)))&15u)):((MODE==2)?(kv0+64*(t)):(64*(t))))
  const unsigned lds0=(unsigned)(uintptr_t)shm;
  float*wsf=(float*)(shm+LDS_WS)+wid*64;
  const bf16*ksrc=Kh+(long)lane*kp+wid*8;
  const bf16*vsrc=Vh+(long)(16*(wid&3)+(lane>>2))*vp+(wid>>2)*32+(lane&3)*8;
  const unsigned kdst=lds0+LDS_K+wid*1024, vdst=lds0+LDS_V+wid*1024;
  #define DMA_K(t,slot) glds16(ksrc+(long)KVS(t)*kp,(unsigned)__builtin_amdgcn_readfirstlane(kdst+(slot)))
  #define DMA_V(t,slot) glds16(vsrc+(long)KVS(t)*vp,(unsigned)__builtin_amdgcn_readfirstlane(vdst+(slot)))
  const int vb0=(int)(lds0+LDS_V)+((lane>>4)&1)*32+(lane&3)*8+(4*hi+((lane&15)>>2))*64;
  const char*Kbase=shm+LDS_K; bf16x8 kf[8];
  const lds_cptr shm3=(lds_cptr)shm; const lds_cptr kp0=shm3+LDS_K+hi*1024+r32*16; const lds_cptr vp0=shm3+LDS_V+((lane>>4)&1)*32+(lane&3)*8+(4*hi+((lane&15)>>2))*64;
  const int NT=(MODE==1)?((q0==0||q0==SEQ-QB)?6:8):((MODE==2)?(SEQ/KVBLK/4):(SEQ/KVBLK));
  if(!primed){DMA_K(0,0);DMA_V(0,0);DMA_K(1,SLOTB);}
  bf16x8 qr[4];
  #pragma unroll
  for(int d0=0;d0<4;++d0)qr[d0]=*reinterpret_cast<const bf16x8*>(&Qw[(long)r32*qp+d0*16+hi*8]);
  float mhat=0.f,l_reg=0.f;float z0_=0.f;asm volatile("":"+v"(z0_));f32x16 o[2],negm;
  #pragma unroll
  for(int r=0;r<16;++r){o[0][r]=z0_;o[1][r]=z0_;negm[r]=z0_;}
  asm volatile("":"+v"(negm));
  const int qrel=wid*QBLK+r32;
  #define CMASK(P0,P1,t) do{ if constexpr(MODE==1) swamask(P0,P1,KVS(t)-q0,qrel,hi); }while(0)
  bool resc=false;
  #define START(P0,P1) do{ const float rm=rowmax(P0,P1); resc=false; \
    { const float dl=rm; mhat=fadd_s(mhat,dl); \
      _Pragma("unroll") for(int r=0;r<16;++r){P0[r]=fsub_s(P0[r],dl);P1[r]=fsub_s(P1[r],dl);} \
      _Pragma("unroll") for(int r=0;r<16;++r)negm[r]=-mhat; asm volatile("":"+v"(negm)); } \
    _Pragma("unroll") for(int r=0;r<16;++r)P0[r]=__builtin_amdgcn_exp2f(P0[r]); }while(0)
  #define RESC() do{ if(resc){ asm volatile("s_waitcnt lgkmcnt(0)":::"memory"); \
      _Pragma("unroll") for(int d_=0;d_<2;++d_) _Pragma("unroll") for(int r=0;r<16;++r)o[d_][r]*=wsf[crow(r,hi)]; } }while(0)
  f32x16 pA0,pA1,pB0,pB1;
  int sl_prev=0,sl_cur=0,sl_next=SLOTB;
  #define ROT() do{sl_prev=sl_cur;sl_cur=sl_next;sl_next=(sl_next==(NSLOT-1)*SLOTB)?0:sl_next+SLOTB;}while(0)
  DMA_K(2,2*SLOTB);
  WAIT_BAR(3);
  qkt(pA0,pA1,Kbase,qr,negm,r32,hi);asm volatile("s_nop 15\n\ts_nop 7":"+v"(pA0),"+v"(pA1));CMASK(pA0,pA1,0);
  START(pA0,pA1);
  _Pragma("unroll") for(int r=0;r<16;++r)pA1[r]=__builtin_amdgcn_exp2f(pA1[r]);
  WAIT_BAR(0);
  DMA_K(3,0);DMA_V(1,SLOTB);
  ROT();
  kload8(kf,kp0+sl_cur);
  WAIT_BAR(2);
  s16x4 vlo[8],vhi[8]; u32x4 pw0,pw1,pw2,pw3;
  #define PKW(P,B) cvtpk_s(P[B],P[B+1])
  #define PAF(k) __builtin_bit_cast(bf16x8,pw##k)
  #define VFR(i) (bf16x8){vlo[i][0],vlo[i][1],vlo[i][2],vlo[i][3],vhi[i][0],vhi[i][1],vhi[i][2],vhi[i][3]}
  #define PIN(x) asm volatile("":"+v"(x))
  #define MX3(a,b,c) __builtin_fmaxf(__builtin_fmaxf((a),(b)),(c))
  #define GAPA(MF,A0,A1,A2,A3,W0,W1,PW) do{ MF; sacc+=A0; sacc+=A1; sacc+=A2; sacc+=A3; PIN(sacc); W0; W1; PIN(PW); SBAR(); }while(0)
  #define EX(v) __builtin_amdgcn_exp2f(v)
  #define GAPB(MF,X,B) do{ MF; X[B]=EX(X[B]); X[B+1]=EX(X[B+1]); X[B+2]=EX(X[B+2]); X[B+3]=EX(X[B+3]); PIN(X); SBAR(); }while(0)
  #define VRD(i) do{ vlo[i]=vtr(vp_+(((i)>>2)*4096+((i)&3)*1024)); vhi[i]=vtr(vp_+(((i)>>2)*4096+((i)&3)*1024+512)); }while(0)
  #define KRD(G,j) do{ if(G){ kload2(kf,kp0+sl_next,j); SBAR(); } }while(0)
  #define STEP(C0,C1,P0,P1,t,GK,GV,GL) do{ SBAR(); \
    const lds_cptr vp_=vp0+sl_prev; \
    __builtin_amdgcn_s_setprio(1); VRD(0); SBAR(); float sacc=(P0[0]+P0[1]); \
    GAPA(C0=__builtin_amdgcn_mfma_f32_32x32x16_bf16(kf[0],qr[0],negm,0,0,0), P0[2],P0[3],P0[4],P0[5],     pw0[0]=PKW(P0,0), pw0[1]=PKW(P0,2), pw0); \
    VRD(4); SBAR(); GAPA(C1=__builtin_amdgcn_mfma_f32_32x32x16_bf16(kf[1],qr[0],negm,0,0,0), P0[6],P0[7],P0[8],P0[9],     pw0[2]=PKW(P0,4), pw0[3]=PKW(P0,6), pw0); \
    VRD(1); SBAR(); GAPA(C0=__builtin_amdgcn_mfma_f32_32x32x16_bf16(kf[2],qr[1],C0,0,0,0),   P0[10],P0[11],P0[12],P0[13], pw1[0]=PKW(P0,8), pw1[1]=PKW(P0,10), pw1); \
    VRD(5); SBAR(); GAPA(C1=__builtin_amdgcn_mfma_f32_32x32x16_bf16(kf[3],qr[1],C1,0,0,0),   P0[14],P0[15],P1[0],P1[1],   pw1[2]=PKW(P0,12),pw1[3]=PKW(P0,14), pw1); \
    VRD(2); SBAR(); GAPA(C0=__builtin_amdgcn_mfma_f32_32x32x16_bf16(kf[4],qr[2],C0,0,0,0),   P1[2],P1[3],P1[4],P1[5],     pw2[0]=PKW(P1,0), pw2[1]=PKW(P1,2), pw2); \
    VRD(6); SBAR(); GAPA(C1=__builtin_amdgcn_mfma_f32_32x32x16_bf16(kf[5],qr[2],C1,0,0,0),   P1[6],P1[7],P1[8],P1[9],     pw2[2]=PKW(P1,4), pw2[3]=PKW(P1,6), pw2); \
    VRD(3); SBAR(); GAPA(C0=__builtin_amdgcn_mfma_f32_32x32x16_bf16(kf[6],qr[3],C0,0,0,0),   P1[10],P1[11],P1[12],P1[13], pw3[0]=PKW(P1,8), pw3[1]=PKW(P1,10), pw3); \
    VRD(7); SBAR(); GAPA(C1=__builtin_amdgcn_mfma_f32_32x32x16_bf16(kf[7],qr[3],C1,0,0,0),   P1[14],P1[15],0.f,0.f,       pw3[2]=PKW(P1,12),pw3[3]=PKW(P1,14), pw3); \
    l_reg+=sacc; __builtin_amdgcn_s_setprio(0); \
    if(GK){DMA_K((t)+3,sl_cur);} if(GV){DMA_V((t)+1,sl_next);} \
    CMASK(C0,C1,t); \
    { float a=MX3(C0[0],C0[1],C1[0]),b=MX3(C0[2],C0[3],C1[1]); a=MX3(a,C1[2],C1[3]); \
      _Pragma("unroll") for(int r=4;r<16;r+=4){a=MX3(a,C0[r],C0[r+1]);b=MX3(b,C0[r+2],C0[r+3]);a=MX3(a,C1[r],C1[r+1]);b=MX3(b,C1[r+2],C1[r+3]);} \
      float rm=__builtin_fmaxf(a,b); { auto rr=__builtin_amdgcn_permlane32_swap(__float_as_uint(rm),__float_as_uint(rm),false,false); rm=__builtin_fmaxf(__uint_as_float(rr[0]),__uint_as_float(rr[1])); } \
      resc=false; \
      if(__builtin_expect(__any(rm>(float)THRL),0)){ const float dl=__builtin_fmaxf(rm,0.f); mhat+=dl; \
        _Pragma("unroll") for(int r=0;r<16;++r){C0[r]-=dl;C1[r]-=dl;} \
        _Pragma("unroll") for(int r=0;r<16;++r)negm[r]=-mhat; asm volatile("":"+v"(negm)); \
        const float f=__builtin_amdgcn_exp2f(-dl); l_reg*=f; if(hi==0)wsf[r32]=f; resc=true; } } \
    SBAR(); \
    __builtin_amdgcn_s_setprio(1); \
    GAPB(o[0]=__builtin_amdgcn_mfma_f32_32x32x16_bf16(PAF(0),VFR(0),o[0],0,0,0), C0,0); \
    GAPB(o[1]=__builtin_amdgcn_mfma_f32_32x32x16_bf16(PAF(0),VFR(4),o[1],0,0,0), C0,4); \
    KRD(GL,0); GAPB(o[0]=__builtin_amdgcn_mfma_f32_32x32x16_bf16(PAF(1),VFR(1),o[0],0,0,0), C0,8); \
    KRD(GL,1); GAPB(o[1]=__builtin_amdgcn_mfma_f32_32x32x16_bf16(PAF(1),VFR(5),o[1],0,0,0), C0,12); \
    KRD(GL,2); GAPB(o[0]=__builtin_amdgcn_mfma_f32_32x32x16_bf16(PAF(2),VFR(2),o[0],0,0,0), C1,0); \
    KRD(GL,3); GAPB(o[1]=__builtin_amdgcn_mfma_f32_32x32x16_bf16(PAF(2),VFR(6),o[1],0,0,0), C1,4); \
    GAPB(o[0]=__builtin_amdgcn_mfma_f32_32x32x16_bf16(PAF(3),VFR(3),o[0],0,0,0), C1,8); \
    GAPB(o[1]=__builtin_amdgcn_mfma_f32_32x32x16_bf16(PAF(3),VFR(7),o[1],0,0,0), C1,12); \
    __builtin_amdgcn_s_setprio(0); \
    }while(0)
  int t=1;
  for(;t+5<NT;t+=2){
    STEP(pB0,pB1,pA0,pA1,t,true,true,true);     WAIT_BAR(2); RESC(); ROT();
    STEP(pA0,pA1,pB0,pB1,t+1,true,true,true);   WAIT_BAR(2); RESC(); ROT();
  }
  #undef CMASK
  #define CMASK(P0,P1,t) do{ if constexpr(MODE==1) swamask(P0,P1,KVS(t)-q0,qrel,hi); }while(0)
  #define ENDW(tt) do{ if((tt)+3<NT){WAIT_BAR(2);} else if((tt)+2<NT){WAIT_BAR(1);} else {WAIT_BAR(0);} }while(0)
  for(;t+1<NT;t+=2){
    STEP(pB0,pB1,pA0,pA1,t,(t+3<NT),(t+1<NT),(t+1<NT));       ENDW(t);   RESC(); ROT();
    STEP(pA0,pA1,pB0,pB1,t+1,(t+4<NT),(t+2<NT),(t+2<NT));     ENDW(t+1); RESC(); ROT();
  }
  STEP(pB0,pB1,pA0,pA1,NT-1,false,false,false); RESC();
  { float sacc=pB0[0]+pB0[1]; _Pragma("unroll") for(int r=2;r<16;++r)sacc+=pB0[r]; _Pragma("unroll") for(int r=0;r<16;++r)sacc+=pB1[r]; l_reg+=sacc;
    pw0=(u32x4){PKW(pB0,0),PKW(pB0,2),PKW(pB0,4),PKW(pB0,6)};pw1=(u32x4){PKW(pB0,8),PKW(pB0,10),PKW(pB0,12),PKW(pB0,14)};pw2=(u32x4){PKW(pB1,0),PKW(pB1,2),PKW(pB1,4),PKW(pB1,6)};pw3=(u32x4){PKW(pB1,8),PKW(pB1,10),PKW(pB1,12),PKW(pB1,14)};
    SBAR(); pv(o,vb0+sl_cur,PAF(0),PAF(1),PAF(2),PAF(3)); }
  #undef PKW
  #undef PAF
  #undef VFR
  #undef PIN
  #undef MX3
  #undef GAPA
  #undef GAPB
  #undef EX
  #undef VRD
  #undef KRD
  #undef STEP
  #undef ENDW
  asm volatile("s_waitcnt lgkmcnt(0)\n\ts_barrier":::"memory");
  if(prime_next){DMA_K(0,0);DMA_V(0,0);DMA_K(1,SLOTB);}
  {auto rr=__builtin_amdgcn_permlane32_swap(__float_as_uint(l_reg),__float_as_uint(l_reg),false,false);l_reg=__uint_as_float(rr[0])+__uint_as_float(rr[1]);}
  if constexpr(MODE==1) l_reg+=__builtin_amdgcn_exp2f(sink_l2-mhat);
  if constexpr(MODE==2){ if(hi==0){ float*sp=stats+2*(long)(q0+wid*QBLK+r32); sp[0]=mhat; sp[1]=l_reg; } }
  if(hi==0)wsf[32+r32]=l_reg;asm volatile("s_waitcnt lgkmcnt(0)":::"memory");
  float rli[16];
  #pragma unroll
  for(int r=0;r<16;++r)rli[r]=__builtin_amdgcn_rcpf(wsf[32+crow(r,hi)]);
  bf16*Ow=Ob+(long)(q0+wid*QBLK)*op;
  { bf16*stg=(bf16*)(shm+LDS_OST)+wid*2048;
    #pragma unroll
    for(int r=0;r<16;++r){const int orow=crow(r,hi);
      #pragma unroll
      for(int d0=0;d0<2;++d0)stg[orow*64+d0*32+r32]=__float2bfloat16(o[d0][r]*rli[r]);}
    asm volatile("s_waitcnt lgkmcnt(0)":::"memory");
    #pragma unroll
    for(int i=0;i<4;++i){const int row=i*8+(lane>>3),ch=lane&7; const u32x4 v=*(const u32x4*)(stg+row*64+ch*8); ATTN_STORE16(Ow+(long)row*op+ch*8,v);} }
  asm volatile("s_waitcnt lgkmcnt(0)\n\ts_barrier":::"memory");
  #undef DMA_K
  #undef KVS
  #undef DMA_V
  #undef CMASK
  #undef START
  #undef RESC
  #undef ROT
}
constexpr int ATTN_LDS_BYTES=LDS_BYTES;
#undef SBAR
#undef WAIT_BAR
}
#include <hip/hip_cooperative_groups.h>
namespace cg = cooperative_groups;
#define LAS __attribute__((address_space(3)))
#define GAS __attribute__((address_space(1)))
typedef unsigned short bf16;
typedef unsigned v4u __attribute__((ext_vector_type(4)));
typedef unsigned v2u __attribute__((ext_vector_type(2)));
typedef float f32x4 __attribute__((ext_vector_type(4)));
typedef float f32x16 __attribute__((ext_vector_type(16)));
typedef short bf16x8 __attribute__((ext_vector_type(8)));
constexpr int NWAVES = 8, NTHR = 512;
constexpr int DMODEL = 1024, SEQ = 8192, MG = 2 * SEQ, NGRP = 3, DEPTH = 2, INC = 3088, NPROJ = 3072, DFF = 4096;
constexpr float EPS = 1e-6f;
constexpr float LOG2E = 1.4426950408889634f;
constexpr size_t MiB = 1u << 20;
constexpr size_t WS_ROPE = 1 * MiB;
constexpr size_t WS_WIN = 4 * MiB, WS_WOUT = 16 * MiB, WS_WUP = 20 * MiB, WS_WDN = 36 * MiB;
constexpr size_t WS_HN = 52 * MiB, WS_DNRAW = 84 * MiB, WS_Z = 108 * MiB, WS_DFQ = 116 * MiB, WS_DFK = 132 * MiB, WS_DFV = 148 * MiB;
constexpr size_t WS_SWQ = 164 * MiB, WS_SWKV = 172 * MiB, WS_BG = 180 * MiB, WS_GS = 181 * MiB;
constexpr size_t WS_QS = 182 * MiB, WS_KS = 198 * MiB, WS_KT = 214 * MiB, WS_U = 230 * MiB, WS_W = 246 * MiB;
constexpr size_t WS_ODN = 262 * MiB, WS_ODF = 294 * MiB, WS_MIX = 326 * MiB, WS_HID = 358 * MiB, WS_END = 486 * MiB;
constexpr size_t WS_WL = 3 * MiB;
constexpr size_t WS_SS2 = 497 * MiB;
constexpr size_t WS_SS = 496 * MiB;
constexpr size_t WS_PO = 486 * MiB, WS_PS = 494 * MiB;
constexpr int LDS_BYTES = 147456;
static_assert(WS_DNRAW == 84 * MiB && WS_Z == 108 * MiB && WS_DFQ == 116 * MiB && WS_DFK == 132 * MiB && WS_DFV == 148 * MiB && WS_SWQ == 164 * MiB && WS_SWKV == 172 * MiB, "EpiProj offsets");

__device__ __forceinline__ float bf2f(unsigned short b) { return __uint_as_float((unsigned)b << 16); }
__device__ __forceinline__ unsigned f2bf(float f) { unsigned u = __builtin_bit_cast(unsigned, f); return (u + 0x7fffu + ((u >> 16) & 1u)) >> 16; }
typedef float f32x2_ __attribute__((ext_vector_type(2))); typedef __bf16 bf16x2_ __attribute__((ext_vector_type(2)));
__device__ __forceinline__ unsigned pk2(float lo, float hi) { f32x2_ v = {lo, hi}; bf16x2_ b = __builtin_convertvector(v, bf16x2_); return __builtin_bit_cast(unsigned, b); }
__device__ __forceinline__ float shx(float v, int o, int lane) { return __int_as_float(__builtin_amdgcn_ds_bpermute((lane ^ o) << 2, __float_as_int(v))); }
__device__ __forceinline__ float wave_sum(float v, int lane) {
#pragma unroll
    for (int o = 1; o < 64; o <<= 1) v += shx(v, o, lane);
    return v;
}
#define MFMA32(a, b, c) __builtin_amdgcn_mfma_f32_32x32x16_bf16((a), (b), (c), 0, 0, 0)
__device__ __forceinline__ int crow(int r, int hi) { return (r & 3) + 8 * (r >> 2) + 4 * hi; }
__device__ __forceinline__ bf16x8 pack8(const f32x16& x, int s) {
    v4u p; p.x = pk2(x[8 * s], x[8 * s + 1]); p.y = pk2(x[8 * s + 2], x[8 * s + 3]); p.z = pk2(x[8 * s + 4], x[8 * s + 5]); p.w = pk2(x[8 * s + 6], x[8 * s + 7]);
    return __builtin_bit_cast(bf16x8, p);
}

#define XB_TMO      128
#define XB_XCNT(j)  (256  + 64 * (j))
#define XB_XSUB(j)  (1280 + 64 * (j))
#define XB_XGEN(j)  (2304 + 64 * (j))
#define XB_TOP      3328
#define XB_TOPGEN   3392
#define XCD_BAR_WORDS 3456
#define XB_SPIN_CAP (1u << 18)

__device__ __forceinline__ unsigned xb_ld(unsigned* p)              { return __hip_atomic_load(p, __ATOMIC_RELAXED, __HIP_MEMORY_SCOPE_AGENT); }
__device__ __forceinline__ unsigned xb_add(unsigned* p, unsigned v) { return __hip_atomic_fetch_add(p, v, __ATOMIC_RELAXED, __HIP_MEMORY_SCOPE_AGENT); }
__device__ __forceinline__ unsigned xb_xcc_id() { return (unsigned)__builtin_amdgcn_s_getreg((3 << 11) | 20) & 0xFu; }
#define XB_SPIN(cond, bar) do { unsigned _sp = 0; while (cond) { __builtin_amdgcn_s_sleep(1); \
    if ((++_sp & 255u) == 0u) { if (xb_ld(&(bar)[XB_TMO])) break; if (_sp > XB_SPIN_CAP) { atomicAdd(&(bar)[XB_TMO], 1u); break; } } } } while (0)

struct XcdBarrier {
    unsigned* bar; unsigned x;
    volatile LAS unsigned* st;
};

__device__ __forceinline__ XcdBarrier xcd_barrier_post(unsigned* bar, volatile LAS unsigned* st) {
    XcdBarrier b; b.bar = bar; b.x = xb_xcc_id(); b.st = st;
    if (threadIdx.x == 0) (void)xb_add(&bar[XB_XCNT(b.x)], 1u);
    return b;
}
__device__ __forceinline__ void xcd_barrier_complete(unsigned* bar, unsigned x, unsigned& nloc, unsigned& nx) {
    const unsigned G = gridDim.x * gridDim.y * gridDim.z;
    unsigned sum, cnt, mine, sp = 0u;
    for (;;) {
        sum = 0u; cnt = 0u; mine = 0u;
#pragma unroll
        for (unsigned j = 0; j < 16; ++j) { const unsigned c = xb_ld(&bar[XB_XCNT(j)]); sum += c; cnt += (c > 0u) ? 1u : 0u; mine = (j == x) ? c : mine; }
        if (sum == G) break;
        __builtin_amdgcn_s_sleep(1);
        if ((++sp & 255u) == 0u) { if (xb_ld(&bar[XB_TMO])) break; if (sp > XB_SPIN_CAP) { atomicAdd(&bar[XB_TMO], 1u); break; } }
    }
    nloc = mine > 0u ? mine : 1u; nx = cnt > 0u ? cnt : 1u;
}

__device__ __forceinline__ void xcd_barrier(const XcdBarrier& b) {
    asm volatile("s_waitcnt vmcnt(0)" ::: "memory");
    __syncthreads();
    if (threadIdx.x == 0) {
        unsigned* bar = b.bar;
        __builtin_amdgcn_s_waitcnt(0);
        unsigned nloc = b.st[0], nx = b.st[1];
        if (nloc == 0u) { xcd_barrier_complete(bar, b.x, nloc, nx); b.st[0] = nloc; b.st[1] = nx; }
        const unsigned old = xb_add(&bar[XB_XSUB(b.x)], 1u);
        const unsigned gen = old / nloc;
        if (old + 1u == (gen + 1u) * nloc) {
            __builtin_amdgcn_fence(__ATOMIC_RELEASE, "agent");
            asm volatile("s_waitcnt vmcnt(0)" ::: "memory");
            const unsigned og = xb_add(&bar[XB_TOP], 1u);
            const unsigned tg = og / nx;
            if (og + 1u == (tg + 1u) * nx) xb_add(&bar[XB_TOPGEN], 1u);
            else XB_SPIN(xb_ld(&bar[XB_TOPGEN]) == tg, bar);
            __builtin_amdgcn_fence(__ATOMIC_ACQUIRE, "agent");
            xb_add(&bar[XB_XGEN(b.x)], 1u);
            asm volatile("s_waitcnt vmcnt(0)" ::: "memory");
        } else {
            XB_SPIN(xb_ld(&bar[XB_XGEN(b.x)]) == gen, bar);
            __builtin_amdgcn_fence(__ATOMIC_ACQUIRE, "agent");
            asm volatile("s_waitcnt vmcnt(0)" ::: "memory");
        }
    }
    __syncthreads();
}

struct Ctx {
    LAS unsigned char* lds; unsigned char* ldsg;
    int tid, lane, wave, vcu, G, bx;
    unsigned char* ws;
};

__device__ __forceinline__ void transpose_item(const float* W, int K, int Nsrc, bf16* WT, int nblk, int item, int skip_from, int skip, LAS float* scr, int lane, const float* kscale = nullptr) {
    const int kb = item / nblk, nb = item % nblk, k0 = 64 * kb, n0 = 32 * nb, c0 = n0 + (n0 >= skip_from ? skip : 0);
    { const int kk0 = lane >> 3, c4 = (lane & 7) * 4;
      f32x4 v[8];
#pragma unroll
      for (int i = 0; i < 8; ++i) v[i] = *(const f32x4*)(W + (size_t)(k0 + kk0 + 8 * i) * Nsrc + c0 + c4);
#pragma unroll
      for (int i = 0; i < 8; ++i) { const int kk = kk0 + 8 * i; const float sc = kscale ? kscale[k0 + kk] : 1.f; LAS float* d = scr + kk * 33 + c4; d[0] = v[i].x * sc; d[1] = v[i].y * sc; d[2] = v[i].z * sc; d[3] = v[i].w * sc; } }
    asm volatile("s_waitcnt lgkmcnt(0)" ::: "memory");
    const int c = lane & 7;
#pragma unroll
    for (int j = 0; j < 4; ++j) { const int n = (lane >> 3) + 8 * j; const LAS float* s = scr + (8 * c) * 33 + n;
        v4u o; o.x = pk2(s[0 * 33], s[1 * 33]); o.y = pk2(s[2 * 33], s[3 * 33]); o.z = pk2(s[4 * 33], s[5 * 33]); o.w = pk2(s[6 * 33], s[7 * 33]);
        *(v4u*)(WT + (size_t)(n0 + n) * K + k0 + 8 * c) = o; }
    asm volatile("s_waitcnt lgkmcnt(0)" ::: "memory");
}

__device__ __forceinline__ void phase_prologue(Ctx& C, const float* w_in, const float* w_out, const float* w_up, const float* w_dn, const float* n2w, const float* n1w) {
    LAS float* scr = (LAS float*)(C.lds + C.wave * 16384);
    const int gw = C.vcu * NWAVES + C.wave, NGW = C.G * NWAVES;
    constexpr int I_IN = (DMODEL / 64) * (NPROJ / 32), I_OUT = (DMODEL / 64) * (DMODEL / 32), I_UP = (DMODEL / 64) * (DFF / 32), I_DN = (DFF / 64) * (DMODEL / 32);
    constexpr int PER = I_IN + I_OUT + I_UP + I_DN;
    for (int it = gw; it < DEPTH * PER; it += NGW) {
        const int l = it / PER; int r = it % PER;
        if (r < I_IN) { transpose_item(w_in + (size_t)l * DMODEL * INC, DMODEL, INC, (bf16*)(C.ws + WS_WIN) + (size_t)l * NPROJ * DMODEL, NPROJ / 32, r, 1024, 16, scr, C.lane, l ? n1w + DMODEL : nullptr); continue; } r -= I_IN;
        if (r < I_OUT) { transpose_item(w_out + (size_t)l * DMODEL * DMODEL, DMODEL, DMODEL, (bf16*)(C.ws + WS_WOUT) + (size_t)l * DMODEL * DMODEL, DMODEL / 32, r, 1 << 30, 0, scr, C.lane); continue; } r -= I_OUT;
        if (r < I_UP) { transpose_item(w_up + (size_t)l * DMODEL * DFF, DMODEL, DFF, (bf16*)(C.ws + WS_WUP) + (size_t)l * DFF * DMODEL, DFF / 32, r, 1 << 30, 0, scr, C.lane, n2w + l * DMODEL); continue; } r -= I_UP;
        transpose_item(w_dn + (size_t)l * DFF * DMODEL, DFF, DMODEL, (bf16*)(C.ws + WS_WDN) + (size_t)l * DMODEL * DFF, DMODEL / 32, r, 1 << 30, 0, scr, C.lane);
    }
    for (int e = C.vcu * NTHR + C.tid; e < DEPTH * 32 * DMODEL; e += C.G * NTHR) { const int k = e & (DMODEL - 1), o = (e >> 10) & 31, l = e >> 15;
        const float v = (o < 16) ? w_in[(size_t)l * DMODEL * INC + (size_t)k * INC + 1024 + o] * (l ? n1w[DMODEL + k] : 1.f) : 0.f;
        ((bf16*)(C.ws + WS_WL))[e] = (bf16)(pk2(v, 0.f) & 0xffffu); }
    float* cosT = (float*)(C.ws + WS_ROPE); float* sinT = cosT + SEQ * 32;
    for (int e = C.vcu * NTHR + C.tid; e < SEQ * 32; e += C.G * NTHR) {
        const int pos = e >> 5, i = e & 31;
        const double inv = exp(-(double)i * (9.210340371976184 / 32.0));
        double rev = (double)pos * inv * 0.15915494309189535;
        rev -= floor(rev);
        const float fr = (float)rev;
        cosT[e] = __builtin_amdgcn_cosf(fr); sinT[e] = __builtin_amdgcn_sinf(fr);
    }
}

template <bool LOGITS>
__device__ __forceinline__ void phase_norm(Ctx& C, const float* x, const float* nw, bf16* hn, const float* w_in_l, float* bg) {
    LAS float* wl = (LAS float*)C.lds;
    if (LOGITS) {
        for (int e = C.tid; e < DMODEL * 16; e += NTHR) { const int k = e >> 4, o = e & 15;
            wl[(((((k >> 8) * 4 + (k & 3)) * 4 + (o >> 2)) * 64 + ((k >> 2) & 63)) * 4) + (o & 3)] = w_in_l[(size_t)k * INC + 1024 + o]; }
        __syncthreads();
    }
    const int gw = C.vcu * NWAVES + C.wave, NGW = C.G * NWAVES;
    f32x4 wv[4];
#pragma unroll
    for (int j = 0; j < 4; ++j) wv[j] = ((const f32x4*)nw)[C.lane + 64 * j];
    f32x4 v[4];
    { const f32x4* xr = (const f32x4*)(x + (size_t)gw * DMODEL) + C.lane;
#pragma unroll
      for (int j = 0; j < 4; ++j) v[j] = xr[64 * j]; }
    for (int m = gw; m < MG; m += NGW) {
        f32x4 vn[4]; { const int mn = (m + NGW < MG) ? m + NGW : m; const f32x4* xr = (const f32x4*)(x + (size_t)mn * DMODEL) + C.lane;
#pragma unroll
          for (int j = 0; j < 4; ++j) vn[j] = xr[64 * j]; }
        float s = 0.f;
#pragma unroll
        for (int j = 0; j < 4; ++j) s += (v[j].x * v[j].x + v[j].y * v[j].y) + (v[j].z * v[j].z + v[j].w * v[j].w);
        const float rstd = 1.f / sqrtf(wave_sum(s, C.lane) * (1.f / DMODEL) + EPS);
        unsigned long long* o8 = (unsigned long long*)(hn + (size_t)m * DMODEL) + C.lane;
#pragma unroll
        for (int j = 0; j < 4; ++j) { v[j] = v[j] * rstd * wv[j]; o8[64 * j] = (unsigned long long)pk2(v[j].x, v[j].y) | ((unsigned long long)pk2(v[j].z, v[j].w) << 32); }
        if (LOGITS) {
            float acc[16];
#pragma unroll
            for (int o = 0; o < 16; ++o) acc[o] = 0.f;
#pragma unroll
            for (int j = 0; j < 4; ++j)
#pragma unroll
                for (int e = 0; e < 4; ++e) { const int k = 4 * C.lane + 256 * j + e; const float hv = v[j][e];
#pragma unroll
                    for (int o4 = 0; o4 < 4; ++o4) { const f32x4 w4 = *(const LAS f32x4*)(wl + ((((j * 4 + e) * 4 + o4) * 64 + C.lane) * 4)); acc[4 * o4] += hv * w4.x; acc[4 * o4 + 1] += hv * w4.y; acc[4 * o4 + 2] += hv * w4.z; acc[4 * o4 + 3] += hv * w4.w; } }
            float mine = 0.f;
#pragma unroll
            for (int o = 0; o < 16; ++o) { const float t = wave_sum(acc[o], C.lane); if (C.lane == o) mine = t; }
            if (C.lane < 16) bg[(size_t)m * 16 + C.lane] = mine;
        }
#pragma unroll
        for (int j = 0; j < 4; ++j) v[j] = vn[j];
    }
    if (LOGITS) __syncthreads();
}

__device__ __forceinline__ void phase_logits(Ctx& C, const bf16* A, const bf16* WL, const float* ss, float* bg) {
    const int r32 = C.lane & 31, hi = C.lane >> 5, tl = C.wave >> 2, kq = C.wave & 3, row0 = (tl * 256 + C.vcu) * 32;
    const GAS bf16* ap = (const GAS bf16*)A + (size_t)(row0 + r32) * DMODEL + kq * 256 + 8 * hi; const GAS bf16* bp = (const GAS bf16*)WL + (size_t)r32 * DMODEL + kq * 256 + 8 * hi;
    bf16x8 af[16], bf_[16];
#pragma unroll
    for (int j = 0; j < 16; ++j) { af[j] = *(const GAS bf16x8*)(ap + 16 * j); bf_[j] = *(const GAS bf16x8*)(bp + 16 * j); }
    f32x16 acc = f32x16{};
#pragma unroll
    for (int j = 0; j < 16; ++j) acc = MFMA32(af[j], bf_[j], acc);
    LAS f32x4* part = (LAS f32x4*)C.lds + (C.wave * 64 + C.lane) * 4;
#pragma unroll
    for (int q = 0; q < 4; ++q) part[q] = (f32x4){acc[4 * q], acc[4 * q + 1], acc[4 * q + 2], acc[4 * q + 3]};
    __syncthreads();
    if (kq == 0 && r32 < 16) {
#pragma unroll
        for (int q = 0; q < 4; ++q) { f32x4 t = part[q];
#pragma unroll
            for (int w = 1; w < 4; ++w) t += ((LAS f32x4*)C.lds + ((C.wave + w) * 64 + C.lane) * 4)[q];
#pragma unroll
            for (int e = 0; e < 4; ++e) { const int r = 4 * q + e, row = row0 + crow(r, hi); const float rs = ss ? pg8::row_rstd(ss, row) : 1.0f; bg[(size_t)row * 16 + r32] = t[e] * rs; } }
    }
    __syncthreads();
}

__device__ __forceinline__ void phase_final_norm(Ctx& C, float* x, const float* nw) {
    const int gw = C.vcu * NWAVES + C.wave, NGW = C.G * NWAVES;
    f32x4 wv[4];
#pragma unroll
    for (int j = 0; j < 4; ++j) wv[j] = ((const f32x4*)nw)[C.lane + 64 * j];
    for (int m = gw; m < MG; m += 2 * NGW) {
        f32x4* xa = (f32x4*)(x + (size_t)m * DMODEL) + C.lane; f32x4* xb = (f32x4*)(x + (size_t)(m + NGW) * DMODEL) + C.lane;
        f32x4 va[4], vb[4]; float sa = 0.f, sb = 0.f;
#pragma unroll
        for (int j = 0; j < 4; ++j) { va[j] = xa[64 * j]; vb[j] = xb[64 * j]; }
#pragma unroll
        for (int j = 0; j < 4; ++j) { sa += (va[j].x * va[j].x + va[j].y * va[j].y) + (va[j].z * va[j].z + va[j].w * va[j].w); sb += (vb[j].x * vb[j].x + vb[j].y * vb[j].y) + (vb[j].z * vb[j].z + vb[j].w * vb[j].w); }
        const float ra = 1.f / sqrtf(wave_sum(sa, C.lane) * (1.f / DMODEL) + EPS), rb = 1.f / sqrtf(wave_sum(sb, C.lane) * (1.f / DMODEL) + EPS);
#pragma unroll
        for (int j = 0; j < 4; ++j) { xa[64 * j] = va[j] * ra * wv[j]; xb[64 * j] = vb[j] * rb * wv[j]; }
    }
}

__device__ __forceinline__ void phase_rope(Ctx& C) {
    const float* cosT = (const float*)(C.ws + WS_ROPE); const float* sinT = cosT + SEQ * 32;
    const int total = MG * 22 * 4, T = C.G * NTHR;
    for (int it0 = C.vcu * NTHR + C.tid; it0 < total; it0 += 4 * T) {
        bf16* p[4]; float sc[4]; v4u a[4], b[4]; f32x4 c0[4], c1[4], s0[4], s1[4]; bool ok[4];
#pragma unroll
        for (int u = 0; u < 4; ++u) {
            const int it = it0 + u * T; ok[u] = it < total; const int itc = ok[u] ? it : it0;
            const int i8 = itc & 3, grp = (itc >> 2) % 22, row = (itc >> 2) / 22, pos = row & (SEQ - 1);
            sc[u] = 1.f;
            if (grp < 8) { p[u] = (bf16*)(C.ws + WS_DFQ) + (size_t)row * 512 + grp * 64; sc[u] = 0.125f * LOG2E; }
            else if (grp < 16) { p[u] = (bf16*)(C.ws + WS_DFK) + (size_t)row * 512 + (grp - 8) * 64; }
            else if (grp < 20) { p[u] = (bf16*)(C.ws + WS_SWQ) + (size_t)row * 256 + (grp - 16) * 64; sc[u] = 0.125f * LOG2E; }
            else { p[u] = (bf16*)(C.ws + WS_SWKV) + (size_t)row * 256 + (grp - 20) * 64; }
            p[u] += i8 * 8;
            a[u] = *(const v4u*)(p[u]); b[u] = *(const v4u*)(p[u] + 32);
            c0[u] = *(const f32x4*)(cosT + pos * 32 + i8 * 8); c1[u] = *(const f32x4*)(cosT + pos * 32 + i8 * 8 + 4);
            s0[u] = *(const f32x4*)(sinT + pos * 32 + i8 * 8); s1[u] = *(const f32x4*)(sinT + pos * 32 + i8 * 8 + 4);
        }
#pragma unroll
        for (int u = 0; u < 4; ++u) {
            v4u oa, ob;
#pragma unroll
            for (int w = 0; w < 4; ++w) {
                const float x1l = __uint_as_float(a[u][w] << 16), x1h = __uint_as_float(a[u][w] & 0xffff0000u), x2l = __uint_as_float(b[u][w] << 16), x2h = __uint_as_float(b[u][w] & 0xffff0000u);
                const float cl = (w < 2) ? c0[u][2 * w] : c1[u][2 * w - 4], ch = (w < 2) ? c0[u][2 * w + 1] : c1[u][2 * w - 3];
                const float sl = (w < 2) ? s0[u][2 * w] : s1[u][2 * w - 4], sh = (w < 2) ? s0[u][2 * w + 1] : s1[u][2 * w - 3];
                oa[w] = pk2((x1l * cl - x2l * sl) * sc[u], (x1h * ch - x2h * sh) * sc[u]);
                ob[w] = pk2((x2l * cl + x1l * sl) * sc[u], (x2h * ch + x1h * sh) * sc[u]);
            }
            if (ok[u]) { *(v4u*)(p[u]) = oa; *(v4u*)(p[u] + 32) = ob; }
        }
    }
}

__device__ __forceinline__ void rope_span(Ctx& C, int beg, int end, int t, int nthr) {
    const float* cosT = (const float*)(C.ws + WS_ROPE); const float* sinT = cosT + SEQ * 32;
    for (int it0 = beg + t; it0 < end; it0 += 2 * nthr) {
        bf16* p[2]; float sc[2]; v4u a[2], b[2]; f32x4 c0[2], c1[2], s0[2], s1[2]; bool ok[2];
#pragma unroll
        for (int u = 0; u < 2; ++u) {
            const int it = it0 + u * nthr; ok[u] = it < end; const int itc = ok[u] ? it : it0;
            const int i8 = itc & 3, grp = (itc >> 2) % 22, row = (itc >> 2) / 22, pos = row & (SEQ - 1);
            sc[u] = 1.f;
            if (grp < 8) { p[u] = (bf16*)(C.ws + WS_DFQ) + (size_t)row * 512 + grp * 64; sc[u] = 0.125f * LOG2E; }
            else if (grp < 16) { p[u] = (bf16*)(C.ws + WS_DFK) + (size_t)row * 512 + (grp - 8) * 64; }
            else if (grp < 20) { p[u] = (bf16*)(C.ws + WS_SWQ) + (size_t)row * 256 + (grp - 16) * 64; sc[u] = 0.125f * LOG2E; }
            else { p[u] = (bf16*)(C.ws + WS_SWKV) + (size_t)row * 256 + (grp - 20) * 64; }
            p[u] += i8 * 8;
            a[u] = *(const v4u*)(p[u]); b[u] = *(const v4u*)(p[u] + 32);
            c0[u] = *(const f32x4*)(cosT + pos * 32 + i8 * 8); c1[u] = *(const f32x4*)(cosT + pos * 32 + i8 * 8 + 4);
            s0[u] = *(const f32x4*)(sinT + pos * 32 + i8 * 8); s1[u] = *(const f32x4*)(sinT + pos * 32 + i8 * 8 + 4);
        }
#pragma unroll
        for (int u = 0; u < 2; ++u) {
            v4u oa, ob;
#pragma unroll
            for (int w = 0; w < 4; ++w) {
                const float x1l = __uint_as_float(a[u][w] << 16), x1h = __uint_as_float(a[u][w] & 0xffff0000u), x2l = __uint_as_float(b[u][w] << 16), x2h = __uint_as_float(b[u][w] & 0xffff0000u);
                const float cl = (w < 2) ? c0[u][2 * w] : c1[u][2 * w - 4], ch = (w < 2) ? c0[u][2 * w + 1] : c1[u][2 * w - 3];
                const float sl = (w < 2) ? s0[u][2 * w] : s1[u][2 * w - 4], sh = (w < 2) ? s0[u][2 * w + 1] : s1[u][2 * w - 3];
                oa[w] = pk2((x1l * cl - x2l * sl) * sc[u], (x1h * ch - x2h * sh) * sc[u]);
                ob[w] = pk2((x2l * cl + x1l * sl) * sc[u], (x2h * ch + x1h * sh) * sc[u]);
            }
            if (ok[u]) { *(v4u*)(p[u]) = oa; *(v4u*)(p[u] + 32) = ob; }
        }
    }
}

__device__ __forceinline__ void phase_dn_prep(Ctx& C, const float* convw, const float* a_log, const float* dt_bias) {
    constexpr int P = 65;
    LAS float* raw = (LAS float*)C.lds;
    LAS float* KK = raw; LAS float* QK = raw + 64 * P; LAS float* Ld = raw + 2 * 64 * P;
    LAS float* qkv = (LAS float*)(C.lds + 66048);
    LAS float* sm = (LAS float*)(C.lds + 66048 + 49920);
    LAS float* betaT = sm, *gT = sm + 128, *Gs = sm + 256, *bs = sm + 384;
    const bf16* dnraw = (const bf16*)(C.ws + WS_DNRAW); const float* bg = (const float*)(C.ws + WS_BG);
    for (int task = C.vcu; task < 2 * 4 * 128; task += C.G) {
        const int nc = task & 127, h = (task >> 7) & 3, seq = task >> 9, c0 = nc * 64;
        __syncthreads();
        int tid_ = C.tid; asm volatile("" : "+v"(tid_));
        const int tidl = tid_, lanel = tid_ & 63, wavel = __builtin_amdgcn_readfirstlane(tid_ >> 6);
        for (int idx = tidl; idx < 3 * 68 * 8; idx += NTHR) {
            const int c8 = idx & 7, rr = (idx >> 3) % 68, part = (idx >> 3) / 68, t = c0 - 2 + rr;
            v4u v = (v4u){0u, 0u, 0u, 0u};
            if (t >= 0 && t < SEQ) v = *(const v4u*)(dnraw + (size_t)(seq * SEQ + t) * 768 + part * 256 + h * 64 + c8 * 8);
            LAS float* d = raw + (part * 68 + rr) * 64 + c8 * 8;
#pragma unroll
            for (int w = 0; w < 4; ++w) { d[2 * w] = __uint_as_float(v[w] << 16); d[2 * w + 1] = __uint_as_float(v[w] & 0xffff0000u); }
        }
        if (tidl < 128) { const int dir = tidl >> 6, i = tidl & 63; const size_t row = (size_t)(seq * SEQ + c0 + i);
            const float bl = bg[row * 16 + dir * 4 + h], al = bg[row * 16 + 8 + dir * 4 + h] + dt_bias[dir * 4 + h];
            betaT[dir * 64 + i] = 1.f / (1.f + __expf(-bl));
            const float e_ = __expf(-fabsf(al)); const float sp = fmaxf(al, 0.f) + ((e_ < 0.01f) ? e_ * (1.f - e_ * (0.5f - e_ * 0.33333333f)) : __logf(1.f + e_));
            gT[dir * 64 + i] = -__expf(a_log[dir * 4 + h]) * sp; }
        __syncthreads();
        { const int c = tidl & 63, i0 = tidl >> 6;
#pragma unroll
          for (int part = 0; part < 3; ++part) { float cw[5];
#pragma unroll
            for (int j = 0; j < 5; ++j) cw[j] = convw[j * 768 + part * 256 + h * 64 + c];
#pragma unroll
            for (int k = 0; k < 8; ++k) { const int i = i0 + 8 * k; float sacc = 0.f;
#pragma unroll
                for (int j = 0; j < 5; ++j) sacc += raw[(part * 68 + i + j) * 64 + c] * cw[j];
                qkv[(part * 64 + i) * P + c] = sacc / (1.f + __expf(-sacc)); } } }
        if (wavel < 2) { const int dir = wavel, il = lanel, it = dir ? 63 - il : il; float a = gT[dir * 64 + it];
#pragma unroll
            for (int o = 1; o < 64; o <<= 1) { const float t = __int_as_float(__builtin_amdgcn_ds_bpermute(((il - o) & 63) << 2, __float_as_int(a))); if (il >= o) a += t; }
            Gs[dir * 64 + il] = a; bs[dir * 64 + il] = betaT[dir * 64 + it];
            const float gl_ = __int_as_float(__builtin_amdgcn_ds_bpermute(63 << 2, __float_as_int(a)));
            sm[512 + dir * 64 + il] = __expf(a); sm[640 + dir * 64 + il] = __expf(gl_ - a); }
        __syncthreads();
        { LAS float* r = qkv + (tidl >> 2) * P + 16 * (tidl & 3); float v[16]; float sq = 0.f;
#pragma unroll
          for (int c = 0; c < 16; ++c) { v[c] = r[c]; sq += v[c] * v[c]; }
          sq += shx(sq, 1, lanel); sq += shx(sq, 2, lanel);
          const float sc = 1.f / sqrtf(sq + EPS);
#pragma unroll
          for (int c = 0; c < 16; ++c) r[c] = v[c] * sc; }
        __syncthreads();
        { const int r32 = lanel & 31, hi = lanel >> 5, mat = wavel >> 2, it = (wavel >> 1) & 1, mt = wavel & 1;
          const LAS float* ar = qkv + ((mat ? 0 : 64) + r32 + 32 * it) * P + 2 * hi; const LAS float* br = qkv + (64 + r32 + 32 * mt) * P + 2 * hi;
          f32x16 acc = f32x16{};
#pragma unroll
          for (int j = 0; j < 16; ++j) { const float a0 = ar[4 * j], a1 = ar[4 * j + 1], b0 = br[4 * j], b1 = br[4 * j + 1];
              acc = __builtin_amdgcn_mfma_f32_32x32x2f32(a0, b0, acc, 0, 0, 0); acc = __builtin_amdgcn_mfma_f32_32x32x2f32(a1, b1, acc, 0, 0, 0); }
          LAS float* dst = (mat ? QK : KK) + (32 * it) * P + r32 + 32 * mt;
#pragma unroll
          for (int r = 0; r < 16; ++r) dst[((r & 3) + 8 * (r >> 2) + 4 * hi) * P] = acc[r]; }
        __syncthreads();
        for (int idx = tidl; idx < 2 * 64 * 64; idx += NTHR) {
            const int ml = idx & 63, il = (idx >> 6) & 63, dir = idx >> 12;
            const int it = dir ? 63 - il : il, mt = dir ? 63 - ml : ml;
            float v = 0.f;
            if (il > ml) v = bs[dir * 64 + il] * KK[it * P + mt] * __expf(Gs[dir * 64 + il] - Gs[dir * 64 + ml]);
            Ld[idx] = v;
        }
        __syncthreads();
        const int blk0 = ((0 * 2 + seq) * 4 + h) * 128 + nc, blk1 = ((1 * 2 + seq) * 4 + h) * 128 + (127 - nc);
        if (wavel < 4) {
            const int dir = wavel >> 1, col = (wavel & 1) * 64 + lanel;
            unsigned lb = (unsigned)(uintptr_t)(Ld + dir * 4096);
            const LAS float* src = (col < 64) ? (qkv + (2 * 64) * P + col) : (qkv + 64 * P + (col - 64));
            float xs[64];
#pragma unroll
            for (int il = 0; il < 64; ++il) {
                const int it = dir ? 63 - il : il;
                float a = src[it * P] * bs[dir * 64 + il];
                if (col >= 64) a *= sm[512 + dir * 64 + il];
#pragma unroll
                for (int m4 = 0; m4 < (il + 3) / 4; ++m4) { const f32x4 l4 = *(const LAS f32x4*)(uintptr_t)(lb + (il * 64 + 4 * m4) * 4);
                    if (4 * m4 < il) a -= l4.x * xs[4 * m4];
                    if (4 * m4 + 1 < il) a -= l4.y * xs[4 * m4 + 1];
                    if (4 * m4 + 2 < il) a -= l4.z * xs[4 * m4 + 2];
                    if (4 * m4 + 3 < il) a -= l4.w * xs[4 * m4 + 3]; }
                xs[il] = a; if (il & 1) asm volatile("" : "+v"(lb) : "v"(a));
            }
            const int blk = dir ? blk1 : blk0;
            if (col < 64) {
                bf16* U = (bf16*)(C.ws + WS_U) + (size_t)blk * 4096;
                const int et = col >> 5, r32 = col & 31;
#pragma unroll
                for (int mt = 0; mt < 2; ++mt)
#pragma unroll
                    for (int hi = 0; hi < 2; ++hi) { v4u o0, o1;
#pragma unroll
                        for (int q = 0; q < 4; ++q) { const int ra = 2 * q, rb = 2 * q + 1, rc = 8 + 2 * q, rd = 9 + 2 * q;
                            o0[q] = pk2(xs[32 * mt + (ra & 3) + 8 * (ra >> 2) + 4 * hi], xs[32 * mt + (rb & 3) + 8 * (rb >> 2) + 4 * hi]);
                            o1[q] = pk2(xs[32 * mt + (rc & 3) + 8 * (rc >> 2) + 4 * hi], xs[32 * mt + (rd & 3) + 8 * (rd >> 2) + 4 * hi]); }
                        bf16* dst = U + ((mt * 2 + et) * 64 + r32 + 32 * hi) * 16; *(v4u*)dst = o0; *(v4u*)(dst + 8) = o1; }
            } else {
                bf16* W = (bf16*)(C.ws + WS_W) + (size_t)blk * 4096; const int d = col - 64;
#pragma unroll
                for (int il = 0; il < 64; ++il) W[il * 64 + d] = (bf16)(pk2(xs[il], 0.f) & 0xffffu);
            }
        } else {
            const int t2 = tidl - 256;
            for (int idx = t2; idx < 2 * 64 * 8; idx += 256) {
                const int d8 = idx & 7, il = (idx >> 3) & 63, dir = idx >> 9;
                const int it = dir ? 63 - il : il; const LAS float* s = qkv + it * P + d8 * 8; const float f = 0.125f * sm[512 + dir * 64 + il];
                v4u o; o.x = pk2(s[0] * f, s[1] * f); o.y = pk2(s[2] * f, s[3] * f); o.z = pk2(s[4] * f, s[5] * f); o.w = pk2(s[6] * f, s[7] * f);
                *(v4u*)((bf16*)(C.ws + WS_QS) + (size_t)(dir ? blk1 : blk0) * 4096 + il * 64 + d8 * 8) = o;
            }
            for (int idx = t2; idx < 2 * 64 * 8; idx += 256) {
                const int i8 = idx & 7, d = (idx >> 3) & 63, dir = idx >> 9; const float gl = Gs[dir * 64 + 63];
                float v[8];
#pragma unroll
                for (int j = 0; j < 8; ++j) { const int il = i8 * 8 + j, it = dir ? 63 - il : il; v[j] = qkv[(64 + it) * P + d] * sm[640 + dir * 64 + il]; }
                v4u o; o.x = pk2(v[0], v[1]); o.y = pk2(v[2], v[3]); o.z = pk2(v[4], v[5]); o.w = pk2(v[6], v[7]);
                *(v4u*)((bf16*)(C.ws + WS_KT) + (size_t)(dir ? blk1 : blk0) * 4096 + d * 64 + i8 * 8) = o;
            }
            for (int idx = t2; idx < 2 * 3 * 64 * 2; idx += 256) {
                const int half = idx & 1, ln = (idx >> 1) & 63, tt = (idx >> 7) % 3, dir = (idx >> 7) / 3;
                const int mt = (tt == 2) ? 1 : 0, itl = (tt == 0) ? 0 : 1, r32 = ln & 31, hi = ln >> 5, il = r32 + 32 * itl, itok = dir ? 63 - il : il;
                const float gi = Gs[dir * 64 + il];
                float v[8];
#pragma unroll
                for (int j = 0; j < 8; ++j) { const int r = 8 * half + j, ml = (r & 3) + 8 * (r >> 2) + 4 * hi + 32 * mt, mtok = dir ? 63 - ml : ml;
                    v[j] = (il >= ml) ? 0.125f * QK[itok * P + mtok] * __expf(gi - Gs[dir * 64 + ml]) : 0.f; }
                v4u o; o.x = pk2(v[0], v[1]); o.y = pk2(v[2], v[3]); o.z = pk2(v[4], v[5]); o.w = pk2(v[6], v[7]);
                *(v4u*)((bf16*)(C.ws + WS_KS) + (size_t)(dir ? blk1 : blk0) * 4096 + ((mt * 2 + itl) * 64 + ln) * 16 + 8 * half) = o;
            }
            if (t2 < 2) ((float*)(C.ws + WS_GS))[t2 ? blk1 : blk0] = __expf(Gs[t2 * 64 + 63]);
            { constexpr int PER_TASK = (MG * 22 * 4) / 1024; const int tslot = (task - C.vcu) / C.G; const int beg = (C.vcu * 4 + tslot) * PER_TASK; rope_span(C, beg, beg + PER_TASK, t2, 256); }
        }
    }
    __syncthreads();
}

#define DN_BAR() asm volatile("s_waitcnt lgkmcnt(0)\n\ts_barrier" ::: "memory")
#define LDG(T, base, off) (*(const GAS T*)((const GAS char*)(base) + (off)))
__device__ __forceinline__ void dn_chain(Ctx& C, int ch) {
    constexpr int SP = 72, IMG = 64 * SP;
    LAS bf16* STb = (LAS bf16*)C.lds; LAS v4u* VN = (LAS v4u*)(C.lds + 3 * IMG * 2);
    const int lane = C.lane, r32 = lane & 31, hi = lane >> 5, w = C.wave, wl = w & 3;
    const int dir = ch >> 3, seq = (ch >> 2) & 1, h = ch & 3;
    const GAS bf16* QD = (const GAS bf16*)(C.ws + WS_QS) + (size_t)ch * 128 * 4096; const GAS bf16* AT = (const GAS bf16*)(C.ws + WS_KS) + (size_t)ch * 128 * 4096;
    const GAS bf16* KT = (const GAS bf16*)(C.ws + WS_KT) + (size_t)ch * 128 * 4096; const GAS bf16* UU = (const GAS bf16*)(C.ws + WS_U) + (size_t)ch * 128 * 4096;
    const GAS bf16* WW = (const GAS bf16*)(C.ws + WS_W) + (size_t)ch * 128 * 4096; const GAS float* GL = (const GAS float*)(C.ws + WS_GS) + (size_t)ch * 128;
    GAS float* ODN = (GAS float*)(C.ws + WS_ODN) + (size_t)dir * MG * 256;
    __syncthreads();
    for (int e = C.tid; e < 3 * IMG / 2; e += NTHR) ((LAS unsigned*)STb)[e] = 0u;
    __syncthreads();
    if (w < 4) {
        const int et = wl >> 1, dt = wl & 1;
        f32x16 ST = f32x16{};
        bf16x8 wA0[2][4], kB0[2][2], wA1[2][4], kB1[2][2]; v4u uu0[2][2], uu1[2][2]; float gam0, gam1;
        const unsigned off_w0 = (unsigned)((r32 * 64 + 8 * hi) * 2), off_u0 = (unsigned)((et * 64 + lane) * 32), off_kt = (unsigned)(((r32 + 32 * dt) * 64 + 4 * hi) * 2);
#define CH_LOAD(n_, wA, kB, uu, gam) do { const GAS bf16* Wb = WW + (size_t)(n_) * 4096; const GAS bf16* Ub = UU + (size_t)(n_) * 4096; const GAS bf16* KTb = KT + (size_t)(n_) * 4096; \
            _Pragma("unroll") for (int mt = 0; mt < 2; ++mt) { \
                _Pragma("unroll") for (int kk = 0; kk < 4; ++kk) wA[mt][kk] = LDG(bf16x8, Wb, off_w0 + (unsigned)(mt * 4096 + kk * 32)); \
                uu[mt][0] = LDG(v4u, Ub, off_u0 + (unsigned)(mt * 4096)); uu[mt][1] = LDG(v4u, Ub, off_u0 + (unsigned)(mt * 4096 + 16)); \
                _Pragma("unroll") for (int s = 0; s < 2; ++s) { const v2u lo = LDG(v2u, KTb, off_kt + (unsigned)((32 * mt + 16 * s) * 2)), hh = LDG(v2u, KTb, off_kt + (unsigned)((32 * mt + 16 * s + 8) * 2)); \
                    kB[mt][s] = __builtin_bit_cast(bf16x8, (v4u){lo.x, lo.y, hh.x, hh.y}); } } \
            gam = GL[n_]; } while (0)
#define CH_STEP(n_, wA, kB, uu, gam) do { \
            const int c3 = (n_) % 3, x3 = (c3 == 2) ? 0 : c3 + 1; \
            bf16x8 sB[4]; \
            _Pragma("unroll") for (int kk = 0; kk < 4; ++kk) sB[kk] = *(const LAS bf16x8*)(STb + c3 * IMG + (r32 + 32 * et) * SP + 16 * kk + 8 * hi); \
            f32x16 ws0 = f32x16{}, ws1 = f32x16{}; \
            _Pragma("unroll") for (int kk = 0; kk < 4; ++kk) { ws0 = MFMA32(wA[0][kk], sB[kk], ws0); ws1 = MFMA32(wA[1][kk], sB[kk], ws1); } \
            _Pragma("unroll") for (int r = 0; r < 16; ++r) { \
                const float u0 = (r & 1) ? __uint_as_float(uu[0][r >> 3][(r >> 1) & 3] & 0xffff0000u) : __uint_as_float(uu[0][r >> 3][(r >> 1) & 3] << 16); \
                const float u1 = (r & 1) ? __uint_as_float(uu[1][r >> 3][(r >> 1) & 3] & 0xffff0000u) : __uint_as_float(uu[1][r >> 3][(r >> 1) & 3] << 16); \
                ws0[r] = u0 - ws0[r]; ws1[r] = u1 - ws1[r]; ST[r] *= gam; } \
            const bf16x8 p00 = pack8(ws0, 0), p01 = pack8(ws0, 1), p10 = pack8(ws1, 0), p11 = pack8(ws1, 1); \
            { LAS v4u* vn = VN + ((((n_) & 1) * 2 + et) * 4) * 64 + lane; vn[0] = __builtin_bit_cast(v4u, p00); vn[64] = __builtin_bit_cast(v4u, p01); vn[128] = __builtin_bit_cast(v4u, p10); vn[192] = __builtin_bit_cast(v4u, p11); } \
            ST = MFMA32(p00, kB[0][0], ST); ST = MFMA32(p10, kB[1][0], ST); ST = MFMA32(p01, kB[0][1], ST); ST = MFMA32(p11, kB[1][1], ST); \
            LAS bf16* dst = STb + x3 * IMG + (32 * et) * SP + r32 + 32 * dt; \
            _Pragma("unroll") for (int r = 0; r < 16; ++r) dst[crow(r, hi) * SP] = (bf16)(pk2(ST[r], 0.f) & 0xffffu); \
            DN_BAR(); } while (0)
        CH_LOAD(0, wA0, kB0, uu0, gam0);
        for (int n = 0; n < 128; n += 2) {
            CH_LOAD(n + 1, wA1, kB1, uu1, gam1);
            CH_STEP(n, wA0, kB0, uu0, gam0);
            CH_LOAD((n + 2 < 128) ? n + 2 : 127, wA0, kB0, uu0, gam0);
            CH_STEP(n + 1, wA1, kB1, uu1, gam1);
        }
        DN_BAR();
#undef CH_LOAD
#undef CH_STEP
    } else {
        const int it = wl >> 1, et = wl & 1;
        bf16x8 qA0[4], qA1[4]; v4u at0[2][2], at1[2][2];
        const unsigned off_q = (unsigned)(((r32 + 32 * it) * 64 + 8 * hi) * 2), off_at0 = (unsigned)((it * 64 + lane) * 32);
#define OW_LOAD(n_, qA, at) do { const GAS bf16* Qb = QD + (size_t)(n_) * 4096; const GAS bf16* Ab = AT + (size_t)(n_) * 4096; \
            _Pragma("unroll") for (int kk = 0; kk < 4; ++kk) qA[kk] = LDG(bf16x8, Qb, off_q + (unsigned)(kk * 32)); \
            _Pragma("unroll") for (int mt = 0; mt < 2; ++mt) { if (mt <= it) { at[mt][0] = LDG(v4u, Ab, off_at0 + (unsigned)(mt * 4096)); at[mt][1] = LDG(v4u, Ab, off_at0 + (unsigned)(mt * 4096 + 16)); } } } while (0)
#define OW_STEP(n_, qA, at) do { \
            const int c3 = (n_) % 3; \
            bf16x8 sB[4]; \
            _Pragma("unroll") for (int kk = 0; kk < 4; ++kk) sB[kk] = *(const LAS bf16x8*)(STb + c3 * IMG + (r32 + 32 * et) * SP + 16 * kk + 8 * hi); \
            const LAS v4u* vn = VN + ((((n_) & 1) * 2 + et) * 4) * 64 + lane; \
            f32x16 o = f32x16{}; \
            _Pragma("unroll") for (int kk = 0; kk < 4; ++kk) o = MFMA32(qA[kk], sB[kk], o); \
            _Pragma("unroll") for (int mt = 0; mt < 2; ++mt) { if (mt <= it) { \
                _Pragma("unroll") for (int s = 0; s < 2; ++s) o = MFMA32(__builtin_bit_cast(bf16x8, at[mt][s]), __builtin_bit_cast(bf16x8, vn[(mt * 2 + s) * 64]), o); } } \
            _Pragma("unroll") for (int r = 0; r < 16; ++r) { const int sr = (n_) * 64 + 32 * it + crow(r, hi), t = dir ? (SEQ - 1 - sr) : sr; \
                ODN[(size_t)(seq * SEQ + t) * 256 + h * 64 + 32 * et + r32] = o[r]; } \
            DN_BAR(); } while (0)
        OW_LOAD(0, qA0, at0);
        DN_BAR();
        for (int n = 0; n < 128; n += 2) {
            OW_LOAD(n + 1, qA1, at1);
            OW_STEP(n, qA0, at0);
            OW_LOAD((n + 2 < 128) ? n + 2 : 127, qA0, at0);
            OW_STEP(n + 1, qA1, at1);
        }
#undef OW_LOAD
#undef OW_STEP
    }
    __syncthreads();
}
#undef LDG
__device__ __forceinline__ void phase_finalize(Ctx& C, int li, const float* dn_norm_w, const float* diff_lambda, const float* diff_norm_w) {
    const int gw = C.vcu * NWAVES + C.wave, NGW = C.G * NWAVES, lane = C.lane;
    const float lam_init = 0.8f - 0.6f * __expf(-0.3f * (float)li);
    const float d1 = wave_sum(diff_lambda[lane] * diff_lambda[64 + lane], lane), d2 = wave_sum(diff_lambda[128 + lane] * diff_lambda[192 + lane], lane);
    const float lam = __expf(d1) - __expf(d2) + lam_init;
    const f32x4 nwd = *(const f32x4*)(dn_norm_w + (4 * lane & 63));
    const f32x4 nf0 = *(const f32x4*)(diff_norm_w + (8 * lane & 127)), nf1 = *(const f32x4*)(diff_norm_w + (8 * lane & 127) + 4);
    const float* of = (const float*)(C.ws + WS_ODN); const float* ob = of + (size_t)MG * 256;
    const bf16* zb = (const bf16*)(C.ws + WS_Z); const bf16* odf = (const bf16*)(C.ws + WS_ODF); bf16* mix = (bf16*)(C.ws + WS_MIX);
    const int hh_ = lane >> 4, e0_ = 8 * (lane & 15);
    f32x4 na = *(const f32x4*)(of + (size_t)gw * 256 + 4 * lane), nb = *(const f32x4*)(ob + (size_t)gw * 256 + 4 * lane); v2u nz = *(const v2u*)(zb + (size_t)gw * 256 + 4 * lane);
    v4u nda = *(const v4u*)(odf + (size_t)gw * 1024 + hh_ * 256 + e0_), ndb = *(const v4u*)(odf + (size_t)gw * 1024 + hh_ * 256 + 128 + e0_);
    for (int m = gw; m < MG; m += NGW) {
        const f32x4 ca = na, cb = nb; const v2u cz = nz; const v4u cda = nda, cdb = ndb;
        { const int mn = (m + NGW < MG) ? m + NGW : m;
          na = *(const f32x4*)(of + (size_t)mn * 256 + 4 * lane); nb = *(const f32x4*)(ob + (size_t)mn * 256 + 4 * lane); nz = *(const v2u*)(zb + (size_t)mn * 256 + 4 * lane);
          nda = *(const v4u*)(odf + (size_t)mn * 1024 + hh_ * 256 + e0_); ndb = *(const v4u*)(odf + (size_t)mn * 1024 + hh_ * 256 + 128 + e0_); }
        {
            const f32x4 a = ca, b = cb;
            const f32x4 o = a + b; float s = (o.x * o.x + o.y * o.y) + (o.z * o.z + o.w * o.w);
            s += shx(s, 1, lane); s += shx(s, 2, lane); s += shx(s, 4, lane); s += shx(s, 8, lane);
            const float rstd = 1.f / sqrtf(s * (1.f / 64.f) + EPS);
            const v2u zz = cz;
            const float z0 = __uint_as_float(zz.x << 16), z1 = __uint_as_float(zz.x & 0xffff0000u), z2 = __uint_as_float(zz.y << 16), z3 = __uint_as_float(zz.y & 0xffff0000u);
            v2u w; w.x = pk2(o.x * rstd * nwd.x * (z0 / (1.f + __expf(-z0))), o.y * rstd * nwd.y * (z1 / (1.f + __expf(-z1))));
            w.y = pk2(o.z * rstd * nwd.z * (z2 / (1.f + __expf(-z2))), o.w * rstd * nwd.w * (z3 / (1.f + __expf(-z3))));
            *(v2u*)(mix + (size_t)m * 1024 + 4 * lane) = w;
        }
        {
            const int hh = lane >> 4, e0 = 8 * (lane & 15);
            v4u a = cda; const v4u b = cdb;
            if (hh == 0 && m < SEQ) {
                const int cc = e0 >> 6; const bf16* po = (const bf16*)(C.ws + WS_PO); const float* ps = (const float*)(C.ws + WS_PS);
                float mp[4], lp[4]; v4u pp[4]; float mm = -INFINITY;
#pragma unroll
                for (int p = 0; p < 4; ++p) { pp[p] = *(const v4u*)(po + ((size_t)(p * 2 + cc) * SEQ + m) * 64 + (e0 & 63)); mp[p] = ps[((size_t)(p * 2 + cc) * SEQ + m) * 2]; lp[p] = ps[((size_t)(p * 2 + cc) * SEQ + m) * 2 + 1]; mm = fmaxf(mm, mp[p]); }
                float wsum = 0.f;
#pragma unroll
                for (int p = 0; p < 4; ++p) { lp[p] *= __builtin_amdgcn_exp2f(mp[p] - mm); wsum += lp[p]; }
                const float inv = 1.f / wsum;
#pragma unroll
                for (int w = 0; w < 4; ++w) { float lo = 0.f, hi_ = 0.f;
#pragma unroll
                    for (int p = 0; p < 4; ++p) { lo += lp[p] * __uint_as_float(pp[p][w] << 16); hi_ += lp[p] * __uint_as_float(pp[p][w] & 0xffff0000u); }
                    a[w] = pk2(lo * inv, hi_ * inv); }
            }
            float o[8]; float s = 0.f;
#pragma unroll
            for (int w = 0; w < 4; ++w) { o[2 * w] = __uint_as_float(a[w] << 16) - lam * __uint_as_float(b[w] << 16); o[2 * w + 1] = __uint_as_float(a[w] & 0xffff0000u) - lam * __uint_as_float(b[w] & 0xffff0000u);
                s += o[2 * w] * o[2 * w] + o[2 * w + 1] * o[2 * w + 1]; }
            s += shx(s, 1, lane); s += shx(s, 2, lane); s += shx(s, 4, lane); s += shx(s, 8, lane);
            const float sc = (1.f - lam_init) / sqrtf(s * (1.f / 128.f) + EPS);
            v4u w; w.x = pk2(o[0] * sc * nf0.x, o[1] * sc * nf0.y); w.y = pk2(o[2] * sc * nf0.z, o[3] * sc * nf0.w); w.z = pk2(o[4] * sc * nf1.x, o[5] * sc * nf1.y); w.w = pk2(o[6] * sc * nf1.z, o[7] * sc * nf1.w);
            *(v4u*)(mix + (size_t)m * 1024 + 256 + 8 * lane) = w;
        }
    }
}

struct Args { const float* in[16]; float* out; unsigned char* ws; };
__device__ __forceinline__ const float* ldarg(int k) { const Args* p = (const Args*)__builtin_amdgcn_kernarg_segment_ptr(); asm volatile("" : "+s"(p)); return p->in[k]; }
__device__ __forceinline__ float* ldout() { const Args* p = (const Args*)__builtin_amdgcn_kernarg_segment_ptr(); asm volatile("" : "+s"(p)); return p->out; }
__device__ __forceinline__ unsigned char* ldws() { const Args* p = (const Args*)__builtin_amdgcn_kernarg_segment_ptr(); asm volatile("" : "+s"(p)); return p->ws; }
__device__ __forceinline__ void refresh(Ctx& C, unsigned char* ldsp) {
    int t = threadIdx.x; asm volatile("" : "+v"(t));
    int bx = blockIdx.x; asm volatile("" : "+s"(bx));
    int G = gridDim.x; asm volatile("" : "+s"(G));
    unsigned lo = (unsigned)(uintptr_t)ldsp; asm volatile("" : "+s"(lo));
    C.lds = (LAS unsigned char*)(uintptr_t)lo; C.ldsg = ldsp; C.tid = t; C.lane = t & 63; C.wave = __builtin_amdgcn_readfirstlane(t >> 6);
    C.G = G; C.vcu = (G % 8 == 0) ? (bx % 8) * (G / 8) + bx / 8 : bx; C.bx = bx;
    C.ws = ldws();
}
#define RF() refresh(C, lds)
#define GSYNC() do { RF(); XcdBarrier b_; b_.bar = (unsigned*)C.ws; b_.x = xb_xcc_id(); b_.st = (volatile LAS unsigned*)(C.lds + 131424); xcd_barrier(b_); } while (0)
__global__ void __launch_bounds__(NTHR, 2) hybrid_fwd(Args args) {
    extern __shared__ __attribute__((aligned(16))) unsigned char lds[];
    cg::grid_group grid = cg::this_grid();
    Ctx C; RF();
    if (C.tid < 2) ((volatile LAS unsigned*)(C.lds + 131424))[C.tid] = 0u;
    __syncthreads();
    if (C.tid == 0) (void)xb_add(&((unsigned*)C.ws)[XB_XCNT(xb_xcc_id())], 1u);
#define ARGP(k) (ldarg(k))
#define x_prompt ARGP(0)
#define x_sample ARGP(1)
#define norm1_w ARGP(2)
#define w_in ARGP(3)
#define conv_w ARGP(4)
#define a_log ARGP(5)
#define dt_bias ARGP(6)
#define dn_norm_w ARGP(7)
#define diff_lambda ARGP(8)
#define diff_norm_w ARGP(9)
#define swa_sink ARGP(10)
#define w_out ARGP(11)
#define norm2_w ARGP(12)
#define w_up ARGP(13)
#define w_dn ARGP(14)
#define final_w ARGP(15)
#define HN ((bf16*)(C.ws + WS_HN))
#define MIX ((bf16*)(C.ws + WS_MIX))
#define HID ((bf16*)(C.ws + WS_HID))
    phase_prologue(C, w_in, w_out, w_up, w_dn, norm2_w, norm1_w);
    RF();
    phase_norm<false>(C, x_prompt, norm1_w, HN, nullptr, nullptr);
    grid.sync();
    for (int g = 0; g < NGRP; ++g) {
#define xo (ldout() + (size_t)g * MG * DMODEL)
        for (int li = 0; li < DEPTH; ++li) {
#define xcur (li ? (const float*)xo : ((g < 2) ? x_prompt + (size_t)g * MG * DMODEL : x_sample))
            RF();
            if (li == 0 && g > 0) { phase_norm<false>(C, xcur, norm1_w, HN, nullptr, nullptr); GSYNC(); }
            RF();
            { pg8::Gemm gm{HN, (const bf16*)(C.ws + WS_WIN) + (size_t)li * NPROJ * DMODEL, MG, NPROJ, DMODEL}; pg8::StaticOrder S; S.init(MG, NPROJ, C.G, C.bx);
              phase_logits(C, HN, (const bf16*)(C.ws + WS_WL) + (size_t)li * 32 * DMODEL, li ? (const float*)(C.ws + WS_SS2) : nullptr, (float*)(C.ws + WS_BG));
              pg8::EpiProj E{C.ws, li ? (const float*)(C.ws + WS_SS2) : nullptr};
              pg8::gemm_phase<pg8::EpiProj, pg8::StaticOrder, true, true>(C.lds, gm, S, E); }
            GSYNC();
            RF();
            RF();
#ifndef NO_PREP
            phase_dn_prep(C, conv_w + (size_t)li * 5 * 768, a_log + li * 8, dt_bias + li * 8);
#endif
            GSYNC();
            RF();
            {
#ifndef NO_CHAIN
                if (C.vcu < 16) dn_chain(C, C.vcu);
#endif
                __syncthreads(); RF();
                using abf = attn_body::bf16;
                {
                    const int nun = (C.vcu < 16) ? 0 : 4;
                    for (int i = 0; i < nun; ++i) {
                        const int bh = C.vcu >> 3, s = C.vcu & 7, b = bh >> 4, vh = bh & 15, h = vh >> 2, j = (vh >> 1) & 1, c = vh & 1;
                        const abf* Qb = (const abf*)(C.ws + WS_DFQ) + (size_t)b * SEQ * 512 + h * 128 + j * 64;
                        const abf* Kb = (const abf*)(C.ws + WS_DFK) + (size_t)b * SEQ * 512 + h * 128 + j * 64;
                        const abf* Vb = (const abf*)(C.ws + WS_DFV) + (size_t)b * SEQ * 512 + h * 128 + c * 64;
                        abf* Ob = (abf*)(C.ws + WS_ODF) + (size_t)b * SEQ * 1024 + h * 256 + j * 128 + c * 64;
                        const int qb = (i == 0) ? s : (i == 1) ? 15 - s : (i == 2) ? 16 + s : 31 - s;
                        attn_body::attn_unit<8, 0>(Qb, 512, Kb, 512, Vb, 512, Ob, 1024, qb * 256, 0.f, (char*)C.ldsg, 0, nullptr, i > 0, i + 1 < nun); }
                    {
                        RF();
                        const int qu = (C.vcu < 16) ? 240 + C.vcu : C.vcu - 16, part = qu & 3, un = qu >> 2, v2 = un & 15, i2 = un >> 4, s = v2 & 7, c = v2 >> 3;
                        const int qb = (i2 == 0) ? s : (i2 == 1) ? 15 - s : (i2 == 2) ? 16 + s : 31 - s;
                        const abf* Qb = (const abf*)(C.ws + WS_DFQ); const abf* Kb = (const abf*)(C.ws + WS_DFK); const abf* Vb = (const abf*)(C.ws + WS_DFV) + c * 64;
                        abf* Ob = (abf*)(C.ws + WS_PO) + (size_t)(part * 2 + c) * SEQ * 64;
                        attn_body::attn_unit<8, 2>(Qb, 512, Kb, 512, Vb, 512, Ob, 64, qb * 256, 0.f, (char*)C.ldsg, part * (SEQ / 4), (float*)(C.ws + WS_PS) + (size_t)(part * 2 + c) * SEQ * 2);
                    }
                }
                RF();
                {
                    const int nsw = 1;
                    for (int i = 0; i < nsw; ++i) {
                        const int un = C.vcu;
                        const int b = un >> 7, h = (un >> 5) & 3, qb = un & 31;
                        const abf* Qb = (const abf*)(C.ws + WS_SWQ) + (size_t)b * SEQ * 256 + h * 64;
                        const abf* Kb = (const abf*)(C.ws + WS_SWKV) + (size_t)b * SEQ * 256 + (h >> 1) * 64;
                        const abf* Vb = (const abf*)(C.ws + WS_SWKV) + (size_t)b * SEQ * 256 + 128 + (h >> 1) * 64;
                        abf* Ob = (abf*)(C.ws + WS_MIX) + (size_t)b * SEQ * 1024 + 768 + h * 64;
                        attn_body::attn_unit<8, 1>(Qb, 256, Kb, 256, Vb, 256, Ob, 1024, qb * 256, swa_sink[li * 4 + h] * LOG2E, (char*)C.ldsg);
                    }
                }
            }
            GSYNC();
            RF();
            phase_finalize(C, li, dn_norm_w + li * 64, diff_lambda + li * 256, diff_norm_w + li * 128);
            GSYNC();
            RF();
            { pg8::Gemm gm{MIX, (const bf16*)(C.ws + WS_WOUT) + (size_t)li * DMODEL * DMODEL, MG, DMODEL, DMODEL}; pg8::StaticOrder S; S.init(MG, DMODEL, C.G, C.bx);
              pg8::EpiRes E{li ? nullptr : xcur, li ? (const bf16*)HN : nullptr, nullptr, HN, (float*)(C.ws + WS_SS)};
              pg8::gemm_phase<pg8::EpiRes, pg8::StaticOrder, true, true>(C.lds, gm, S, E); }
            GSYNC();
            RF();
            { pg8::Gemm gm{HN, (const bf16*)(C.ws + WS_WUP) + (size_t)li * DFF * DMODEL, MG, DFF, DMODEL}; pg8::StaticOrder S; S.init(MG, DFF, C.G, C.bx);
              pg8::EpiRelu2S E{HID, (const float*)(C.ws + WS_SS), DFF};
              pg8::gemm_phase<pg8::EpiRelu2S, pg8::StaticOrder, true, true>(C.lds, gm, S, E); }
            GSYNC();
            RF();
            { pg8::Gemm gm{HID, (const bf16*)(C.ws + WS_WDN) + (size_t)li * DMODEL * DFF, MG, DMODEL, DFF}; pg8::StaticOrder S; S.init(MG, DMODEL, C.G, C.bx);
              pg8::EpiRes E{nullptr, HN, li ? xo : nullptr, li ? nullptr : HN, li ? nullptr : (float*)(C.ws + WS_SS2)};
              pg8::gemm_phase<pg8::EpiRes, pg8::StaticOrder, true, true>(C.lds, gm, S, E); }
            GSYNC();
        }
        RF();
        phase_final_norm(C, xo, final_w);
    }
}

extern "C" void kernel_launch(void* const* d_in, const int* in_sizes, int n_in, void* d_out, int out_size, void* d_ws, size_t ws_size, hipStream_t stream) {
    static int grid = 0;
    if (grid == 0) {
        if (n_in != 16 || ws_size < 498 * MiB) { fprintf(stderr, "kernel_launch: unexpected inputs (n_in %d, ws %zu)\n", n_in, ws_size); grid = -1; return; }
        int dev = 0, cus = 0, per_cu = 0;
        hipGetDevice(&dev); hipDeviceGetAttribute(&cus, hipDeviceAttributeMultiprocessorCount, dev);
        if (hipFuncSetAttribute((const void*)hybrid_fwd, hipFuncAttributeMaxDynamicSharedMemorySize, LDS_BYTES) != hipSuccess) { fprintf(stderr, "kernel_launch: hipFuncSetAttribute failed\n"); grid = -1; return; }
        hipOccupancyMaxActiveBlocksPerMultiprocessor(&per_cu, (const void*)hybrid_fwd, NTHR, LDS_BYTES);
        (void)hipGetLastError();
        if (per_cu < 1) per_cu = 1;
        grid = cus;
        if (grid != 256) fprintf(stderr, "kernel_launch: %d CUs (built for 256)\n", grid);
    }
    if (grid < 0) return;
    if (hipMemsetAsync(d_ws, 0, 65536, stream) != hipSuccess) { fprintf(stderr, "kernel_launch: hipMemsetAsync failed\n"); return; }
    Args a{};
    for (int i = 0; i < 16; ++i) a.in[i] = (const float*)d_in[i];
    a.out = (float*)d_out; a.ws = (unsigned char*)d_ws;
    void* kargs[] = {&a};
    hipError_t e = hipLaunchCooperativeKernel((const void*)hybrid_fwd, dim3(grid), dim3(NTHR), kargs, LDS_BYTES, stream);
    if (e != hipSuccess) fprintf(stderr, "cooperative launch failed: %s (grid %d)\n", hipGetErrorString(e), grid);
}
```

```cpp
#include <hip/hip_runtime.h>
#include <cstdio>
#include <cstdint>
namespace pg8 {
#define PG8_LAS __attribute__((address_space(3)))
typedef unsigned short bf16_t;
typedef short bf16x8 __attribute__((ext_vector_type(8)));
typedef float f32x4 __attribute__((ext_vector_type(4)));
typedef unsigned u32x4 __attribute__((ext_vector_type(4)));
constexpr int BM = 256, BK = 64, HALF = 128, HTB = HALF * BK * 2  , STAGE_BYTES = 8 * HTB, NXCD = 8, WGM = 4;

__host__ __device__ __forceinline__ int lds_byte(int r, int c) { const int st = (r >> 4) * 2 + (c >> 5), rr = r & 15, cc = c & 31, ob = rr * 64 + cc * 2; return st * 1024 + (ob ^ (((ob >> 9) & 1) << 5)); }
__host__ __device__ __forceinline__ void stage_rc(int b, int& R, int& C) { const int st = b / 1024, sb = b % 1024, swz = sb ^ (((sb >> 9) & 1) << 5); R = (st >> 1) * 16 + swz / 64; C = (st & 1) * 32 + (swz % 64) / 2; }
__host__ __device__ __forceinline__ int perm32(int rho) { const int n = rho >> 4, i = rho & 15; return 8 * (i >> 2) + 4 * n + (i & 3); }

struct Unit { int pm, pn; };
struct Gemm { const bf16_t* A; const bf16_t* Bt; int M, N, K; };

struct StaticOrder {
    int nM, nN, nwg, G, c;
    __host__ __device__ void init(int M, int N, int G_, int c_) { nM = M / BM; nN = N / BM; nwg = nM * nN; G = G_; c = c_; }
    __host__ __device__ bool next(int i, Unit& u) const {
        const long L = (long)i * G + c; if (L >= nwg) return false;
        int wgid = (int)L; { const int q = nwg / NXCD, r = nwg % NXCD, xcd = wgid % NXCD, off = wgid / NXCD; wgid = (xcd < r ? xcd * (q + 1) : r * (q + 1) + (xcd - r) * q) + off; }
        const int nig = WGM * nN, gid = wgid / nig, fm = gid * WGM, gsz = (nM - fm) < WGM ? (nM - fm) : WGM;
        u.pm = fm + ((wgid % nig) % gsz); u.pn = (wgid % nig) / gsz; return true;
    }
    __device__ __forceinline__ void a_ready(const Unit&) const {}
    __device__ __forceinline__ void done(const Unit&) const {}
};

__device__ __forceinline__ unsigned cvt_pk_bf16(float lo, float hi) { unsigned r; asm volatile("v_cvt_pk_bf16_f32 %0, %1, %2" : "=v"(r) : "v"(lo), "v"(hi)); return r; }

__device__ __forceinline__ float row_rstd(const float* ss, int row) {
    const f32x4* p = (const f32x4*)(ss + (size_t)row * 16); const f32x4 a = p[0], b = p[1], c = p[2], d = p[3];
    const float t = (((a[0] + a[1]) + (a[2] + a[3])) + ((b[0] + b[1]) + (b[2] + b[3]))) + (((c[0] + c[1]) + (c[2] + c[3])) + ((d[0] + d[1]) + (d[2] + d[3])));
    return 1.0f / sqrtf(t * (1.0f / 1024.0f) + 1e-6f);
}
struct EpiProj {
    static constexpr bool PERM = true, AFTER_DRAIN = false;
    unsigned char* ws;
    const float* ss;
    __device__ __forceinline__ void operator()(const f32x4 (&acc)[2][2][4][2], const Unit& u, int wr, int wc, int fr, int fq) const {
        const int row0 = u.pm * BM + wr * 64 + fr; const int pn = u.pn;
        size_t boff; int ldc, colt;
        if (pn < 3) { boff = (size_t)84 << 20; ldc = 768; colt = pn * 256; }
        else if (pn == 3) { boff = (size_t)108 << 20; ldc = 256; colt = 0; }
        else if (pn < 6) { boff = (size_t)116 << 20; ldc = 512; colt = (pn - 4) * 256; }
        else if (pn < 8) { boff = (size_t)132 << 20; ldc = 512; colt = (pn - 6) * 256; }
        else if (pn < 10) { boff = (size_t)148 << 20; ldc = 512; colt = (pn - 8) * 256; }
        else if (pn == 10) { boff = (size_t)164 << 20; ldc = 256; colt = 0; }
        else { boff = (size_t)172 << 20; ldc = 256; colt = 0; }
        bf16_t* base = (bf16_t*)(ws + boff);
        const int col0 = colt + wc * 32 + 8 * fq;
#pragma unroll
        for (int ai = 0; ai < 2; ++ai)
#pragma unroll
            for (int m = 0; m < 4; ++m) { const int row = row0 + ai * HALF + m * 16; bf16_t* rowp = base + (size_t)row * ldc + col0;
                const float rs = ss ? row_rstd(ss, row) : 1.0f;
#pragma unroll
                for (int bj = 0; bj < 2; ++bj) { const f32x4 v0 = acc[ai][bj][m][0] * rs, v1 = acc[ai][bj][m][1] * rs;
                    u32x4 w; w.x = cvt_pk_bf16(v0[0], v0[1]); w.y = cvt_pk_bf16(v0[2], v0[3]); w.z = cvt_pk_bf16(v1[0], v1[1]); w.w = cvt_pk_bf16(v1[2], v1[3]);
                    *(u32x4*)(rowp + bj * HALF) = w; } }
    }
};
struct EpiRelu2 {
    static constexpr bool PERM = true, AFTER_DRAIN = false;
    bf16_t* O; int ldc;
    __device__ __forceinline__ void operator()(const f32x4 (&acc)[2][2][4][2], const Unit& u, int wr, int wc, int fr, int fq) const {
        const int row0 = u.pm * BM + wr * 64 + fr; const int col0 = u.pn * BM + wc * 32 + 8 * fq;
#pragma unroll
        for (int ai = 0; ai < 2; ++ai)
#pragma unroll
            for (int m = 0; m < 4; ++m) { bf16_t* rowp = O + (size_t)(row0 + ai * HALF + m * 16) * ldc + col0;
#pragma unroll
                for (int bj = 0; bj < 2; ++bj) { f32x4 v0 = acc[ai][bj][m][0], v1 = acc[ai][bj][m][1];
#pragma unroll
                    for (int e = 0; e < 4; ++e) { const float a = fmaxf(v0[e], 0.f), b = fmaxf(v1[e], 0.f); v0[e] = a * a; v1[e] = b * b; }
                    u32x4 w; w.x = cvt_pk_bf16(v0[0], v0[1]); w.y = cvt_pk_bf16(v0[2], v0[3]); w.z = cvt_pk_bf16(v1[0], v1[1]); w.w = cvt_pk_bf16(v1[2], v1[3]);
                    *(u32x4*)(rowp + bj * HALF) = w; } }
    }
};
struct EpiResid {
    static constexpr bool PERM = false, AFTER_DRAIN = false;
    const float* base; float* out; int ldc;
    __device__ __forceinline__ void operator()(const f32x4 (&acc)[2][2][4][2], const Unit& u, int wr, int wc, int fr, int fq) const {
        const int col0 = u.pn * BM + wc * 32 + 4 * fq;
#pragma unroll
        for (int ai = 0; ai < 2; ++ai)
#pragma unroll
            for (int m = 0; m < 4; ++m) { const size_t off = (size_t)(u.pm * BM + ai * HALF + wr * 64 + m * 16 + fr) * ldc + col0;
#pragma unroll
                for (int bj = 0; bj < 2; ++bj)
#pragma unroll
                    for (int n = 0; n < 2; ++n) { const f32x4 bs = *(const f32x4*)(base + off + bj * HALF + n * 16); *(f32x4*)(out + off + bj * HALF + n * 16) = bs + acc[ai][bj][m][n]; }  asm volatile("" ::: "memory"); }
    }
};

struct EpiResidN {
    static constexpr bool PERM = false, AFTER_DRAIN = false;
    const float* base; float* out; bf16_t* xb; float* ss; int ldc;
    __device__ __forceinline__ void operator()(const f32x4 (&acc)[2][2][4][2], const Unit& u, int wr, int wc, int fr, int fq) const {
        typedef unsigned u32x2 __attribute__((ext_vector_type(2)));
        const int col0 = u.pn * BM + wc * 32 + 4 * fq, lane = fr + 16 * fq;
#pragma unroll
        for (int ai = 0; ai < 2; ++ai)
#pragma unroll
            for (int m = 0; m < 4; ++m) { const int row = u.pm * BM + ai * HALF + wr * 64 + m * 16 + fr; const size_t off = (size_t)row * ldc + col0; float sq = 0.f;
#pragma unroll
                for (int bj = 0; bj < 2; ++bj)
#pragma unroll
                    for (int n = 0; n < 2; ++n) { const f32x4 bs = *(const f32x4*)(base + off + bj * HALF + n * 16); const f32x4 o = bs + acc[ai][bj][m][n];
                        *(f32x4*)(out + off + bj * HALF + n * 16) = o; sq += (o[0] * o[0] + o[1] * o[1]) + (o[2] * o[2] + o[3] * o[3]);
                        u32x2 w; w.x = cvt_pk_bf16(o[0], o[1]); w.y = cvt_pk_bf16(o[2], o[3]); *(u32x2*)(xb + off + bj * HALF + n * 16) = w; }
                sq += __int_as_float(__builtin_amdgcn_ds_bpermute((lane ^ 16) << 2, __float_as_int(sq))); sq += __int_as_float(__builtin_amdgcn_ds_bpermute((lane ^ 32) << 2, __float_as_int(sq)));
                if (fq == 0) ss[(size_t)row * 16 + u.pn * 4 + wc] = sq;
                asm volatile("" ::: "memory"); }
    }
};
struct EpiRes {
    static constexpr bool PERM = false, AFTER_DRAIN = false;
    const float* basef; const bf16_t* baseb; float* out; bf16_t* xb; float* ss;
    __device__ __forceinline__ void operator()(const f32x4 (&acc)[2][2][4][2], const Unit& u, int wr, int wc, int fr, int fq) const {
        typedef unsigned u32x2 __attribute__((ext_vector_type(2)));
        constexpr int ldc = 1024; const int col0 = u.pn * BM + wc * 32 + 4 * fq, lane = fr + 16 * fq;
#pragma unroll
        for (int ai = 0; ai < 2; ++ai)
#pragma unroll
            for (int m = 0; m < 4; ++m) { const int row = u.pm * BM + ai * HALF + wr * 64 + m * 16 + fr; const size_t off = (size_t)row * ldc + col0; float sq = 0.f;
#pragma unroll
                for (int bj = 0; bj < 2; ++bj)
#pragma unroll
                    for (int n = 0; n < 2; ++n) { const size_t o2 = off + bj * HALF + n * 16; f32x4 bs;
                        if (baseb) { const u32x2 b2 = *(const u32x2*)(baseb + o2); bs = (f32x4){__uint_as_float(b2.x << 16), __uint_as_float(b2.x & 0xffff0000u), __uint_as_float(b2.y << 16), __uint_as_float(b2.y & 0xffff0000u)}; }
                        else bs = *(const f32x4*)(basef + o2);
                        const f32x4 o = bs + acc[ai][bj][m][n];
                        if (out) *(f32x4*)(out + o2) = o;
                        if (xb) { sq += (o[0] * o[0] + o[1] * o[1]) + (o[2] * o[2] + o[3] * o[3]); u32x2 w; w.x = cvt_pk_bf16(o[0], o[1]); w.y = cvt_pk_bf16(o[2], o[3]); *(u32x2*)(xb + o2) = w; } }
                if (xb) { sq += __int_as_float(__builtin_amdgcn_ds_bpermute((lane ^ 16) << 2, __float_as_int(sq))); sq += __int_as_float(__builtin_amdgcn_ds_bpermute((lane ^ 32) << 2, __float_as_int(sq)));
                    if (fq == 0) ss[(size_t)row * 16 + u.pn * 4 + wc] = sq; }
                asm volatile("" ::: "memory"); }
    }
};
struct EpiRelu2S {
    static constexpr bool PERM = true, AFTER_DRAIN = false;
    bf16_t* O; const float* ss; int ldc;
    __device__ __forceinline__ void operator()(const f32x4 (&acc)[2][2][4][2], const Unit& u, int wr, int wc, int fr, int fq) const {
        const int row0 = u.pm * BM + wr * 64 + fr; const int col0 = u.pn * BM + wc * 32 + 8 * fq;
#pragma unroll
        for (int ai = 0; ai < 2; ++ai)
#pragma unroll
            for (int m = 0; m < 4; ++m) { const int row = row0 + ai * HALF + m * 16; bf16_t* rowp = O + (size_t)row * ldc + col0;
                const float rs = row_rstd(ss, row);
#pragma unroll
                for (int bj = 0; bj < 2; ++bj) { f32x4 v0 = acc[ai][bj][m][0], v1 = acc[ai][bj][m][1];
#pragma unroll
                    for (int e = 0; e < 4; ++e) { const float a = fmaxf(v0[e] * rs, 0.f), b = fmaxf(v1[e] * rs, 0.f); v0[e] = a * a; v1[e] = b * b; }
                    u32x4 w; w.x = cvt_pk_bf16(v0[0], v0[1]); w.y = cvt_pk_bf16(v0[2], v0[3]); w.z = cvt_pk_bf16(v1[0], v1[1]); w.w = cvt_pk_bf16(v1[2], v1[3]);
                    *(u32x4*)(rowp + bj * HALF) = w; } }
    }
};

template <class Epi, class Sched, bool ALIGN_EPI = false, bool SP2 = false>
__device__ __forceinline__ void gemm_phase(PG8_LAS unsigned char* lds, const Gemm g, const Sched& S, const Epi& E) {
    int tid_l = threadIdx.x; asm volatile("" : "+v"(tid_l));
    const int tid = tid_l, wid = __builtin_amdgcn_readfirstlane(tid >> 6), lane = tid & 63, wr = wid >> 2, wc = wid & 3, fr = lane & 15, fq = lane >> 4;
    const int K = g.K, nt = K / BK;
    unsigned voffA[2], voffB[2];
#pragma unroll
    for (int i = 0; i < 2; ++i) { int R, C; stage_rc(tid * 16 + i * 8192, R, C); const int Rb = Epi::PERM ? ((R & ~31) + perm32(R & 31)) : R;
        voffA[i] = (unsigned)(R * K + C) * 2u; voffB[i] = (unsigned)(Rb * K + C) * 2u; }
    const size_t kstep = (size_t)(BK * 2);
    const size_t hstep = (size_t)HALF * K * 2;
    const size_t tstep = 2 * hstep;
    const unsigned ldsw = (unsigned)wid * 1024u;
    const int aoff = lds_byte(wr * 64 + fr, fq * 8), boff = lds_byte(wc * 32 + fr, fq * 8);
#define PG8_SA(b, h) (((b) * 2 + (h)) * HTB)
#define PG8_SB(b, h) ((4 + (b) * 2 + (h)) * HTB)
#define PG8_STAGE(bufoff, gbase, voff) do { _Pragma("unroll") for (int _i = 0; _i < 2; ++_i) \
        __builtin_amdgcn_global_load_lds((const unsigned*)((const char*)(gbase) + (voff)[_i]), (PG8_LAS unsigned*)(lds + (bufoff) + ldsw + _i * 8192), 16, 0, 0); } while (0)
#define PG8_LDA(dst, b, h) do { _Pragma("unroll") for (int m = 0; m < 4; ++m) _Pragma("unroll") for (int k = 0; k < 2; ++k) dst[m][k] = *(const PG8_LAS bf16x8*)(lds + PG8_SA(b, h) + aoff + m * 2048 + k * 1024); } while (0)
#define PG8_LDB(dst, b, h) do { _Pragma("unroll") for (int n = 0; n < 2; ++n) _Pragma("unroll") for (int k = 0; k < 2; ++k) dst[n][k] = *(const PG8_LAS bf16x8*)(lds + PG8_SB(b, h) + boff + n * 2048 + k * 1024); } while (0)
#define PG8_MMA(ai, bj, At, Bt) do { __builtin_amdgcn_s_setprio(1); _Pragma("unroll") for (int m = 0; m < 4; ++m) _Pragma("unroll") for (int n = 0; n < 2; ++n) _Pragma("unroll") for (int k = 0; k < 2; ++k) \
        acc[ai][bj][m][n] = __builtin_amdgcn_mfma_f32_16x16x32_bf16(Bt[n][k], At[m][k], acc[ai][bj][m][n], 0, 0, 0); __builtin_amdgcn_s_setprio(0); } while (0)
#define PG8_WAIT_V(n) asm volatile("s_waitcnt vmcnt(" #n ")" ::: "memory")
#define PG8_WAIT_L(n) asm volatile("s_waitcnt lgkmcnt(" #n ")" ::: "memory")
#define PG8_BAR __builtin_amdgcn_s_barrier()
#define PG8_SCHED __builtin_amdgcn_sched_barrier(0)
    Unit cur, nxt; int ui = 0;
    if (!S.next(0, cur)) return;
    f32x4 acc[2][2][4][2];
#pragma unroll
    for (int a = 0; a < 2; ++a)
#pragma unroll
        for (int b = 0; b < 2; ++b)
#pragma unroll
            for (int m = 0; m < 4; ++m)
#pragma unroll
                for (int n = 0; n < 2; ++n) acc[a][b][m][n] = (f32x4){0.f, 0.f, 0.f, 0.f};
    bf16x8 At[4][2], B0[2][2], B1[2][2];
    const char* cA = (const char*)g.A + (size_t)cur.pm * tstep; const char* cB = (const char*)g.Bt + (size_t)cur.pn * tstep;
    S.a_ready(cur);
    if constexpr (SP2) {
        PG8_STAGE(PG8_SB(0, 0), cB, voffB); PG8_STAGE(PG8_SB(0, 1), cB + hstep, voffB); PG8_STAGE(PG8_SA(0, 0), cA, voffA); PG8_STAGE(PG8_SA(0, 1), cA + hstep, voffA);
        if (wr == 1) PG8_BAR;
        PG8_WAIT_V(2); PG8_BAR;
        PG8_STAGE(PG8_SB(1, 0), cB + kstep, voffB); PG8_STAGE(PG8_SA(1, 0), cA + kstep, voffA); PG8_STAGE(PG8_SB(1, 1), cB + hstep + kstep, voffB);
        PG8_WAIT_V(6); PG8_BAR;
    } else {
        PG8_STAGE(PG8_SB(0, 0), cB, voffB); PG8_STAGE(PG8_SA(0, 0), cA, voffA); PG8_STAGE(PG8_SB(0, 1), cB + hstep, voffB); PG8_STAGE(PG8_SA(0, 1), cA + hstep, voffA);
        if (wr == 1) PG8_BAR;
        PG8_WAIT_V(4); PG8_BAR;
        PG8_STAGE(PG8_SB(1, 0), cB + kstep, voffB); PG8_STAGE(PG8_SA(1, 0), cA + kstep, voffA); PG8_STAGE(PG8_SB(1, 1), cB + hstep + kstep, voffB);
        PG8_WAIT_V(6); PG8_BAR;
    }
    for (;;) {
        const bool has_next = S.next(ui + 1, nxt);
        const char* nA = has_next ? (const char*)g.A + (size_t)nxt.pm * tstep : cA; const char* nB = has_next ? (const char*)g.Bt + (size_t)nxt.pn * tstep : cB;
        for (int t = 0; t < nt; t += 2) {
            const bool last = (t == nt - 2);
            const char* a1 = cA + (size_t)(t + 1) * kstep;
            const char* a2 = last ? nA : cA + (size_t)(t + 2) * kstep; const char* b2 = last ? nB : cB + (size_t)(t + 2) * kstep;
            const char* a3 = a2 + kstep; const char* b3 = b2 + kstep;
            if (last && has_next) S.a_ready(nxt);
            if constexpr (SP2) {
            PG8_LDB(B0, 0, 0); PG8_LDB(B1, 0, 1); PG8_SCHED; PG8_LDA(At, 0, 0); PG8_STAGE(PG8_SA(1, 1), a1 + hstep, voffA);
            PG8_WAIT_V(8); PG8_WAIT_L(0); PG8_BAR; PG8_MMA(0, 0, At, B0); PG8_MMA(0, 1, At, B1); PG8_BAR; PG8_SCHED;
            PG8_LDA(At, 0, 1); PG8_STAGE(PG8_SB(0, 0), b2, voffB); PG8_STAGE(PG8_SB(0, 1), b2 + hstep, voffB); PG8_STAGE(PG8_SA(0, 0), a2, voffA);
            PG8_WAIT_V(8); PG8_WAIT_L(0); PG8_BAR; PG8_MMA(1, 0, At, B0); PG8_MMA(1, 1, At, B1); PG8_BAR; PG8_SCHED;
            PG8_LDB(B0, 1, 0); PG8_LDB(B1, 1, 1); PG8_SCHED; PG8_LDA(At, 1, 0); PG8_STAGE(PG8_SA(0, 1), a2 + hstep, voffA);
            PG8_WAIT_V(8); PG8_WAIT_L(0); PG8_BAR; PG8_MMA(0, 0, At, B0); PG8_MMA(0, 1, At, B1); PG8_BAR; PG8_SCHED;
            PG8_LDA(At, 1, 1); PG8_STAGE(PG8_SB(1, 0), b3, voffB); PG8_STAGE(PG8_SB(1, 1), b3 + hstep, voffB); PG8_STAGE(PG8_SA(1, 0), a3, voffA);
            PG8_WAIT_V(8); PG8_WAIT_L(0); PG8_BAR; PG8_MMA(1, 0, At, B0); PG8_MMA(1, 1, At, B1); PG8_BAR; PG8_SCHED;
            } else {
            PG8_LDB(B0, 0, 0); PG8_SCHED; PG8_LDA(At, 0, 0); PG8_STAGE(PG8_SA(1, 1), a1 + hstep, voffA);
            PG8_WAIT_L(8); PG8_BAR; PG8_WAIT_L(0); PG8_MMA(0, 0, At, B0); PG8_BAR; PG8_SCHED;
            PG8_LDB(B1, 0, 1); PG8_STAGE(PG8_SB(0, 0), b2, voffB);
            PG8_BAR; PG8_WAIT_L(0); PG8_MMA(0, 1, At, B1); PG8_BAR;
            PG8_LDA(At, 0, 1); PG8_STAGE(PG8_SA(0, 0), a2, voffA);
            PG8_BAR; PG8_WAIT_L(0); PG8_MMA(1, 0, At, B0); PG8_BAR; PG8_SCHED;
            PG8_STAGE(PG8_SB(0, 1), b2 + hstep, voffB);
            PG8_WAIT_V(6); PG8_BAR; PG8_MMA(1, 1, At, B1); PG8_BAR;
            PG8_LDB(B0, 1, 0); PG8_SCHED; PG8_LDA(At, 1, 0); PG8_STAGE(PG8_SA(0, 1), a2 + hstep, voffA);
            PG8_WAIT_L(8); PG8_BAR; PG8_WAIT_L(0); PG8_MMA(0, 0, At, B0); PG8_BAR; PG8_SCHED;
            PG8_LDB(B1, 1, 1); PG8_STAGE(PG8_SB(1, 0), b3, voffB);
            PG8_BAR; PG8_WAIT_L(0); PG8_MMA(0, 1, At, B1); PG8_BAR;
            PG8_LDA(At, 1, 1); PG8_STAGE(PG8_SA(1, 0), a3, voffA);
            PG8_BAR; PG8_WAIT_L(0); PG8_MMA(1, 0, At, B0); PG8_BAR; PG8_SCHED;
            PG8_STAGE(PG8_SB(1, 1), b3 + hstep, voffB);
            PG8_WAIT_V(6); PG8_BAR; PG8_MMA(1, 1, At, B1); PG8_BAR;
            }
        }
        if constexpr (ALIGN_EPI) { if (wr == 0) PG8_BAR; }
        if constexpr (!Epi::AFTER_DRAIN) { E(acc, cur, wr, wc, fr, fq); S.done(cur); }
        if (!has_next) break;
#pragma unroll
        for (int a = 0; a < 2; ++a)
#pragma unroll
            for (int b = 0; b < 2; ++b)
#pragma unroll
                for (int m = 0; m < 4; ++m)
#pragma unroll
                    for (int n = 0; n < 2; ++n) acc[a][b][m][n] = (f32x4){0.f, 0.f, 0.f, 0.f};
        cur = nxt; cA = nA; cB = nB; ++ui;
        if constexpr (ALIGN_EPI) { if (wr == 1) PG8_BAR; }
    }
    PG8_WAIT_V(0);
    if constexpr (!ALIGN_EPI) { if (wr == 0) PG8_BAR; }
    PG8_BAR;
    if constexpr (Epi::AFTER_DRAIN) { E.fused(acc, cur, wr, wc, fr, fq, lds, wid, lane); S.done(cur); }
#undef PG8_SA
#undef PG8_SB
#undef PG8_STAGE
#undef PG8_LDA
#undef PG8_LDB
#undef PG8_MMA
#undef PG8_WAIT_V
#undef PG8_WAIT_L
#undef PG8_BAR
#undef PG8_SCHED
}
}

#ifndef PG8_SP2
#define PG8_SP2 true
#endif
#ifndef PG8_ALIGN
#define PG8_ALIGN true
#endif
#include <hip/hip_bf16.h>
#include <cmath>
namespace attn_body {
using bf16=__hip_bfloat16;
using bf16x8=__attribute__((ext_vector_type(8)))short;
using s16x4=__attribute__((ext_vector_type(4)))short;
using f32x16=__attribute__((ext_vector_type(16)))float;
using u32x4=__attribute__((ext_vector_type(4)))unsigned;
constexpr int SEQ=8192,D=64;
constexpr int NW=8,QBLK=32,QB=QBLK*NW,KVBLK=64,NQB=SEQ/QB;
constexpr int ATTN_UNIT_ROWS=QB;
__device__ __forceinline__ int crow(int r,int hi){return (r&3)+8*(r>>2)+4*hi;}
#define SBAR() __builtin_amdgcn_sched_barrier(0)
__device__ __forceinline__ void cmask(f32x16&p0,f32x16&p1,int jb,int qrel,int hi){
  const float NEG=-INFINITY; int kb=64*jb+4*hi;
  #pragma unroll
  for(int r=0;r<16;++r){int kv=kb+(r&3)+8*(r>>2); if(kv>qrel)p0[r]=NEG; if(kv+32>qrel)p1[r]=NEG;}
}

constexpr int NSLOT=3, SLOTB=8192;
constexpr int LDS_K=0, LDS_V=NSLOT*SLOTB, LDS_WS=2*NSLOT*SLOTB, LDS_OST=LDS_WS+NW*64*4, LDS_BYTES=LDS_OST+NW*4096;
constexpr float C2=0.125f*1.4426950408889634f;
__device__ __forceinline__ void glds16(const void*gsrc,unsigned lds_dst){unsigned keep;
  asm volatile("s_mov_b32 %0, m0\n\ts_mov_b32 m0, %2\n\ts_nop 0\n\tglobal_load_lds_dwordx4 %1, off\n\ts_mov_b32 m0, %0":"=&s"(keep):"v"(gsrc),"s"(lds_dst):"memory");}
__device__ __forceinline__ float max3f(float a,float b,float c){float r;asm("v_max3_f32 %0, %1, %2, %3":"=v"(r):"v"(a),"v"(b),"v"(c));return r;}
__device__ __forceinline__ float max2f(float a,float b){float r;asm("v_max_f32_e32 %0, %1, %2":"=v"(r):"v"(a),"v"(b));return r;}
__device__ __forceinline__ float fadd_s(float a,float b){float r;asm("v_add_f32_e32 %0, %1, %2":"=v"(r):"v"(a),"v"(b));return r;}
__device__ __forceinline__ float fsub_s(float a,float b){float r;asm("v_sub_f32_e32 %0, %1, %2":"=v"(r):"v"(a),"v"(b));return r;}
typedef float f32x2_t __attribute__((ext_vector_type(2))); typedef __bf16 bf16x2_t __attribute__((ext_vector_type(2)));
__device__ __forceinline__ unsigned cvtpk_s(float lo,float hi){f32x2_t v={lo,hi};bf16x2_t b=__builtin_convertvector(v,bf16x2_t);return __builtin_bit_cast(unsigned,b);}
#define WAIT_BAR(N) asm volatile("s_waitcnt vmcnt(" #N ") lgkmcnt(0)\n\ts_barrier":::"memory")

__device__ __forceinline__ void qkt(f32x16&p0,f32x16&p1,const char*Kslot,const bf16x8*qr,const f32x16&negm,int r32,int hi){
  const char*kb=Kslot+hi*1024+r32*16;
  #pragma unroll
  for(int d0=0;d0<4;++d0){
    const bf16x8 b0=*reinterpret_cast<const bf16x8*>(kb+d0*2048);
    const bf16x8 b1=*reinterpret_cast<const bf16x8*>(kb+d0*2048+512);
    if(d0==0){p0=__builtin_amdgcn_mfma_f32_32x32x16_bf16(b0,qr[0],negm,0,0,0);p1=__builtin_amdgcn_mfma_f32_32x32x16_bf16(b1,qr[0],negm,0,0,0);}
    else{p0=__builtin_amdgcn_mfma_f32_32x32x16_bf16(b0,qr[d0],p0,0,0,0);p1=__builtin_amdgcn_mfma_f32_32x32x16_bf16(b1,qr[d0],p1,0,0,0);}}
}
typedef __attribute__((address_space(3))) const char* lds_cptr;
typedef short v4i16_t __attribute__((ext_vector_type(4)));
__device__ __forceinline__ void kload8(bf16x8*kf,lds_cptr kp){
  kf[0]=*(const __attribute__((address_space(3))) bf16x8*)(kp);      kf[1]=*(const __attribute__((address_space(3))) bf16x8*)(kp+512);
  kf[2]=*(const __attribute__((address_space(3))) bf16x8*)(kp+2048); kf[3]=*(const __attribute__((address_space(3))) bf16x8*)(kp+2560);
  kf[4]=*(const __attribute__((address_space(3))) bf16x8*)(kp+4096); kf[5]=*(const __attribute__((address_space(3))) bf16x8*)(kp+4608);
  kf[6]=*(const __attribute__((address_space(3))) bf16x8*)(kp+6144); kf[7]=*(const __attribute__((address_space(3))) bf16x8*)(kp+6656);
}
__device__ __forceinline__ void kload2(bf16x8*kf,lds_cptr kp,int j){ kf[2*j]=*(const __attribute__((address_space(3))) bf16x8*)(kp+j*2048); kf[2*j+1]=*(const __attribute__((address_space(3))) bf16x8*)(kp+j*2048+512); }
__device__ __forceinline__ s16x4 vtr(lds_cptr p){ return __builtin_bit_cast(s16x4,__builtin_amdgcn_ds_read_tr16_b64_v4i16((__attribute__((address_space(3))) v4i16_t*)p)); }
__device__ __forceinline__ float rowmax(const f32x16&p0,const f32x16&p1){
  float a=max3f(p0[0],p0[1],p1[0]),b=max3f(p0[2],p0[3],p1[1]);a=max3f(a,p1[2],p1[3]);
  #pragma unroll
  for(int r=4;r<16;r+=4){a=max3f(a,p0[r],p0[r+1]);b=max3f(b,p0[r+2],p0[r+3]);a=max3f(a,p1[r],p1[r+1]);b=max3f(b,p1[r+2],p1[r+3]);}
  const float m=max2f(a,b);
  auto rr=__builtin_amdgcn_permlane32_swap(__float_as_uint(m),__float_as_uint(m),false,false);
  return max2f(__uint_as_float(rr[0]),__uint_as_float(rr[1]));
}
__device__ __forceinline__ void pv(f32x16*o,int vb,bf16x8 pa0,bf16x8 pa1,bf16x8 pa2,bf16x8 pa3){
  #pragma unroll
  for(int d0=0;d0<2;++d0){s16x4 lo[4],hi[4];
    #pragma unroll
    for(int ks=0;ks<4;++ks){
      asm volatile("ds_read_b64_tr_b16 %0,%1 offset:%c2":"=&v"(lo[ks]):"v"(vb),"i"(d0*4096+ks*1024):"memory");
      asm volatile("ds_read_b64_tr_b16 %0,%1 offset:%c2":"=&v"(hi[ks]):"v"(vb),"i"(d0*4096+ks*1024+512):"memory");}
    asm volatile("s_waitcnt lgkmcnt(0)":::"memory");SBAR();
    #define PK(k) (bf16x8){lo[k][0],lo[k][1],lo[k][2],lo[k][3],hi[k][0],hi[k][1],hi[k][2],hi[k][3]}
    o[d0]=__builtin_amdgcn_mfma_f32_32x32x16_bf16(pa0,PK(0),o[d0],0,0,0);
    o[d0]=__builtin_amdgcn_mfma_f32_32x32x16_bf16(pa1,PK(1),o[d0],0,0,0);
    o[d0]=__builtin_amdgcn_mfma_f32_32x32x16_bf16(pa2,PK(2),o[d0],0,0,0);
    o[d0]=__builtin_amdgcn_mfma_f32_32x32x16_bf16(pa3,PK(3),o[d0],0,0,0);
    #undef PK
  }
}

#ifndef ATTN_STORE16
#define ATTN_STORE16(p,v) (*(u32x4*)(p)=(v))
#endif
__device__ __forceinline__ void swamask(f32x16&p0,f32x16&p1,int kvrel,int qrel,int hi){
  const float NEG=-INFINITY; const int kb=kvrel+4*hi-qrel;
  #pragma unroll
  for(int r=0;r<16;++r){int dl=kb+(r&3)+8*(r>>2); if(dl>128||dl<-128)p0[r]=NEG; if(dl+32>128||dl+32<-128)p1[r]=NEG;}
}
template<int THRL,int MODE> __device__ __forceinline__ void attn_unit(const bf16*Qb,int qp,const bf16*__restrict__ Kh,int kp,const bf16*__restrict__ Vh,int vp,bf16*Ob,int op,int q0,float sink_l2,char*shm,int kv0=0,float*stats=nullptr,bool primed=false,bool prime_next=false){
  int tid_l=threadIdx.x; asm volatile("":"+v"(tid_l));
  const int tid=tid_l,lane=tid&63,r32=lane&31,hi=lane>>5; const int wid=__builtin_amdgcn_readfirstlane(tid>>6);
  const bf16*Qw=Qb+(long)(q0+wid*QBLK)*qp;
  const unsigned ord=(MODE==1)?((q0==0)?0x765243u:((q0==SEQ-QB)?0x015243u:0x70615243u)):0u;
  #define KVS(t) ((MODE==1)?(q0-128+64*(int)((ord>>(4*(t)))&15u)):((MODE==2)?(kv0+64*(t)):(64*(t))))
  const unsigned lds0=(unsigned)(uintptr_t)shm;
  float*wsf=(float*)(shm+LDS_WS)+wid*64;
  const bf16*ksrc=Kh+(long)lane*kp+wid*8;
  const bf16*vsrc=Vh+(long)(16*(wid&3)+(lane>>2))*vp+(wid>>2)*32+(lane&3)*8;
  const unsigned kdst=lds0+LDS_K+wid*1024, vdst=lds0+LDS_V+wid*1024;
  #define DMA_K(t,slot) glds16(ksrc+(long)KVS(t)*kp,(unsigned)__builtin_amdgcn_readfirstlane(kdst+(slot)))
  #define DMA_V(t,slot) glds16(vsrc+(long)KVS(t)*vp,(unsigned)__builtin_amdgcn_readfirstlane(vdst+(slot)))
  const int vb0=(int)(lds0+LDS_V)+((lane>>4)&1)*32+(lane&3)*8+(4*hi+((lane&15)>>2))*64;
  const char*Kbase=shm+LDS_K; bf16x8 kf[8];
  const lds_cptr shm3=(lds_cptr)shm; const lds_cptr kp0=shm3+LDS_K+hi*1024+r32*16; const lds_cptr vp0=shm3+LDS_V+((lane>>4)&1)*32+(lane&3)*8+(4*hi+((lane&15)>>2))*64;
  const int NT=(MODE==1)?((q0==0||q0==SEQ-QB)?6:8):((MODE==2)?(SEQ/KVBLK/4):(SEQ/KVBLK));
  if(!primed){DMA_K(0,0);DMA_V(0,0);DMA_K(1,SLOTB);}
  bf16x8 qr[4];
  #pragma unroll
  for(int d0=0;d0<4;++d0)qr[d0]=*reinterpret_cast<const bf16x8*>(&Qw[(long)r32*qp+d0*16+hi*8]);
  float mhat=0.f,l_reg=0.f;float z0_=0.f;asm volatile("":"+v"(z0_));f32x16 o[2],negm;
  #pragma unroll
  for(int r=0;r<16;++r){o[0][r]=z0_;o[1][r]=z0_;negm[r]=z0_;}
  asm volatile("":"+v"(negm));
  const int qrel=wid*QBLK+r32;
  #define CMASK(P0,P1,t) do{ if constexpr(MODE==1) swamask(P0,P1,KVS(t)-q0,qrel,hi); }while(0)
  bool resc=false;
  #define START(P0,P1) do{ const float rm=rowmax(P0,P1); resc=false; \
    { const float dl=rm; mhat=fadd_s(mhat,dl); \
      _Pragma("unroll") for(int r=0;r<16;++r){P0[r]=fsub_s(P0[r],dl);P1[r]=fsub_s(P1[r],dl);} \
      _Pragma("unroll") for(int r=0;r<16;++r)negm[r]=-mhat; asm volatile("":"+v"(negm)); } \
    _Pragma("unroll") for(int r=0;r<16;++r)P0[r]=__builtin_amdgcn_exp2f(P0[r]); }while(0)
  #define RESC() do{ if(resc){ asm volatile("s_waitcnt lgkmcnt(0)":::"memory"); \
      _Pragma("unroll") for(int d_=0;d_<2;++d_) _Pragma("unroll") for(int r=0;r<16;++r)o[d_][r]*=wsf[crow(r,hi)]; } }while(0)
  f32x16 pA0,pA1,pB0,pB1;
  int sl_prev=0,sl_cur=0,sl_next=SLOTB;
  #define ROT() do{sl_prev=sl_cur;sl_cur=sl_next;sl_next=(sl_next==(NSLOT-1)*SLOTB)?0:sl_next+SLOTB;}while(0)
  DMA_K(2,2*SLOTB);
  WAIT_BAR(3);
  qkt(pA0,pA1,Kbase,qr,negm,r32,hi);asm volatile("s_nop 15\n\ts_nop 7":"+v"(pA0),"+v"(pA1));CMASK(pA0,pA1,0);
  START(pA0,pA1);
  _Pragma("unroll") for(int r=0;r<16;++r)pA1[r]=__builtin_amdgcn_exp2f(pA1[r]);
  WAIT_BAR(0);
  DMA_K(3,0);DMA_V(1,SLOTB);
  ROT();
  kload8(kf,kp0+sl_cur);
  WAIT_BAR(2);
  s16x4 vlo[8],vhi[8]; u32x4 pw0,pw1,pw2,pw3;
  #define PKW(P,B) cvtpk_s(P[B],P[B+1])
  #define PAF(k) __builtin_bit_cast(bf16x8,pw##k)
  #define VFR(i) (bf16x8){vlo[i][0],vlo[i][1],vlo[i][2],vlo[i][3],vhi[i][0],vhi[i][1],vhi[i][2],vhi[i][3]}
  #define PIN(x) asm volatile("":"+v"(x))
  #define MX3(a,b,c) __builtin_fmaxf(__builtin_fmaxf((a),(b)),(c))
  #define GAPA(MF,A0,A1,A2,A3,W0,W1,PW) do{ MF; sacc+=A0; sacc+=A1; sacc+=A2; sacc+=A3; PIN(sacc); W0; W1; PIN(PW); SBAR(); }while(0)
  #define EX(v) __builtin_amdgcn_exp2f(v)
  #define GAPB(MF,X,B) do{ MF; X[B]=EX(X[B]); X[B+1]=EX(X[B+1]); X[B+2]=EX(X[B+2]); X[B+3]=EX(X[B+3]); PIN(X); SBAR(); }while(0)
  #define VRD(i) do{ vlo[i]=vtr(vp_+(((i)>>2)*4096+((i)&3)*1024)); vhi[i]=vtr(vp_+(((i)>>2)*4096+((i)&3)*1024+512)); }while(0)
  #define KRD(G,j) do{ if(G){ kload2(kf,kp0+sl_next,j); SBAR(); } }while(0)
  #define STEP(C0,C1,P0,P1,t,GK,GV,GL) do{ SBAR(); \
    const lds_cptr vp_=vp0+sl_prev; \
    __builtin_amdgcn_s_setprio(1); VRD(0); SBAR(); float sacc=(P0[0]+P0[1]); \
    GAPA(C0=__builtin_amdgcn_mfma_f32_32x32x16_bf16(kf[0],qr[0],negm,0,0,0), P0[2],P0[3],P0[4],P0[5],     pw0[0]=PKW(P0,0), pw0[1]=PKW(P0,2), pw0); \
    VRD(4); SBAR(); GAPA(C1=__builtin_amdgcn_mfma_f32_32x32x16_bf16(kf[1],qr[0],negm,0,0,0), P0[6],P0[7],P0[8],P0[9],     pw0[2]=PKW(P0,4), pw0[3]=PKW(P0,6), pw0); \
    VRD(1); SBAR(); GAPA(C0=__builtin_amdgcn_mfma_f32_32x32x16_bf16(kf[2],qr[1],C0,0,0,0),   P0[10],P0[11],P0[12],P0[13], pw1[0]=PKW(P0,8), pw1[1]=PKW(P0,10), pw1); \
    VRD(5); SBAR(); GAPA(C1=__builtin_amdgcn_mfma_f32_32x32x16_bf16(kf[3],qr[1],C1,0,0,0),   P0[14],P0[15],P1[0],P1[1],   pw1[2]=PKW(P0,12),pw1[3]=PKW(P0,14), pw1); \
    VRD(2); SBAR(); GAPA(C0=__builtin_amdgcn_mfma_f32_32x32x16_bf16(kf[4],qr[2],C0,0,0,0),   P1[2],P1[3],P1[4],P1[5],     pw2[0]=PKW(P1,0), pw2[1]=PKW(P1,2), pw2); \
    VRD(6); SBAR(); GAPA(C1=__builtin_amdgcn_mfma_f32_32x32x16_bf16(kf[5],qr[2],C1,0,0,0),   P1[6],P1[7],P1[8],P1[9],     pw2[2]=PKW(P1,4), pw2[3]=PKW(P1,6), pw2); \
    VRD(3); SBAR(); GAPA(C0=__builtin_amdgcn_mfma_f32_32x32x16_bf16(kf[6],qr[3],C0,0,0,0),   P1[10],P1[11],P1[12],P1[13], pw3[0]=PKW(P1,8), pw3[1]=PKW(P1,10), pw3); \
    VRD(7); SBAR(); GAPA(C1=__builtin_amdgcn_mfma_f32_32x32x16_bf16(kf[7],qr[3],C1,0,0,0),   P1[14],P1[15],0.f,0.f,       pw3[2]=PKW(P1,12),pw3[3]=PKW(P1,14), pw3); \
    l_reg+=sacc; __builtin_amdgcn_s_setprio(0); \
    if(GK){DMA_K((t)+3,sl_cur);} if(GV){DMA_V((t)+1,sl_next);} \
    CMASK(C0,C1,t); \
    { float a=MX3(C0[0],C0[1],C1[0]),b=MX3(C0[2],C0[3],C1[1]); a=MX3(a,C1[2],C1[3]); \
      _Pragma("unroll") for(int r=4;r<16;r+=4){a=MX3(a,C0[r],C0[r+1]);b=MX3(b,C0[r+2],C0[r+3]);a=MX3(a,C1[r],C1[r+1]);b=MX3(b,C1[r+2],C1[r+3]);} \
      float rm=__builtin_fmaxf(a,b); { auto rr=__builtin_amdgcn_permlane32_swap(__float_as_uint(rm),__float_as_uint(rm),false,false); rm=__builtin_fmaxf(__uint_as_float(rr[0]),__uint_as_float(rr[1])); } \
      resc=false; \
      if(__builtin_expect(__any(rm>(float)THRL),0)){ const float dl=__builtin_fmaxf(rm,0.f); mhat+=dl; \
        _Pragma("unroll") for(int r=0;r<16;++r){C0[r]-=dl;C1[r]-=dl;} \
        _Pragma("unroll") for(int r=0;r<16;++r)negm[r]=-mhat; asm volatile("":"+v"(negm)); \
        const float f=__builtin_amdgcn_exp2f(-dl); l_reg*=f; if(hi==0)wsf[r32]=f; resc=true; } } \
    SBAR(); \
    __builtin_amdgcn_s_setprio(1); \
    GAPB(o[0]=__builtin_amdgcn_mfma_f32_32x32x16_bf16(PAF(0),VFR(0),o[0],0,0,0), C0,0); \
    GAPB(o[1]=__builtin_amdgcn_mfma_f32_32x32x16_bf16(PAF(0),VFR(4),o[1],0,0,0), C0,4); \
    KRD(GL,0); GAPB(o[0]=__builtin_amdgcn_mfma_f32_32x32x16_bf16(PAF(1),VFR(1),o[0],0,0,0), C0,8); \
    KRD(GL,1); GAPB(o[1]=__builtin_amdgcn_mfma_f32_32x32x16_bf16(PAF(1),VFR(5),o[1],0,0,0), C0,12); \
    KRD(GL,2); GAPB(o[0]=__builtin_amdgcn_mfma_f32_32x32x16_bf16(PAF(2),VFR(2),o[0],0,0,0), C1,0); \
    KRD(GL,3); GAPB(o[1]=__builtin_amdgcn_mfma_f32_32x32x16_bf16(PAF(2),VFR(6),o[1],0,0,0), C1,4); \
    GAPB(o[0]=__builtin_amdgcn_mfma_f32_32x32x16_bf16(PAF(3),VFR(3),o[0],0,0,0), C1,8); \
    GAPB(o[1]=__builtin_amdgcn_mfma_f32_32x32x16_bf16(PAF(3),VFR(7),o[1],0,0,0), C1,12); \
    __builtin_amdgcn_s_setprio(0); \
    }while(0)
  int t=1;
  for(;t+5<NT;t+=2){
    STEP(pB0,pB1,pA0,pA1,t,true,true,true);     WAIT_BAR(2); RESC(); ROT();
    STEP(pA0,pA1,pB0,pB1,t+1,true,true,true);   WAIT_BAR(2); RESC(); ROT();
  }
  #undef CMASK
  #define CMASK(P0,P1,t) do{ if constexpr(MODE==1) swamask(P0,P1,KVS(t)-q0,qrel,hi); }while(0)
  #define ENDW(tt) do{ if((tt)+3<NT){WAIT_BAR(2);} else if((tt)+2<NT){WAIT_BAR(1);} else {WAIT_BAR(0);} }while(0)
  for(;t+1<NT;t+=2){
    STEP(pB0,pB1,pA0,pA1,t,(t+3<NT),(t+1<NT),(t+1<NT));       ENDW(t);   RESC(); ROT();
    STEP(pA0,pA1,pB0,pB1,t+1,(t+4<NT),(t+2<NT),(t+2<NT));     ENDW(t+1); RESC(); ROT();
  }
  STEP(pB0,pB1,pA0,pA1,NT-1,false,false,false); RESC();
  { float sacc=pB0[0]+pB0[1]; _Pragma("unroll") for(int r=2;r<16;++r)sacc+=pB0[r]; _Pragma("unroll") for(int r=0;r<16;++r)sacc+=pB1[r]; l_reg+=sacc;
    pw0=(u32x4){PKW(pB0,0),PKW(pB0,2),PKW(pB0,4),PKW(pB0,6)};pw1=(u32x4){PKW(pB0,8),PKW(pB0,10),PKW(pB0,12),PKW(pB0,14)};pw2=(u32x4){PKW(pB1,0),PKW(pB1,2),PKW(pB1,4),PKW(pB1,6)};pw3=(u32x4){PKW(pB1,8),PKW(pB1,10),PKW(pB1,12),PKW(pB1,14)};
    SBAR(); pv(o,vb0+sl_cur,PAF(0),PAF(1),PAF(2),PAF(3)); }
  #undef PKW
  #undef PAF
  #undef VFR
  #undef PIN
  #undef MX3
  #undef GAPA
  #undef GAPB
  #undef EX
  #undef VRD
  #undef KRD
  #undef STEP
  #undef ENDW
  asm volatile("s_waitcnt lgkmcnt(0)\n\ts_barrier":::"memory");
  if(prime_next){DMA_K(0,0);DMA_V(0,0);DMA_K(1,SLOTB);}
  {auto rr=__builtin_amdgcn_permlane32_swap(__float_as_uint(l_reg),__float_as_uint(l_reg),false,false);l_reg=__uint_as_float(rr[0])+__uint_as_float(rr[1]);}
  if constexpr(MODE==1) l_reg+=__builtin_amdgcn_exp2f(sink_l2-mhat);
  if constexpr(MODE==2){ if(hi==0){ float*sp=stats+2*(long)(q0+wid*QBLK+r32); sp[0]=mhat; sp[1]=l_reg; } }
  if(hi==0)wsf[32+r32]=l_reg;asm volatile("s_waitcnt lgkmcnt(0)":::"memory");
  float rli[16];
  #pragma unroll
  for(int r=0;r<16;++r)rli[r]=__builtin_amdgcn_rcpf(wsf[32+crow(r,hi)]);
  bf16*Ow=Ob+(long)(q0+wid*QBLK)*op;
  { bf16*stg=(bf16*)(shm+LDS_OST)+wid*2048;
    #pragma unroll
    for(int r=0;r<16;++r){const int orow=crow(r,hi);
      #pragma unroll
      for(int d0=0;d0<2;++d0)stg[orow*64+d0*32+r32]=__float2bfloat16(o[d0][r]*rli[r]);}
    asm volatile("s_waitcnt lgkmcnt(0)":::"memory");
    #pragma unroll
    for(int i=0;i<4;++i){const int row=i*8+(lane>>3),ch=lane&7; const u32x4 v=*(const u32x4*)(stg+row*64+ch*8); ATTN_STORE16(Ow+(long)row*op+ch*8,v);} }
  asm volatile("s_waitcnt lgkmcnt(0)\n\ts_barrier":::"memory");
  #undef DMA_K
  #undef KVS
  #undef DMA_V
  #undef CMASK
  #undef START
  #undef RESC
  #undef ROT
}
constexpr int ATTN_LDS_BYTES=LDS_BYTES;
#undef SBAR
#undef WAIT_BAR
}
#include <hip/hip_cooperative_groups.h>
namespace cg = cooperative_groups;
#define LAS __attribute__((address_space(3)))
#define GAS __attribute__((address_space(1)))
typedef unsigned short bf16;
typedef unsigned v4u __attribute__((ext_vector_type(4)));
typedef unsigned v2u __attribute__((ext_vector_type(2)));
typedef float f32x4 __attribute__((ext_vector_type(4)));
typedef float f32x16 __attribute__((ext_vector_type(16)));
typedef short bf16x8 __attribute__((ext_vector_type(8)));
constexpr int NWAVES = 8, NTHR = 512;
constexpr int DMODEL = 1024, SEQ = 8192, MG = 2 * SEQ, NGRP = 3, DEPTH = 2, INC = 3088, NPROJ = 3072, DFF = 4096;
constexpr float EPS = 1e-6f;
constexpr float LOG2E = 1.4426950408889634f;
constexpr size_t MiB = 1u << 20;
constexpr size_t WS_ROPE = 1 * MiB;
constexpr size_t WS_WIN = 4 * MiB, WS_WOUT = 16 * MiB, WS_WUP = 20 * MiB, WS_WDN = 36 * MiB;
constexpr size_t WS_HN = 52 * MiB, WS_DNRAW = 84 * MiB, WS_Z = 108 * MiB, WS_DFQ = 116 * MiB, WS_DFK = 132 * MiB, WS_DFV = 148 * MiB;
constexpr size_t WS_SWQ = 164 * MiB, WS_SWKV = 172 * MiB, WS_BG = 180 * MiB, WS_GS = 181 * MiB;
constexpr size_t WS_QS = 182 * MiB, WS_KS = 198 * MiB, WS_KT = 214 * MiB, WS_U = 230 * MiB, WS_W = 246 * MiB;
constexpr size_t WS_ODN = 262 * MiB, WS_ODF = 294 * MiB, WS_MIX = 326 * MiB, WS_HID = 358 * MiB, WS_END = 486 * MiB;
constexpr size_t WS_WL = 3 * MiB;
constexpr size_t WS_SS2 = 497 * MiB;
constexpr size_t WS_SS = 496 * MiB;
constexpr size_t WS_PO = 486 * MiB, WS_PS = 494 * MiB;
constexpr int LDS_BYTES = 147456;
static_assert(WS_DNRAW == 84 * MiB && WS_Z == 108 * MiB && WS_DFQ == 116 * MiB && WS_DFK == 132 * MiB && WS_DFV == 148 * MiB && WS_SWQ == 164 * MiB && WS_SWKV == 172 * MiB, "EpiProj offsets");

__device__ __forceinline__ float bf2f(unsigned short b) { return __uint_as_float((unsigned)b << 16); }
__device__ __forceinline__ unsigned f2bf(float f) { unsigned u = __builtin_bit_cast(unsigned, f); return (u + 0x7fffu + ((u >> 16) & 1u)) >> 16; }
typedef float f32x2_ __attribute__((ext_vector_type(2))); typedef __bf16 bf16x2_ __attribute__((ext_vector_type(2)));
__device__ __forceinline__ unsigned pk2(float lo, float hi) { f32x2_ v = {lo, hi}; bf16x2_ b = __builtin_convertvector(v, bf16x2_); return __builtin_bit_cast(unsigned, b); }
__device__ __forceinline__ float shx(float v, int o, int lane) { return __int_as_float(__builtin_amdgcn_ds_bpermute((lane ^ o) << 2, __float_as_int(v))); }
__device__ __forceinline__ float wave_sum(float v, int lane) {
#pragma unroll
    for (int o = 1; o < 64; o <<= 1) v += shx(v, o, lane);
    return v;
}
#define MFMA32(a, b, c) __builtin_amdgcn_mfma_f32_32x32x16_bf16((a), (b), (c), 0, 0, 0)
__device__ __forceinline__ int crow(int r, int hi) { return (r & 3) + 8 * (r >> 2) + 4 * hi; }
__device__ __forceinline__ bf16x8 pack8(const f32x16& x, int s) {
    v4u p; p.x = pk2(x[8 * s], x[8 * s + 1]); p.y = pk2(x[8 * s + 2], x[8 * s + 3]); p.z = pk2(x[8 * s + 4], x[8 * s + 5]); p.w = pk2(x[8 * s + 6], x[8 * s + 7]);
    return __builtin_bit_cast(bf16x8, p);
}

#define XB_TMO      128
#define XB_XCNT(j)  (256  + 64 * (j))
#define XB_XSUB(j)  (1280 + 64 * (j))
#define XB_XGEN(j)  (2304 + 64 * (j))
#define XB_TOP      3328
#define XB_TOPGEN   3392
#define XCD_BAR_WORDS 3456
#define XB_SPIN_CAP (1u << 18)

__device__ __forceinline__ unsigned xb_ld(unsigned* p)              { return __hip_atomic_load(p, __ATOMIC_RELAXED, __HIP_MEMORY_SCOPE_AGENT); }
__device__ __forceinline__ unsigned xb_add(unsigned* p, unsigned v) { return __hip_atomic_fetch_add(p, v, __ATOMIC_RELAXED, __HIP_MEMORY_SCOPE_AGENT); }
__device__ __forceinline__ unsigned xb_xcc_id() { return (unsigned)__builtin_amdgcn_s_getreg((3 << 11) | 20) & 0xFu; }
#define XB_SPIN(cond, bar) do { unsigned _sp = 0; while (cond) { __builtin_amdgcn_s_sleep(1); \
    if ((++_sp & 255u) == 0u) { if (xb_ld(&(bar)[XB_TMO])) break; if (_sp > XB_SPIN_CAP) { atomicAdd(&(bar)[XB_TMO], 1u); break; } } } } while (0)

struct XcdBarrier {
    unsigned* bar; unsigned x;
    volatile LAS unsigned* st;
};

__device__ __forceinline__ XcdBarrier xcd_barrier_post(unsigned* bar, volatile LAS unsigned* st) {
    XcdBarrier b; b.bar = bar; b.x = xb_xcc_id(); b.st = st;
    if (threadIdx.x == 0) (void)xb_add(&bar[XB_XCNT(b.x)], 1u);
    return b;
}
__device__ __forceinline__ void xcd_barrier_complete(unsigned* bar, unsigned x, unsigned& nloc, unsigned& nx) {
    const unsigned G = gridDim.x * gridDim.y * gridDim.z;
    unsigned sum, cnt, mine, sp = 0u;
    for (;;) {
        sum = 0u; cnt = 0u; mine = 0u;
#pragma unroll
        for (unsigned j = 0; j < 16; ++j) { const unsigned c = xb_ld(&bar[XB_XCNT(j)]); sum += c; cnt += (c > 0u) ? 1u : 0u; mine = (j == x) ? c : mine; }
        if (sum == G) break;
        __builtin_amdgcn_s_sleep(1);
        if ((++sp & 255u) == 0u) { if (xb_ld(&bar[XB_TMO])) break; if (sp > XB_SPIN_CAP) { atomicAdd(&bar[XB_TMO], 1u); break; } }
    }
    nloc = mine > 0u ? mine : 1u; nx = cnt > 0u ? cnt : 1u;
}

__device__ __forceinline__ void xcd_barrier(const XcdBarrier& b) {
    asm volatile("s_waitcnt vmcnt(0)" ::: "memory");
    __syncthreads();
    if (threadIdx.x == 0) {
        unsigned* bar = b.bar;
        __builtin_amdgcn_s_waitcnt(0);
        unsigned nloc = b.st[0], nx = b.st[1];
        if (nloc == 0u) { xcd_barrier_complete(bar, b.x, nloc, nx); b.st[0] = nloc; b.st[1] = nx; }
        const unsigned old = xb_add(&bar[XB_XSUB(b.x)], 1u);
        const unsigned gen = old / nloc;
        if (old + 1u == (gen + 1u) * nloc) {
            __builtin_amdgcn_fence(__ATOMIC_RELEASE, "agent");
            asm volatile("s_waitcnt vmcnt(0)" ::: "memory");
            const unsigned og = xb_add(&bar[XB_TOP], 1u);
            const unsigned tg = og / nx;
            if (og + 1u == (tg + 1u) * nx) xb_add(&bar[XB_TOPGEN], 1u);
            else XB_SPIN(xb_ld(&bar[XB_TOPGEN]) == tg, bar);
            __builtin_amdgcn_fence(__ATOMIC_ACQUIRE, "agent");
            xb_add(&bar[XB_XGEN(b.x)], 1u);
            asm volatile("s_waitcnt vmcnt(0)" ::: "memory");
        } else {
            XB_SPIN(xb_ld(&bar[XB_XGEN(b.x)]) == gen, bar);
            __builtin_amdgcn_fence(__ATOMIC_ACQUIRE, "agent");
            asm volatile("s_waitcnt vmcnt(0)" ::: "memory");
        }
    }
    __syncthreads();
}

struct Ctx {
    LAS unsigned char* lds; unsigned char* ldsg;
    int tid, lane, wave, vcu, G, bx;
    unsigned char* ws;
};

__device__ __forceinline__ void transpose_item(const float* W, int K, int Nsrc, bf16* WT, int nblk, int item, int skip_from, int skip, LAS float* scr, int lane, const float* kscale = nullptr) {
    const int kb = item / nblk, nb = item % nblk, k0 = 64 * kb, n0 = 32 * nb, c0 = n0 + (n0 >= skip_from ? skip : 0);
    { const int kk0 = lane >> 3, c4 = (lane & 7) * 4;
      f32x4 v[8];
#pragma unroll
      for (int i = 0; i < 8; ++i) v[i] = *(const f32x4*)(W + (size_t)(k0 + kk0 + 8 * i) * Nsrc + c0 + c4);
#pragma unroll
      for (int i = 0; i < 8; ++i) { const int kk = kk0 + 8 * i; const float sc = kscale ? kscale[k0 + kk] : 1.f; LAS float* d = scr + kk * 33 + c4; d[0] = v[i].x * sc; d[1] = v[i].y * sc; d[2] = v[i].z * sc; d[3] = v[i].w * sc; } }
    asm volatile("s_waitcnt lgkmcnt(0)" ::: "memory");
    const int c = lane & 7;
#pragma unroll
    for (int j = 0; j < 4; ++j) { const int n = (lane >> 3) + 8 * j; const LAS float* s = scr + (8 * c) * 33 + n;
        v4u o; o.x = pk2(s[0 * 33], s[1 * 33]); o.y = pk2(s[2 * 33], s[3 * 33]); o.z = pk2(s[4 * 33], s[5 * 33]); o.w = pk2(s[6 * 33], s[7 * 33]);
        *(v4u*)(WT + (size_t)(n0 + n) * K + k0 + 8 * c) = o; }
    asm volatile("s_waitcnt lgkmcnt(0)" ::: "memory");
}

__device__ __forceinline__ void phase_prologue(Ctx& C, const float* w_in, const float* w_out, const float* w_up, const float* w_dn, const float* n2w, const float* n1w) {
    LAS float* scr = (LAS float*)(C.lds + C.wave * 16384);
    const int gw = C.vcu * NWAVES + C.wave, NGW = C.G * NWAVES;
    constexpr int I_IN = (DMODEL / 64) * (NPROJ / 32), I_OUT = (DMODEL / 64) * (DMODEL / 32), I_UP = (DMODEL / 64) * (DFF / 32), I_DN = (DFF / 64) * (DMODEL / 32);
    constexpr int PER = I_IN + I_OUT + I_UP + I_DN;
    for (int it = gw; it < DEPTH * PER; it += NGW) {
        const int l = it / PER; int r = it % PER;
        if (r < I_IN) { transpose_item(w_in + (size_t)l * DMODEL * INC, DMODEL, INC, (bf16*)(C.ws + WS_WIN) + (size_t)l * NPROJ * DMODEL, NPROJ / 32, r, 1024, 16, scr, C.lane, l ? n1w + DMODEL : nullptr); continue; } r -= I_IN;
        if (r < I_OUT) { transpose_item(w_out + (size_t)l * DMODEL * DMODEL, DMODEL, DMODEL, (bf16*)(C.ws + WS_WOUT) + (size_t)l * DMODEL * DMODEL, DMODEL / 32, r, 1 << 30, 0, scr, C.lane); continue; } r -= I_OUT;
        if (r < I_UP) { transpose_item(w_up + (size_t)l * DMODEL * DFF, DMODEL, DFF, (bf16*)(C.ws + WS_WUP) + (size_t)l * DFF * DMODEL, DFF / 32, r, 1 << 30, 0, scr, C.lane, n2w + l * DMODEL); continue; } r -= I_UP;
        transpose_item(w_dn + (size_t)l * DFF * DMODEL, DFF, DMODEL, (bf16*)(C.ws + WS_WDN) + (size_t)l * DMODEL * DFF, DMODEL / 32, r, 1 << 30, 0, scr, C.lane);
    }
    for (int e = C.vcu * NTHR + C.tid; e < DEPTH * 32 * DMODEL; e += C.G * NTHR) { const int k = e & (DMODEL - 1), o = (e >> 10) & 31, l = e >> 15;
        const float v = (o < 16) ? w_in[(size_t)l * DMODEL * INC + (size_t)k * INC + 1024 + o] * (l ? n1w[DMODEL + k] : 1.f) : 0.f;
        ((bf16*)(C.ws + WS_WL))[e] = (bf16)(pk2(v, 0.f) & 0xffffu); }
    float* cosT = (float*)(C.ws + WS_ROPE); float* sinT = cosT + SEQ * 32;
    for (int e = C.vcu * NTHR + C.tid; e < SEQ * 32; e += C.G * NTHR) {
        const int pos = e >> 5, i = e & 31;
        const double inv = exp(-(double)i * (9.210340371976184 / 32.0));
        double rev = (double)pos * inv * 0.15915494309189535;
        rev -= floor(rev);
        const float fr = (float)rev;
        cosT[e] = __builtin_amdgcn_cosf(fr); sinT[e] = __builtin_amdgcn_sinf(fr);
    }
}

template <bool LOGITS>
__device__ __forceinline__ void phase_norm(Ctx& C, const float* x, const float* nw, bf16* hn, const float* w_in_l, float* bg) {
    LAS float* wl = (LAS float*)C.lds;
    if (LOGITS) {
        for (int e = C.tid; e < DMODEL * 16; e += NTHR) { const int k = e >> 4, o = e & 15;
            wl[(((((k >> 8) * 4 + (k & 3)) * 4 + (o >> 2)) * 64 + ((k >> 2) & 63)) * 4) + (o & 3)] = w_in_l[(size_t)k * INC + 1024 + o]; }
        __syncthreads();
    }
    const int gw = C.vcu * NWAVES + C.wave, NGW = C.G * NWAVES;
    f32x4 wv[4];
#pragma unroll
    for (int j = 0; j < 4; ++j) wv[j] = ((const f32x4*)nw)[C.lane + 64 * j];
    f32x4 v[4];
    { const f32x4* xr = (const f32x4*)(x + (size_t)gw * DMODEL) + C.lane;
#pragma unroll
      for (int j = 0; j < 4; ++j) v[j] = xr[64 * j]; }
    for (int m = gw; m < MG; m += NGW) {
        f32x4 vn[4]; { const int mn = (m + NGW < MG) ? m + NGW : m; const f32x4* xr = (const f32x4*)(x + (size_t)mn * DMODEL) + C.lane;
#pragma unroll
          for (int j = 0; j < 4; ++j) vn[j] = xr[64 * j]; }
        float s = 0.f;
#pragma unroll
        for (int j = 0; j < 4; ++j) s += (v[j].x * v[j].x + v[j].y * v[j].y) + (v[j].z * v[j].z + v[j].w * v[j].w);
        const float rstd = 1.f / sqrtf(wave_sum(s, C.lane) * (1.f / DMODEL) + EPS);
        unsigned long long* o8 = (unsigned long long*)(hn + (size_t)m * DMODEL) + C.lane;
#pragma unroll
        for (int j = 0; j < 4; ++j) { v[j] = v[j] * rstd * wv[j]; o8[64 * j] = (unsigned long long)pk2(v[j].x, v[j].y) | ((unsigned long long)pk2(v[j].z, v[j].w) << 32); }
        if (LOGITS) {
            float acc[16];
#pragma unroll
            for (int o = 0; o < 16; ++o) acc[o] = 0.f;
#pragma unroll
            for (int j = 0; j < 4; ++j)
#pragma unroll
                for (int e = 0; e < 4; ++e) { const int k = 4 * C.lane + 256 * j + e; const float hv = v[j][e];
#pragma unroll
                    for (int o4 = 0; o4 < 4; ++o4) { const f32x4 w4 = *(const LAS f32x4*)(wl + ((((j * 4 + e) * 4 + o4) * 64 + C.lane) * 4)); acc[4 * o4] += hv * w4.x; acc[4 * o4 + 1] += hv * w4.y; acc[4 * o4 + 2] += hv * w4.z; acc[4 * o4 + 3] += hv * w4.w; } }
            float mine = 0.f;
#pragma unroll
            for (int o = 0; o < 16; ++o) { const float t = wave_sum(acc[o], C.lane); if (C.lane == o) mine = t; }
            if (C.lane < 16) bg[(size_t)m * 16 + C.lane] = mine;
        }
#pragma unroll
        for (int j = 0; j < 4; ++j) v[j] = vn[j];
    }
    if (LOGITS) __syncthreads();
}

__device__ __forceinline__ void phase_logits(Ctx& C, const bf16* A, const bf16* WL, const float* ss, float* bg) {
    const int r32 = C.lane & 31, hi = C.lane >> 5, tl = C.wave >> 2, kq = C.wave & 3, row0 = (tl * 256 + C.vcu) * 32;
    const GAS bf16* ap = (const GAS bf16*)A + (size_t)(row0 + r32) * DMODEL + kq * 256 + 8 * hi; const GAS bf16* bp = (const GAS bf16*)WL + (size_t)r32 * DMODEL + kq * 256 + 8 * hi;
    bf16x8 af[16], bf_[16];
#pragma unroll
    for (int j = 0; j < 16; ++j) { af[j] = *(const GAS bf16x8*)(ap + 16 * j); bf_[j] = *(const GAS bf16x8*)(bp + 16 * j); }
    f32x16 acc = f32x16{};
#pragma unroll
    for (int j = 0; j < 16; ++j) acc = MFMA32(af[j], bf_[j], acc);
    LAS f32x4* part = (LAS f32x4*)C.lds + (C.wave * 64 + C.lane) * 4;
#pragma unroll
    for (int q = 0; q < 4; ++q) part[q] = (f32x4){acc[4 * q], acc[4 * q + 1], acc[4 * q + 2], acc[4 * q + 3]};
    __syncthreads();
    if (kq == 0 && r32 < 16) {
#pragma unroll
        for (int q = 0; q < 4; ++q) { f32x4 t = part[q];
#pragma unroll
            for (int w = 1; w < 4; ++w) t += ((LAS f32x4*)C.lds + ((C.wave + w) * 64 + C.lane) * 4)[q];
#pragma unroll
            for (int e = 0; e < 4; ++e) { const int r = 4 * q + e, row = row0 + crow(r, hi); const float rs = ss ? pg8::row_rstd(ss, row) : 1.0f; bg[(size_t)row * 16 + r32] = t[e] * rs; } }
    }
    __syncthreads();
}

__device__ __forceinline__ void phase_final_norm(Ctx& C, float* x, const float* nw) {
    const int gw = C.vcu * NWAVES + C.wave, NGW = C.G * NWAVES;
    f32x4 wv[4];
#pragma unroll
    for (int j = 0; j < 4; ++j) wv[j] = ((const f32x4*)nw)[C.lane + 64 * j];
    for (int m = gw; m < MG; m += 2 * NGW) {
        f32x4* xa = (f32x4*)(x + (size_t)m * DMODEL) + C.lane; f32x4* xb = (f32x4*)(x + (size_t)(m + NGW) * DMODEL) + C.lane;
        f32x4 va[4], vb[4]; float sa = 0.f, sb = 0.f;
#pragma unroll
        for (int j = 0; j < 4; ++j) { va[j] = xa[64 * j]; vb[j] = xb[64 * j]; }
#pragma unroll
        for (int j = 0; j < 4; ++j) { sa += (va[j].x * va[j].x + va[j].y * va[j].y) + (va[j].z * va[j].z + va[j].w * va[j].w); sb += (vb[j].x * vb[j].x + vb[j].y * vb[j].y) + (vb[j].z * vb[j].z + vb[j].w * vb[j].w); }
        const float ra = 1.f / sqrtf(wave_sum(sa, C.lane) * (1.f / DMODEL) + EPS), rb = 1.f / sqrtf(wave_sum(sb, C.lane) * (1.f / DMODEL) + EPS);
#pragma unroll
        for (int j = 0; j < 4; ++j) { xa[64 * j] = va[j] * ra * wv[j]; xb[64 * j] = vb[j] * rb * wv[j]; }
    }
}

__device__ __forceinline__ void phase_rope(Ctx& C) {
    const float* cosT = (const float*)(C.ws + WS_ROPE); const float* sinT = cosT + SEQ * 32;
    const int total = MG * 22 * 4, T = C.G * NTHR;
    for (int it0 = C.vcu * NTHR + C.tid; it0 < total; it0 += 4 * T) {
        bf16* p[4]; float sc[4]; v4u a[4], b[4]; f32x4 c0[4], c1[4], s0[4], s1[4]; bool ok[4];
#pragma unroll
        for (int u = 0; u < 4; ++u) {
            const int it = it0 + u * T; ok[u] = it < total; const int itc = ok[u] ? it : it0;
            const int i8 = itc & 3, grp = (itc >> 2) % 22, row = (itc >> 2) / 22, pos = row & (SEQ - 1);
            sc[u] = 1.f;
            if (grp < 8) { p[u] = (bf16*)(C.ws + WS_DFQ) + (size_t)row * 512 + grp * 64; sc[u] = 0.125f * LOG2E; }
            else if (grp < 16) { p[u] = (bf16*)(C.ws + WS_DFK) + (size_t)row * 512 + (grp - 8) * 64; }
            else if (grp < 20) { p[u] = (bf16*)(C.ws + WS_SWQ) + (size_t)row * 256 + (grp - 16) * 64; sc[u] = 0.125f * LOG2E; }
            else { p[u] = (bf16*)(C.ws + WS_SWKV) + (size_t)row * 256 + (grp - 20) * 64; }
            p[u] += i8 * 8;
            a[u] = *(const v4u*)(p[u]); b[u] = *(const v4u*)(p[u] + 32);
            c0[u] = *(const f32x4*)(cosT + pos * 32 + i8 * 8); c1[u] = *(const f32x4*)(cosT + pos * 32 + i8 * 8 + 4);
            s0[u] = *(const f32x4*)(sinT + pos * 32 + i8 * 8); s1[u] = *(const f32x4*)(sinT + pos * 32 + i8 * 8 + 4);
        }
#pragma unroll
        for (int u = 0; u < 4; ++u) {
            v4u oa, ob;
#pragma unroll
            for (int w = 0; w < 4; ++w) {
                const float x1l = __uint_as_float(a[u][w] << 16), x1h = __uint_as_float(a[u][w] & 0xffff0000u), x2l = __uint_as_float(b[u][w] << 16), x2h = __uint_as_float(b[u][w] & 0xffff0000u);
                const float cl = (w < 2) ? c0[u][2 * w] : c1[u][2 * w - 4], ch = (w < 2) ? c0[u][2 * w + 1] : c1[u][2 * w - 3];
                const float sl = (w < 2) ? s0[u][2 * w] : s1[u][2 * w - 4], sh = (w < 2) ? s0[u][2 * w + 1] : s1[u][2 * w - 3];
                oa[w] = pk2((x1l * cl - x2l * sl) * sc[u], (x1h * ch - x2h * sh) * sc[u]);
                ob[w] = pk2((x2l * cl + x1l * sl) * sc[u], (x2h * ch + x1h * sh) * sc[u]);
            }
            if (ok[u]) { *(v4u*)(p[u]) = oa; *(v4u*)(p[u] + 32) = ob; }
        }
    }
}

__device__ __forceinline__ void rope_span(Ctx& C, int beg, int end, int t, int nthr) {
    const float* cosT = (const float*)(C.ws + WS_ROPE); const float* sinT = cosT + SEQ * 32;
    for (int it0 = beg + t; it0 < end; it0 += 2 * nthr) {
        bf16* p[2]; float sc[2]; v4u a[2], b[2]; f32x4 c0[2], c1[2], s0[2], s1[2]; bool ok[2];
#pragma unroll
        for (int u = 0; u < 2; ++u) {
            const int it = it0 + u * nthr; ok[u] = it < end; const int itc = ok[u] ? it : it0;
            const int i8 = itc & 3, grp = (itc >> 2) % 22, row = (itc >> 2) / 22, pos = row & (SEQ - 1);
            sc[u] = 1.f;
            if (grp < 8) { p[u] = (bf16*)(C.ws + WS_DFQ) + (size_t)row * 512 + grp * 64; sc[u] = 0.125f * LOG2E; }
            else if (grp < 16) { p[u] = (bf16*)(C.ws + WS_DFK) + (size_t)row * 512 + (grp - 8) * 64; }
            else if (grp < 20) { p[u] = (bf16*)(C.ws + WS_SWQ) + (size_t)row * 256 + (grp - 16) * 64; sc[u] = 0.125f * LOG2E; }
            else { p[u] = (bf16*)(C.ws + WS_SWKV) + (size_t)row * 256 + (grp - 20) * 64; }
            p[u] += i8 * 8;
            a[u] = *(const v4u*)(p[u]); b[u] = *(const v4u*)(p[u] + 32);
            c0[u] = *(const f32x4*)(cosT + pos * 32 + i8 * 8); c1[u] = *(const f32x4*)(cosT + pos * 32 + i8 * 8 + 4);
            s0[u] = *(const f32x4*)(sinT + pos * 32 + i8 * 8); s1[u] = *(const f32x4*)(sinT + pos * 32 + i8 * 8 + 4);
        }
#pragma unroll
        for (int u = 0; u < 2; ++u) {
            v4u oa, ob;
#pragma unroll
            for (int w = 0; w < 4; ++w) {
                const float x1l = __uint_as_float(a[u][w] << 16), x1h = __uint_as_float(a[u][w] & 0xffff0000u), x2l = __uint_as_float(b[u][w] << 16), x2h = __uint_as_float(b[u][w] & 0xffff0000u);
                const float cl = (w < 2) ? c0[u][2 * w] : c1[u][2 * w - 4], ch = (w < 2) ? c0[u][2 * w + 1] : c1[u][2 * w - 3];
                const float sl = (w < 2) ? s0[u][2 * w] : s1[u][2 * w - 4], sh = (w < 2) ? s0[u][2 * w + 1] : s1[u][2 * w - 3];
                oa[w] = pk2((x1l * cl - x2l * sl) * sc[u], (x1h * ch - x2h * sh) * sc[u]);
                ob[w] = pk2((x2l * cl + x1l * sl) * sc[u], (x2h * ch + x1h * sh) * sc[u]);
            }
            if (ok[u]) { *(v4u*)(p[u]) = oa; *(v4u*)(p[u] + 32) = ob; }
        }
    }
}

__device__ __forceinline__ void phase_dn_prep(Ctx& C, const float* convw, const float* a_log, const float* dt_bias) {
    constexpr int P = 65;
    LAS float* raw = (LAS float*)C.lds;
    LAS float* KK = raw; LAS float* QK = raw + 64 * P; LAS float* Ld = raw + 2 * 64 * P;
    LAS float* qkv = (LAS float*)(C.lds + 66048);
    LAS float* sm = (LAS float*)(C.lds + 66048 + 49920);
    LAS float* betaT = sm, *gT = sm + 128, *Gs = sm + 256, *bs = sm + 384;
    const bf16* dnraw = (const bf16*)(C.ws + WS_DNRAW); const float* bg = (const float*)(C.ws + WS_BG);
    for (int task = C.vcu; task < 2 * 4 * 128; task += C.G) {
        const int nc = task & 127, h = (task >> 7) & 3, seq = task >> 9, c0 = nc * 64;
        __syncthreads();
        int tid_ = C.tid; asm volatile("" : "+v"(tid_));
        const int tidl = tid_, lanel = tid_ & 63, wavel = __builtin_amdgcn_readfirstlane(tid_ >> 6);
        for (int idx = tidl; idx < 3 * 68 * 8; idx += NTHR) {
            const int c8 = idx & 7, rr = (idx >> 3) % 68, part = (idx >> 3) / 68, t = c0 - 2 + rr;
            v4u v = (v4u){0u, 0u, 0u, 0u};
            if (t >= 0 && t < SEQ) v = *(const v4u*)(dnraw + (size_t)(seq * SEQ + t) * 768 + part * 256 + h * 64 + c8 * 8);
            LAS float* d = raw + (part * 68 + rr) * 64 + c8 * 8;
#pragma unroll
            for (int w = 0; w < 4; ++w) { d[2 * w] = __uint_as_float(v[w] << 16); d[2 * w + 1] = __uint_as_float(v[w] & 0xffff0000u); }
        }
        if (tidl < 128) { const int dir = tidl >> 6, i = tidl & 63; const size_t row = (size_t)(seq * SEQ + c0 + i);
            const float bl = bg[row * 16 + dir * 4 + h], al = bg[row * 16 + 8 + dir * 4 + h] + dt_bias[dir * 4 + h];
            betaT[dir * 64 + i] = __builtin_amdgcn_rcpf(1.f + __expf(-bl));
            const float e_ = __expf(-fabsf(al)); const float sp = fmaxf(al, 0.f) + ((e_ < 0.01f) ? e_ * (1.f - e_ * (0.5f - e_ * 0.33333333f)) : __logf(1.f + e_));
            gT[dir * 64 + i] = -__expf(a_log[dir * 4 + h]) * sp; }
        __syncthreads();
        { const int c = tidl & 63, i0 = tidl >> 6;
#pragma unroll
          for (int part = 0; part < 3; ++part) { float cw[5];
#pragma unroll
            for (int j = 0; j < 5; ++j) cw[j] = convw[j * 768 + part * 256 + h * 64 + c];
#pragma unroll
            for (int k = 0; k < 8; ++k) { const int i = i0 + 8 * k; float sacc = 0.f;
#pragma unroll
                for (int j = 0; j < 5; ++j) sacc += raw[(part * 68 + i + j) * 64 + c] * cw[j];
                qkv[(part * 64 + i) * P + c] = sacc * __builtin_amdgcn_rcpf(1.f + __expf(-sacc)); } } }
        if (wavel < 2) { const int dir = wavel, il = lanel, it = dir ? 63 - il : il; float a = gT[dir * 64 + it];
#pragma unroll
            for (int o = 1; o < 64; o <<= 1) { const float t = __int_as_float(__builtin_amdgcn_ds_bpermute(((il - o) & 63) << 2, __float_as_int(a))); if (il >= o) a += t; }
            Gs[dir * 64 + il] = a; bs[dir * 64 + il] = betaT[dir * 64 + it];
            const float gl_ = __int_as_float(__builtin_amdgcn_ds_bpermute(63 << 2, __float_as_int(a)));
            sm[512 + dir * 64 + il] = __expf(a); sm[640 + dir * 64 + il] = __expf(gl_ - a); }
        __syncthreads();
        { LAS float* r = qkv + (tidl >> 2) * P + 16 * (tidl & 3); float v[16]; float sq = 0.f;
#pragma unroll
          for (int c = 0; c < 16; ++c) { v[c] = r[c]; sq += v[c] * v[c]; }
          sq += shx(sq, 1, lanel); sq += shx(sq, 2, lanel);
          const float sc = __builtin_amdgcn_rsqf(sq + EPS);
#pragma unroll
          for (int c = 0; c < 16; ++c) r[c] = v[c] * sc; }
        __syncthreads();
        { const int r32 = lanel & 31, hi = lanel >> 5, mat = wavel >> 2, it = (wavel >> 1) & 1, mt = wavel & 1;
          const LAS float* ar = qkv + ((mat ? 0 : 64) + r32 + 32 * it) * P + 2 * hi; const LAS float* br = qkv + (64 + r32 + 32 * mt) * P + 2 * hi;
          f32x16 acc = f32x16{};
#pragma unroll
          for (int j = 0; j < 16; ++j) { const float a0 = ar[4 * j], a1 = ar[4 * j + 1], b0 = br[4 * j], b1 = br[4 * j + 1];
              acc = __builtin_amdgcn_mfma_f32_32x32x2f32(a0, b0, acc, 0, 0, 0); acc = __builtin_amdgcn_mfma_f32_32x32x2f32(a1, b1, acc, 0, 0, 0); }
          LAS float* dst = (mat ? QK : KK) + (32 * it) * P + r32 + 32 * mt;
#pragma unroll
          for (int r = 0; r < 16; ++r) dst[((r & 3) + 8 * (r >> 2) + 4 * hi) * P] = acc[r]; }
        __syncthreads();
        for (int idx = tidl; idx < 2 * 64 * 64; idx += NTHR) {
            const int ml = idx & 63, il = (idx >> 6) & 63, dir = idx >> 12;
            const int it = dir ? 63 - il : il, mt = dir ? 63 - ml : ml;
            float v = 0.f;
            if (il > ml) v = bs[dir * 64 + il] * KK[it * P + mt] * __expf(Gs[dir * 64 + il] - Gs[dir * 64 + ml]);
            Ld[idx] = v;
        }
        __syncthreads();
        const int blk0 = ((0 * 2 + seq) * 4 + h) * 128 + nc, blk1 = ((1 * 2 + seq) * 4 + h) * 128 + (127 - nc);
        if (wavel < 4) {
            const int dir = wavel >> 1, col = (wavel & 1) * 64 + lanel;
            unsigned lb = (unsigned)(uintptr_t)(Ld + dir * 4096);
            const LAS float* src = (col < 64) ? (qkv + (2 * 64) * P + col) : (qkv + 64 * P + (col - 64));
            float xs[64];
#pragma unroll
            for (int il = 0; il < 64; ++il) {
                const int it = dir ? 63 - il : il;
                float a = src[it * P] * bs[dir * 64 + il];
                if (col >= 64) a *= sm[512 + dir * 64 + il];
#pragma unroll
                for (int m4 = 0; m4 < (il + 3) / 4; ++m4) { const f32x4 l4 = *(const LAS f32x4*)(uintptr_t)(lb + (il * 64 + 4 * m4) * 4);
                    if (4 * m4 < il) a -= l4.x * xs[4 * m4];
                    if (4 * m4 + 1 < il) a -= l4.y * xs[4 * m4 + 1];
                    if (4 * m4 + 2 < il) a -= l4.z * xs[4 * m4 + 2];
                    if (4 * m4 + 3 < il) a -= l4.w * xs[4 * m4 + 3]; }
                xs[il] = a; if (il & 1) asm volatile("" : "+v"(lb) : "v"(a));
            }
            const int blk = dir ? blk1 : blk0;
            if (col < 64) {
                bf16* U = (bf16*)(C.ws + WS_U) + (size_t)blk * 4096;
                const int et = col >> 5, r32 = col & 31;
#pragma unroll
                for (int mt = 0; mt < 2; ++mt)
#pragma unroll
                    for (int hi = 0; hi < 2; ++hi) { v4u o0, o1;
#pragma unroll
                        for (int q = 0; q < 4; ++q) { const int ra = 2 * q, rb = 2 * q + 1, rc = 8 + 2 * q, rd = 9 + 2 * q;
                            o0[q] = pk2(xs[32 * mt + (ra & 3) + 8 * (ra >> 2) + 4 * hi], xs[32 * mt + (rb & 3) + 8 * (rb >> 2) + 4 * hi]);
                            o1[q] = pk2(xs[32 * mt + (rc & 3) + 8 * (rc >> 2) + 4 * hi], xs[32 * mt + (rd & 3) + 8 * (rd >> 2) + 4 * hi]); }
                        bf16* dst = U + ((mt * 2 + et) * 64 + r32 + 32 * hi) * 16; *(v4u*)dst = o0; *(v4u*)(dst + 8) = o1; }
            } else {
                bf16* W = (bf16*)(C.ws + WS_W) + (size_t)blk * 4096; const int d = col - 64;
#pragma unroll
                for (int il = 0; il < 64; ++il) W[il * 64 + d] = (bf16)(pk2(xs[il], 0.f) & 0xffffu);
            }
        } else {
            const int t2 = tidl - 256;
            for (int idx = t2; idx < 2 * 64 * 8; idx += 256) {
                const int d8 = idx & 7, il = (idx >> 3) & 63, dir = idx >> 9;
                const int it = dir ? 63 - il : il; const LAS float* s = qkv + it * P + d8 * 8; const float f = 0.125f * sm[512 + dir * 64 + il];
                v4u o; o.x = pk2(s[0] * f, s[1] * f); o.y = pk2(s[2] * f, s[3] * f); o.z = pk2(s[4] * f, s[5] * f); o.w = pk2(s[6] * f, s[7] * f);
                *(v4u*)((bf16*)(C.ws + WS_QS) + (size_t)(dir ? blk1 : blk0) * 4096 + il * 64 + d8 * 8) = o;
            }
            for (int idx = t2; idx < 2 * 64 * 8; idx += 256) {
                const int i8 = idx & 7, d = (idx >> 3) & 63, dir = idx >> 9; const float gl = Gs[dir * 64 + 63];
                float v[8];
#pragma unroll
                for (int j = 0; j < 8; ++j) { const int il = i8 * 8 + j, it = dir ? 63 - il : il; v[j] = qkv[(64 + it) * P + d] * sm[640 + dir * 64 + il]; }
                v4u o; o.x = pk2(v[0], v[1]); o.y = pk2(v[2], v[3]); o.z = pk2(v[4], v[5]); o.w = pk2(v[6], v[7]);
                *(v4u*)((bf16*)(C.ws + WS_KT) + (size_t)(dir ? blk1 : blk0) * 4096 + d * 64 + i8 * 8) = o;
            }
            for (int idx = t2; idx < 2 * 3 * 64 * 2; idx += 256) {
                const int half = idx & 1, ln = (idx >> 1) & 63, tt = (idx >> 7) % 3, dir = (idx >> 7) / 3;
                const int mt = (tt == 2) ? 1 : 0, itl = (tt == 0) ? 0 : 1, r32 = ln & 31, hi = ln >> 5, il = r32 + 32 * itl, itok = dir ? 63 - il : il;
                const float gi = Gs[dir * 64 + il];
                float v[8];
#pragma unroll
                for (int j = 0; j < 8; ++j) { const int r = 8 * half + j, ml = (r & 3) + 8 * (r >> 2) + 4 * hi + 32 * mt, mtok = dir ? 63 - ml : ml;
                    v[j] = (il >= ml) ? 0.125f * QK[itok * P + mtok] * __expf(gi - Gs[dir * 64 + ml]) : 0.f; }
                v4u o; o.x = pk2(v[0], v[1]); o.y = pk2(v[2], v[3]); o.z = pk2(v[4], v[5]); o.w = pk2(v[6], v[7]);
                *(v4u*)((bf16*)(C.ws + WS_KS) + (size_t)(dir ? blk1 : blk0) * 4096 + ((mt * 2 + itl) * 64 + ln) * 16 + 8 * half) = o;
            }
            if (t2 < 2) ((float*)(C.ws + WS_GS))[t2 ? blk1 : blk0] = __expf(Gs[t2 * 64 + 63]);
            { constexpr int PER_TASK = (MG * 22 * 4) / 1024; const int tslot = (task - C.vcu) / C.G; const int beg = (C.vcu * 4 + tslot) * PER_TASK; rope_span(C, beg, beg + PER_TASK, t2, 256); }
        }
    }
    __syncthreads();
}

#define DN_BAR() asm volatile("s_waitcnt lgkmcnt(0)\n\ts_barrier" ::: "memory")
#define LDG(T, base, off) (*(const GAS T*)((const GAS char*)(base) + (off)))
__device__ __forceinline__ void dn_chain(Ctx& C, int ch) {
    constexpr int SP = 72, IMG = 64 * SP;
    LAS bf16* STb = (LAS bf16*)C.lds; LAS v4u* VN = (LAS v4u*)(C.lds + 3 * IMG * 2);
    const int lane = C.lane, r32 = lane & 31, hi = lane >> 5, w = C.wave, wl = w & 3;
    const int dir = ch >> 3, seq = (ch >> 2) & 1, h = ch & 3;
    const GAS bf16* QD = (const GAS bf16*)(C.ws + WS_QS) + (size_t)ch * 128 * 4096; const GAS bf16* AT = (const GAS bf16*)(C.ws + WS_KS) + (size_t)ch * 128 * 4096;
    const GAS bf16* KT = (const GAS bf16*)(C.ws + WS_KT) + (size_t)ch * 128 * 4096; const GAS bf16* UU = (const GAS bf16*)(C.ws + WS_U) + (size_t)ch * 128 * 4096;
    const GAS bf16* WW = (const GAS bf16*)(C.ws + WS_W) + (size_t)ch * 128 * 4096; const GAS float* GL = (const GAS float*)(C.ws + WS_GS) + (size_t)ch * 128;
    GAS float* ODN = (GAS float*)(C.ws + WS_ODN) + (size_t)dir * MG * 256;
    __syncthreads();
    for (int e = C.tid; e < 3 * IMG / 2; e += NTHR) ((LAS unsigned*)STb)[e] = 0u;
    __syncthreads();
    if (w < 4) {
        const int et = wl >> 1, dt = wl & 1;
        f32x16 ST = f32x16{};
        bf16x8 wA0[2][4], kB0[2][2], wA1[2][4], kB1[2][2]; v4u uu0[2][2], uu1[2][2]; float gam0, gam1;
        const unsigned off_w0 = (unsigned)((r32 * 64 + 8 * hi) * 2), off_u0 = (unsigned)((et * 64 + lane) * 32), off_kt = (unsigned)(((r32 + 32 * dt) * 64 + 4 * hi) * 2);
#define CH_LOAD(n_, wA, kB, uu, gam) do { const GAS bf16* Wb = WW + (size_t)(n_) * 4096; const GAS bf16* Ub = UU + (size_t)(n_) * 4096; const GAS bf16* KTb = KT + (size_t)(n_) * 4096; \
            _Pragma("unroll") for (int mt = 0; mt < 2; ++mt) { \
                _Pragma("unroll") for (int kk = 0; kk < 4; ++kk) wA[mt][kk] = LDG(bf16x8, Wb, off_w0 + (unsigned)(mt * 4096 + kk * 32)); \
                uu[mt][0] = LDG(v4u, Ub, off_u0 + (unsigned)(mt * 4096)); uu[mt][1] = LDG(v4u, Ub, off_u0 + (unsigned)(mt * 4096 + 16)); \
                _Pragma("unroll") for (int s = 0; s < 2; ++s) { const v2u lo = LDG(v2u, KTb, off_kt + (unsigned)((32 * mt + 16 * s) * 2)), hh = LDG(v2u, KTb, off_kt + (unsigned)((32 * mt + 16 * s + 8) * 2)); \
                    kB[mt][s] = __builtin_bit_cast(bf16x8, (v4u){lo.x, lo.y, hh.x, hh.y}); } } \
            gam = GL[n_]; } while (0)
#define CH_STEP(n_, wA, kB, uu, gam) do { \
            const int c3 = (n_) % 3, x3 = (c3 == 2) ? 0 : c3 + 1; \
            bf16x8 sB[4]; \
            _Pragma("unroll") for (int kk = 0; kk < 4; ++kk) sB[kk] = *(const LAS bf16x8*)(STb + c3 * IMG + (r32 + 32 * et) * SP + 16 * kk + 8 * hi); \
            f32x16 ws0 = f32x16{}, ws1 = f32x16{}; \
            _Pragma("unroll") for (int kk = 0; kk < 4; ++kk) { ws0 = MFMA32(wA[0][kk], sB[kk], ws0); ws1 = MFMA32(wA[1][kk], sB[kk], ws1); } \
            _Pragma("unroll") for (int r = 0; r < 16; ++r) { \
                const float u0 = (r & 1) ? __uint_as_float(uu[0][r >> 3][(r >> 1) & 3] & 0xffff0000u) : __uint_as_float(uu[0][r >> 3][(r >> 1) & 3] << 16); \
                const float u1 = (r & 1) ? __uint_as_float(uu[1][r >> 3][(r >> 1) & 3] & 0xffff0000u) : __uint_as_float(uu[1][r >> 3][(r >> 1) & 3] << 16); \
                ws0[r] = u0 - ws0[r]; ws1[r] = u1 - ws1[r]; ST[r] *= gam; } \
            const bf16x8 p00 = pack8(ws0, 0), p01 = pack8(ws0, 1), p10 = pack8(ws1, 0), p11 = pack8(ws1, 1); \
            { LAS v4u* vn = VN + ((((n_) & 1) * 2 + et) * 4) * 64 + lane; vn[0] = __builtin_bit_cast(v4u, p00); vn[64] = __builtin_bit_cast(v4u, p01); vn[128] = __builtin_bit_cast(v4u, p10); vn[192] = __builtin_bit_cast(v4u, p11); } \
            ST = MFMA32(p00, kB[0][0], ST); ST = MFMA32(p10, kB[1][0], ST); ST = MFMA32(p01, kB[0][1], ST); ST = MFMA32(p11, kB[1][1], ST); \
            LAS bf16* dst = STb + x3 * IMG + (32 * et) * SP + r32 + 32 * dt; \
            _Pragma("unroll") for (int r = 0; r < 16; ++r) dst[crow(r, hi) * SP] = (bf16)(pk2(ST[r], 0.f) & 0xffffu); \
            DN_BAR(); } while (0)
        CH_LOAD(0, wA0, kB0, uu0, gam0);
        for (int n = 0; n < 128; n += 2) {
            CH_LOAD(n + 1, wA1, kB1, uu1, gam1);
            CH_STEP(n, wA0, kB0, uu0, gam0);
            CH_LOAD((n + 2 < 128) ? n + 2 : 127, wA0, kB0, uu0, gam0);
            CH_STEP(n + 1, wA1, kB1, uu1, gam1);
        }
        DN_BAR();
#undef CH_LOAD
#undef CH_STEP
    } else {
        const int it = wl >> 1, et = wl & 1;
        bf16x8 qA0[4], qA1[4]; v4u at0[2][2], at1[2][2];
        const unsigned off_q = (unsigned)(((r32 + 32 * it) * 64 + 8 * hi) * 2), off_at0 = (unsigned)((it * 64 + lane) * 32);
#define OW_LOAD(n_, qA, at) do { const GAS bf16* Qb = QD + (size_t)(n_) * 4096; const GAS bf16* Ab = AT + (size_t)(n_) * 4096; \
            _Pragma("unroll") for (int kk = 0; kk < 4; ++kk) qA[kk] = LDG(bf16x8, Qb, off_q + (unsigned)(kk * 32)); \
            _Pragma("unroll") for (int mt = 0; mt < 2; ++mt) { if (mt <= it) { at[mt][0] = LDG(v4u, Ab, off_at0 + (unsigned)(mt * 4096)); at[mt][1] = LDG(v4u, Ab, off_at0 + (unsigned)(mt * 4096 + 16)); } } } while (0)
#define OW_STEP(n_, qA, at) do { \
            const int c3 = (n_) % 3; \
            bf16x8 sB[4]; \
            _Pragma("unroll") for (int kk = 0; kk < 4; ++kk) sB[kk] = *(const LAS bf16x8*)(STb + c3 * IMG + (r32 + 32 * et) * SP + 16 * kk + 8 * hi); \
            const LAS v4u* vn = VN + ((((n_) & 1) * 2 + et) * 4) * 64 + lane; \
            f32x16 o = f32x16{}; \
            _Pragma("unroll") for (int kk = 0; kk < 4; ++kk) o = MFMA32(qA[kk], sB[kk], o); \
            _Pragma("unroll") for (int mt = 0; mt < 2; ++mt) { if (mt <= it) { \
                _Pragma("unroll") for (int s = 0; s < 2; ++s) o = MFMA32(__builtin_bit_cast(bf16x8, at[mt][s]), __builtin_bit_cast(bf16x8, vn[(mt * 2 + s) * 64]), o); } } \
            _Pragma("unroll") for (int r = 0; r < 16; ++r) { const int sr = (n_) * 64 + 32 * it + crow(r, hi), t = dir ? (SEQ - 1 - sr) : sr; \
                ODN[(size_t)(seq * SEQ + t) * 256 + h * 64 + 32 * et + r32] = o[r]; } \
            DN_BAR(); } while (0)
        OW_LOAD(0, qA0, at0);
        DN_BAR();
        for (int n = 0; n < 128; n += 2) {
            OW_LOAD(n + 1, qA1, at1);
            OW_STEP(n, qA0, at0);
            OW_LOAD((n + 2 < 128) ? n + 2 : 127, qA0, at0);
            OW_STEP(n + 1, qA1, at1);
        }
#undef OW_LOAD
#undef OW_STEP
    }
    __syncthreads();
}
#undef LDG
__device__ __forceinline__ void phase_finalize(Ctx& C, int li, const float* dn_norm_w, const float* diff_lambda, const float* diff_norm_w) {
    const int gw = C.vcu * NWAVES + C.wave, NGW = C.G * NWAVES, lane = C.lane;
    const float lam_init = 0.8f - 0.6f * __expf(-0.3f * (float)li);
    const float d1 = wave_sum(diff_lambda[lane] * diff_lambda[64 + lane], lane), d2 = wave_sum(diff_lambda[128 + lane] * diff_lambda[192 + lane], lane);
    const float lam = __expf(d1) - __expf(d2) + lam_init;
    const f32x4 nwd = *(const f32x4*)(dn_norm_w + (4 * lane & 63));
    const f32x4 nf0 = *(const f32x4*)(diff_norm_w + (8 * lane & 127)), nf1 = *(const f32x4*)(diff_norm_w + (8 * lane & 127) + 4);
    const float* of = (const float*)(C.ws + WS_ODN); const float* ob = of + (size_t)MG * 256;
    const bf16* zb = (const bf16*)(C.ws + WS_Z); const bf16* odf = (const bf16*)(C.ws + WS_ODF); bf16* mix = (bf16*)(C.ws + WS_MIX);
    const int hh_ = lane >> 4, e0_ = 8 * (lane & 15);
    f32x4 na = *(const f32x4*)(of + (size_t)gw * 256 + 4 * lane), nb = *(const f32x4*)(ob + (size_t)gw * 256 + 4 * lane); v2u nz = *(const v2u*)(zb + (size_t)gw * 256 + 4 * lane);
    v4u nda = *(const v4u*)(odf + (size_t)gw * 1024 + hh_ * 256 + e0_), ndb = *(const v4u*)(odf + (size_t)gw * 1024 + hh_ * 256 + 128 + e0_);
    for (int m = gw; m < MG; m += NGW) {
        const f32x4 ca = na, cb = nb; const v2u cz = nz; const v4u cda = nda, cdb = ndb;
        { const int mn = (m + NGW < MG) ? m + NGW : m;
          na = *(const f32x4*)(of + (size_t)mn * 256 + 4 * lane); nb = *(const f32x4*)(ob + (size_t)mn * 256 + 4 * lane); nz = *(const v2u*)(zb + (size_t)mn * 256 + 4 * lane);
          nda = *(const v4u*)(odf + (size_t)mn * 1024 + hh_ * 256 + e0_); ndb = *(const v4u*)(odf + (size_t)mn * 1024 + hh_ * 256 + 128 + e0_); }
        {
            const f32x4 a = ca, b = cb;
            const f32x4 o = a + b; float s = (o.x * o.x + o.y * o.y) + (o.z * o.z + o.w * o.w);
            s += shx(s, 1, lane); s += shx(s, 2, lane); s += shx(s, 4, lane); s += shx(s, 8, lane);
            const float rstd = __builtin_amdgcn_rsqf(s * (1.f / 64.f) + EPS);
            const v2u zz = cz;
            const float z0 = __uint_as_float(zz.x << 16), z1 = __uint_as_float(zz.x & 0xffff0000u), z2 = __uint_as_float(zz.y << 16), z3 = __uint_as_float(zz.y & 0xffff0000u);
            v2u w; w.x = pk2(o.x * rstd * nwd.x * (z0 * __builtin_amdgcn_rcpf(1.f + __expf(-z0))), o.y * rstd * nwd.y * (z1 * __builtin_amdgcn_rcpf(1.f + __expf(-z1))));
            w.y = pk2(o.z * rstd * nwd.z * (z2 * __builtin_amdgcn_rcpf(1.f + __expf(-z2))), o.w * rstd * nwd.w * (z3 * __builtin_amdgcn_rcpf(1.f + __expf(-z3))));
            *(v2u*)(mix + (size_t)m * 1024 + 4 * lane) = w;
        }
        {
            const int hh = lane >> 4, e0 = 8 * (lane & 15);
            v4u a = cda; const v4u b = cdb;
            if (hh == 0 && m < SEQ) {
                const int cc = e0 >> 6; const bf16* po = (const bf16*)(C.ws + WS_PO); const float* ps = (const float*)(C.ws + WS_PS);
                float mp[4], lp[4]; v4u pp[4]; float mm = -INFINITY;
#pragma unroll
                for (int p = 0; p < 4; ++p) { pp[p] = *(const v4u*)(po + ((size_t)(p * 2 + cc) * SEQ + m) * 64 + (e0 & 63)); mp[p] = ps[((size_t)(p * 2 + cc) * SEQ + m) * 2]; lp[p] = ps[((size_t)(p * 2 + cc) * SEQ + m) * 2 + 1]; mm = fmaxf(mm, mp[p]); }
                float wsum = 0.f;
#pragma unroll
                for (int p = 0; p < 4; ++p) { lp[p] *= __builtin_amdgcn_exp2f(mp[p] - mm); wsum += lp[p]; }
                const float inv = 1.f / wsum;
#pragma unroll
                for (int w = 0; w < 4; ++w) { float lo = 0.f, hi_ = 0.f;
#pragma unroll
                    for (int p = 0; p < 4; ++p) { lo += lp[p] * __uint_as_float(pp[p][w] << 16); hi_ += lp[p] * __uint_as_float(pp[p][w] & 0xffff0000u); }
                    a[w] = pk2(lo * inv, hi_ * inv); }
            }
            float o[8]; float s = 0.f;
#pragma unroll
            for (int w = 0; w < 4; ++w) { o[2 * w] = __uint_as_float(a[w] << 16) - lam * __uint_as_float(b[w] << 16); o[2 * w + 1] = __uint_as_float(a[w] & 0xffff0000u) - lam * __uint_as_float(b[w] & 0xffff0000u);
                s += o[2 * w] * o[2 * w] + o[2 * w + 1] * o[2 * w + 1]; }
            s += shx(s, 1, lane); s += shx(s, 2, lane); s += shx(s, 4, lane); s += shx(s, 8, lane);
            const float sc = (1.f - lam_init) * __builtin_amdgcn_rsqf(s * (1.f / 128.f) + EPS);
            v4u w; w.x = pk2(o[0] * sc * nf0.x, o[1] * sc * nf0.y); w.y = pk2(o[2] * sc * nf0.z, o[3] * sc * nf0.w); w.z = pk2(o[4] * sc * nf1.x, o[5] * sc * nf1.y); w.w = pk2(o[6] * sc * nf1.z, o[7] * sc * nf1.w);
            *(v4u*)(mix + (size_t)m * 1024 + 256 + 8 * lane) = w;
        }
    }
}

struct Args { const float* in[16]; float* out; unsigned char* ws; };
__device__ __forceinline__ const float* ldarg(int k) { const Args* p = (const Args*)__builtin_amdgcn_kernarg_segment_ptr(); asm volatile("" : "+s"(p)); return p->in[k]; }
__device__ __forceinline__ float* ldout() { const Args* p = (const Args*)__builtin_amdgcn_kernarg_segment_ptr(); asm volatile("" : "+s"(p)); return p->out; }
__device__ __forceinline__ unsigned char* ldws() { const Args* p = (const Args*)__builtin_amdgcn_kernarg_segment_ptr(); asm volatile("" : "+s"(p)); return p->ws; }
__device__ __forceinline__ void refresh(Ctx& C, unsigned char* ldsp) {
    int t = threadIdx.x; asm volatile("" : "+v"(t));
    int bx = blockIdx.x; asm volatile("" : "+s"(bx));
    int G = gridDim.x; asm volatile("" : "+s"(G));
    unsigned lo = (unsigned)(uintptr_t)ldsp; asm volatile("" : "+s"(lo));
    C.lds = (LAS unsigned char*)(uintptr_t)lo; C.ldsg = ldsp; C.tid = t; C.lane = t & 63; C.wave = __builtin_amdgcn_readfirstlane(t >> 6);
    C.G = G; C.vcu = (G % 8 == 0) ? (bx % 8) * (G / 8) + bx / 8 : bx; C.bx = bx;
    C.ws = ldws();
}
#define RF() refresh(C, lds)
#define GSYNC() do { RF(); XcdBarrier b_; b_.bar = (unsigned*)C.ws; b_.x = xb_xcc_id(); b_.st = (volatile LAS unsigned*)(C.lds + 131424); xcd_barrier(b_); } while (0)
__global__ void __launch_bounds__(NTHR, 2) hybrid_fwd(Args args) {
    extern __shared__ __attribute__((aligned(16))) unsigned char lds[];
    cg::grid_group grid = cg::this_grid();
    Ctx C; RF();
    if (C.tid < 2) ((volatile LAS unsigned*)(C.lds + 131424))[C.tid] = 0u;
    __syncthreads();
    if (C.tid == 0) (void)xb_add(&((unsigned*)C.ws)[XB_XCNT(xb_xcc_id())], 1u);
#define ARGP(k) (ldarg(k))
#define x_prompt ARGP(0)
#define x_sample ARGP(1)
#define norm1_w ARGP(2)
#define w_in ARGP(3)
#define conv_w ARGP(4)
#define a_log ARGP(5)
#define dt_bias ARGP(6)
#define dn_norm_w ARGP(7)
#define diff_lambda ARGP(8)
#define diff_norm_w ARGP(9)
#define swa_sink ARGP(10)
#define w_out ARGP(11)
#define norm2_w ARGP(12)
#define w_up ARGP(13)
#define w_dn ARGP(14)
#define final_w ARGP(15)
#define HN ((bf16*)(C.ws + WS_HN))
#define MIX ((bf16*)(C.ws + WS_MIX))
#define HID ((bf16*)(C.ws + WS_HID))
    phase_prologue(C, w_in, w_out, w_up, w_dn, norm2_w, norm1_w);
    RF();
    phase_norm<false>(C, x_prompt, norm1_w, HN, nullptr, nullptr);
    grid.sync();
    for (int g = 0; g < NGRP; ++g) {
#define xo (ldout() + (size_t)g * MG * DMODEL)
        for (int li = 0; li < DEPTH; ++li) {
#define xcur (li ? (const float*)xo : ((g < 2) ? x_prompt + (size_t)g * MG * DMODEL : x_sample))
            RF();
            if (li == 0 && g > 0) { phase_norm<false>(C, xcur, norm1_w, HN, nullptr, nullptr); GSYNC(); }
            RF();
            { pg8::Gemm gm{HN, (const bf16*)(C.ws + WS_WIN) + (size_t)li * NPROJ * DMODEL, MG, NPROJ, DMODEL}; pg8::StaticOrder S; S.init(MG, NPROJ, C.G, C.bx);
              phase_logits(C, HN, (const bf16*)(C.ws + WS_WL) + (size_t)li * 32 * DMODEL, li ? (const float*)(C.ws + WS_SS2) : nullptr, (float*)(C.ws + WS_BG));
              pg8::EpiProj E{C.ws, li ? (const float*)(C.ws + WS_SS2) : nullptr};
              pg8::gemm_phase<pg8::EpiProj, pg8::StaticOrder, true, true>(C.lds, gm, S, E); }
            GSYNC();
            RF();
            RF();
#ifndef NO_PREP
            phase_dn_prep(C, conv_w + (size_t)li * 5 * 768, a_log + li * 8, dt_bias + li * 8);
#endif
            GSYNC();
            RF();
            {
#ifndef NO_CHAIN
                if (C.vcu < 16) dn_chain(C, C.vcu);
#endif
                __syncthreads(); RF();
                using abf = attn_body::bf16;
                {
                    const int nun = (C.vcu < 16) ? 0 : 4;
                    for (int i = 0; i < nun; ++i) {
                        const int bh = C.vcu >> 3, s = C.vcu & 7, b = bh >> 4, vh = bh & 15, h = vh >> 2, j = (vh >> 1) & 1, c = vh & 1;
                        const abf* Qb = (const abf*)(C.ws + WS_DFQ) + (size_t)b * SEQ * 512 + h * 128 + j * 64;
                        const abf* Kb = (const abf*)(C.ws + WS_DFK) + (size_t)b * SEQ * 512 + h * 128 + j * 64;
                        const abf* Vb = (const abf*)(C.ws + WS_DFV) + (size_t)b * SEQ * 512 + h * 128 + c * 64;
                        abf* Ob = (abf*)(C.ws + WS_ODF) + (size_t)b * SEQ * 1024 + h * 256 + j * 128 + c * 64;
                        const int qb = (i == 0) ? s : (i == 1) ? 15 - s : (i == 2) ? 16 + s : 31 - s;
                        attn_body::attn_unit<8, 0>(Qb, 512, Kb, 512, Vb, 512, Ob, 1024, qb * 256, 0.f, (char*)C.ldsg, 0, nullptr, i > 0, i + 1 < nun); }
                    {
                        RF();
                        const int qu = (C.vcu < 16) ? 240 + C.vcu : C.vcu - 16, part = qu & 3, un = qu >> 2, v2 = un & 15, i2 = un >> 4, s = v2 & 7, c = v2 >> 3;
                        const int qb = (i2 == 0) ? s : (i2 == 1) ? 15 - s : (i2 == 2) ? 16 + s : 31 - s;
                        const abf* Qb = (const abf*)(C.ws + WS_DFQ); const abf* Kb = (const abf*)(C.ws + WS_DFK); const abf* Vb = (const abf*)(C.ws + WS_DFV) + c * 64;
                        abf* Ob = (abf*)(C.ws + WS_PO) + (size_t)(part * 2 + c) * SEQ * 64;
                        attn_body::attn_unit<8, 2>(Qb, 512, Kb, 512, Vb, 512, Ob, 64, qb * 256, 0.f, (char*)C.ldsg, part * (SEQ / 4), (float*)(C.ws + WS_PS) + (size_t)(part * 2 + c) * SEQ * 2);
                    }
                }
                RF();
                {
                    const int nsw = 1;
                    for (int i = 0; i < nsw; ++i) {
                        const int un = C.vcu;
                        const int b = un >> 7, h = (un >> 5) & 3, qb = un & 31;
                        const abf* Qb = (const abf*)(C.ws + WS_SWQ) + (size_t)b * SEQ * 256 + h * 64;
                        const abf* Kb = (const abf*)(C.ws + WS_SWKV) + (size_t)b * SEQ * 256 + (h >> 1) * 64;
                        const abf* Vb = (const abf*)(C.ws + WS_SWKV) + (size_t)b * SEQ * 256 + 128 + (h >> 1) * 64;
                        abf* Ob = (abf*)(C.ws + WS_MIX) + (size_t)b * SEQ * 1024 + 768 + h * 64;
                        attn_body::attn_unit<8, 1>(Qb, 256, Kb, 256, Vb, 256, Ob, 1024, qb * 256, swa_sink[li * 4 + h] * LOG2E, (char*)C.ldsg);
                    }
                }
            }
            GSYNC();
            RF();
            phase_finalize(C, li, dn_norm_w + li * 64, diff_lambda + li * 256, diff_norm_w + li * 128);
            GSYNC();
            RF();
            { pg8::Gemm gm{MIX, (const bf16*)(C.ws + WS_WOUT) + (size_t)li * DMODEL * DMODEL, MG, DMODEL, DMODEL}; pg8::StaticOrder S; S.init(MG, DMODEL, C.G, C.bx);
              pg8::EpiRes E{li ? nullptr : xcur, li ? (const bf16*)HN : nullptr, nullptr, HN, (float*)(C.ws + WS_SS)};
              pg8::gemm_phase<pg8::EpiRes, pg8::StaticOrder, true, true>(C.lds, gm, S, E); }
            GSYNC();
            RF();
            { pg8::Gemm gm{HN, (const bf16*)(C.ws + WS_WUP) + (size_t)li * DFF * DMODEL, MG, DFF, DMODEL}; pg8::StaticOrder S; S.init(MG, DFF, C.G, C.bx);
              pg8::EpiRelu2S E{HID, (const float*)(C.ws + WS_SS), DFF};
              pg8::gemm_phase<pg8::EpiRelu2S, pg8::StaticOrder, true, true>(C.lds, gm, S, E); }
            GSYNC();
            RF();
            { pg8::Gemm gm{HID, (const bf16*)(C.ws + WS_WDN) + (size_t)li * DMODEL * DFF, MG, DMODEL, DFF}; pg8::StaticOrder S; S.init(MG, DMODEL, C.G, C.bx);
              pg8::EpiRes E{nullptr, HN, li ? xo : nullptr, li ? nullptr : HN, li ? nullptr : (float*)(C.ws + WS_SS2)};
              pg8::gemm_phase<pg8::EpiRes, pg8::StaticOrder, true, true>(C.lds, gm, S, E); }
            GSYNC();
        }
        RF();
        phase_final_norm(C, xo, final_w);
    }
}

extern "C" void kernel_launch(void* const* d_in, const int* in_sizes, int n_in, void* d_out, int out_size, void* d_ws, size_t ws_size, hipStream_t stream) {
    static int grid = 0;
    if (grid == 0) {
        if (n_in != 16 || ws_size < 498 * MiB) { fprintf(stderr, "kernel_launch: unexpected inputs (n_in %d, ws %zu)\n", n_in, ws_size); grid = -1; return; }
        int dev = 0, cus = 0, per_cu = 0;
        hipGetDevice(&dev); hipDeviceGetAttribute(&cus, hipDeviceAttributeMultiprocessorCount, dev);
        if (hipFuncSetAttribute((const void*)hybrid_fwd, hipFuncAttributeMaxDynamicSharedMemorySize, LDS_BYTES) != hipSuccess) { fprintf(stderr, "kernel_launch: hipFuncSetAttribute failed\n"); grid = -1; return; }
        hipOccupancyMaxActiveBlocksPerMultiprocessor(&per_cu, (const void*)hybrid_fwd, NTHR, LDS_BYTES);
        (void)hipGetLastError();
        if (per_cu < 1) per_cu = 1;
        grid = cus;
        if (grid != 256) fprintf(stderr, "kernel_launch: %d CUs (built for 256)\n", grid);
    }
    if (grid < 0) return;
    if (hipMemsetAsync(d_ws, 0, 65536, stream) != hipSuccess) { fprintf(stderr, "kernel_launch: hipMemsetAsync failed\n"); return; }
    Args a{};
    for (int i = 0; i < 16; ++i) a.in[i] = (const float*)d_in[i];
    a.out = (float*)d_out; a.ws = (unsigned char*)d_ws;
    void* kargs[] = {&a};
    hipError_t e = hipLaunchCooperativeKernel((const void*)hybrid_fwd, dim3(grid), dim3(NTHR), kargs, LDS_BYTES, stream);
    if (e != hipSuccess) fprintf(stderr, "cooperative launch failed: %s (grid %d)\n", hipGetErrorString(e), grid);
}
```
